# Optimizing an MI355X kernel written in HIP

```python
import jax, jax.numpy as jnp
from jax import lax
import numpy as np

D_MODEL = 1024
BATCH = 8
SEQ = 4096
DEPTH = 1

N_META = 16
CONV_CH = 512
CONV_KERNEL = 31
RWKV_WIDTH = 512
RWKV_HEAD = 64
RWKV_HEADS = RWKV_WIDTH // RWKV_HEAD
RANK_W = 64
RANK_A = 64
RANK_G = 128
N_BRANCH = 2
SHIFT_TOTAL = 3 * RWKV_WIDTH + RANK_W + RANK_A + RANK_G
IN_SPLITS = [CONV_CH, 2 * CONV_CH, 2 * CONV_CH + SHIFT_TOTAL]
IN_TOTAL = 2 * CONV_CH + SHIFT_TOTAL + N_BRANCH * D_MODEL
RWKV_SPLITS = [RWKV_WIDTH, 2 * RWKV_WIDTH, 3 * RWKV_WIDTH, 3 * RWKV_WIDTH + RANK_W, 3 * RWKV_WIDTH + RANK_W + RANK_A]
PEER_HEADS = 8
PEER_NKEYS = 128
PEER_EXPERTS = PEER_NKEYS * PEER_NKEYS
PEER_DHALF = 128
PEER_TOPK = 16
TOK_BLOCK = 256
RMS_EPS = 1e-6
LN_EPS = 1e-5
GN_EPS = 64e-5

kernel_name = "hybrid_conformer_rwkv7_peer_block"


def rmsnorm(x, g):
    xf = x.astype(jnp.float32)
    y = xf * lax.rsqrt(jnp.mean(xf * xf, axis=-1, keepdims=True) + RMS_EPS)
    return (y * g.astype(jnp.float32)).astype(x.dtype)


def token_shift(z):
    return jnp.pad(z[:, :-1], ((0, 0), (1, 0), (0, 0)))


def conformer_conv(val, gate, conv_w, conv_b, ln_g, ln_b, w_out):
    u = val * jax.nn.sigmoid(gate)
    y = lax.conv_general_dilated(
        u, conv_w[:, None, :].astype(u.dtype), window_strides=(1,),
        padding=[(CONV_KERNEL - 1, 0)], dimension_numbers=('NWC', 'WIO', 'NWC'),
        feature_group_count=CONV_CH) + conv_b
    yf = y.astype(jnp.float32)
    mean = jnp.mean(yf, axis=-1, keepdims=True)
    var = jnp.mean(jnp.square(yf - mean), axis=-1, keepdims=True)
    yn = (yf - mean) * lax.rsqrt(var + LN_EPS) * ln_g + ln_b
    return jax.nn.silu(yn).astype(val.dtype) @ w_out


def wkv7_scan(r, decay, k, v, kk, a):
    def step(S, inp):
        r_t, w_t, k_t, v_t, kk_t, a_t = inp
        sa = jnp.einsum('bhvk,bhk->bhv', S, kk_t)
        S = (S * w_t[:, :, None, :]
             - sa[..., None] * (kk_t * a_t)[:, :, None, :]
             + v_t[..., None] * k_t[:, :, None, :])
        return S, jnp.einsum('bhvk,bhk->bhv', S, r_t)
    B, T, H, N = r.shape
    S0 = jnp.zeros((B, H, N, N), jnp.float32)
    xs = tuple(jnp.moveaxis(z, 1, 0) for z in (r, decay, k, v, kk, a))
    _, o = lax.scan(step, S0, xs)
    return jnp.moveaxis(o, 0, 1)


def rwkv7_mix(z, mu, w0, w_up, a0, a_up, g_up, k_k, k_a, r_k, gn_g, gn_b, w_out):
    B, T, _ = z.shape
    zf = z.astype(jnp.float32)
    zf = zf + (token_shift(zf) - zf) * mu
    r, k, v, lw, la, lg = jnp.split(zf, RWKV_SPLITS, axis=-1)
    w = -jax.nn.softplus(-(w0 + jnp.tanh(lw) @ w_up)) - 0.5
    decay = jnp.exp(-jnp.exp(w))
    a = jax.nn.sigmoid(a0 + la @ a_up)
    g = jax.nn.sigmoid(lg) @ g_up
    hd = lambda t: t.reshape(B, T, RWKV_HEADS, RWKV_HEAD)
    kk = hd(k * k_k)
    kk = kk * lax.rsqrt(jnp.maximum(jnp.sum(kk * kk, axis=-1, keepdims=True), 1e-24))
    k = k * (1.0 + (a - 1.0) * k_a)
    r_h, k_h, v_h, a_h = hd(r), hd(k), hd(v), hd(a)
    o = wkv7_scan(r_h, hd(decay), k_h, v_h, kk, a_h)
    mean = jnp.mean(o, axis=-1, keepdims=True)
    var = jnp.mean(jnp.square(o - mean), axis=-1, keepdims=True)
    o = ((o - mean) * lax.rsqrt(var + GN_EPS)).reshape(B, T, RWKV_WIDTH) * gn_g + gn_b
    bonus = jnp.sum(r_h * k_h * r_k, axis=-1, keepdims=True) * v_h
    o = (o + bonus.reshape(B, T, RWKV_WIDTH)) * g
    return o.astype(z.dtype) @ w_out


def peer_ffn(x, w_q, sub_keys, expert_u, expert_v):
    B, T, D = x.shape
    n_tok = B * T
    n_blocks = -(-n_tok // TOK_BLOCK)
    pad = n_blocks * TOK_BLOCK - n_tok
    xt = jnp.pad(x.reshape(n_tok, D), ((0, pad), (0, 0))).reshape(n_blocks, TOK_BLOCK, D)
    K = PEER_TOPK

    def block(xb):
        q = (xb @ w_q).reshape(TOK_BLOCK, PEER_HEADS, 2, PEER_DHALF)
        s = jnp.einsum('thcd,hcnd->thcn', q, sub_keys).astype(jnp.float32)
        top_s, top_i = lax.top_k(s, K)
        cand = top_s[:, :, 0, :, None] + top_s[:, :, 1, None, :]
        best_s, best_c = lax.top_k(cand.reshape(TOK_BLOCK, PEER_HEADS, K * K), K)
        i1 = jnp.take_along_axis(top_i[:, :, 0], best_c // K, axis=-1)
        i2 = jnp.take_along_axis(top_i[:, :, 1], best_c % K, axis=-1)
        e = (i1 * PEER_NKEYS + i2).reshape(TOK_BLOCK, PEER_HEADS * K)
        gate = jax.nn.softmax(best_s, axis=-1).reshape(TOK_BLOCK, PEER_HEADS * K)
        u = expert_u[e]
        act = jax.nn.gelu(jnp.einsum('td,ted->te', xb, u), approximate=False)
        coef = (gate * act.astype(jnp.float32)).astype(xb.dtype)
        return jnp.einsum('te,ted->td', coef, expert_v[e])

    y = lax.map(block, xt)
    return y.reshape(n_blocks * TOK_BLOCK, D)[:n_tok].reshape(B, T, D)


def setup_inputs(seed: int = 0) -> dict:
    key = jax.random.key(seed)
    ks = jax.random.split(key, 32)
    f32 = jnp.float32
    L = DEPTH
    D = D_MODEL

    def nrm(k, shape, s):
        return jax.random.normal(k, shape, f32) * s

    return {
        "x": nrm(ks[0], (BATCH, SEQ, D), 1.0),
        "meta_tokens": nrm(ks[1], (N_META, D), 1.0),
        "g_mix": 1.0 + nrm(ks[2], (L, D), 0.01),
        "w_in": nrm(ks[3], (L, D, IN_TOTAL), D ** -0.5),
        "conv_w": nrm(ks[4], (L, CONV_KERNEL, CONV_CH), CONV_KERNEL ** -0.5),
        "conv_b": nrm(ks[5], (L, CONV_CH), 0.01),
        "conv_ln_g": 1.0 + nrm(ks[6], (L, CONV_CH), 0.01),
        "conv_ln_b": nrm(ks[7], (L, CONV_CH), 0.01),
        "w_conv_out": nrm(ks[8], (L, CONV_CH, D), CONV_CH ** -0.5),
        "mu_shift": jax.random.uniform(ks[9], (L, SHIFT_TOTAL), f32),
        "w0": jax.random.uniform(ks[10], (L, RWKV_WIDTH), f32, -6.0, -1.0),
        "w_up": nrm(ks[11], (L, RANK_W, RWKV_WIDTH), 0.1 * RANK_W ** -0.5),
        "a0": nrm(ks[12], (L, RWKV_WIDTH), 0.1),
        "a_up": nrm(ks[13], (L, RANK_A, RWKV_WIDTH), 0.1 * RANK_A ** -0.5),
        "g_up": nrm(ks[14], (L, RANK_G, RWKV_WIDTH), RANK_G ** -0.5),
        "k_k": 0.85 + nrm(ks[15], (L, RWKV_WIDTH), 0.02),
        "k_a": 1.0 + nrm(ks[16], (L, RWKV_WIDTH), 0.02),
        "r_k": nrm(ks[17], (L, RWKV_HEADS, RWKV_HEAD), 0.1),
        "gn_g": 1.0 + nrm(ks[18], (L, RWKV_WIDTH), 0.01),
        "gn_b": nrm(ks[19], (L, RWKV_WIDTH), 0.01),
        "w_rwkv_out": nrm(ks[20], (L, RWKV_WIDTH, D), RWKV_WIDTH ** -0.5),
        "w_o": nrm(ks[21], (L, D, D), D ** -0.5),
        "g_ffn": 1.0 + nrm(ks[22], (L, D), 0.01),
        "w_q": nrm(ks[23], (L, D, PEER_HEADS * 2 * PEER_DHALF), D ** -0.5),
        "sub_keys": nrm(ks[24], (L, PEER_HEADS, 2, PEER_NKEYS, PEER_DHALF), PEER_DHALF ** -0.5),
        "expert_u": nrm(ks[25], (L, PEER_EXPERTS, D), D ** -0.5),
        "expert_v": nrm(ks[26], (L, PEER_EXPERTS, D), PEER_HEADS ** -0.5),
        "g_final": 1.0 + nrm(ks[27], (D,), 0.01),
    }


def reference(x, meta_tokens, g_mix, w_in, conv_w, conv_b, conv_ln_g, conv_ln_b, w_conv_out,
              mu_shift, w0, w_up, a0, a_up, g_up, k_k, k_a, r_k, gn_g, gn_b, w_rwkv_out,
              w_o, g_ffn, w_q, sub_keys, expert_u, expert_v, g_final):
    B = x.shape[0]
    meta = jnp.broadcast_to(meta_tokens[None].astype(x.dtype), (B, N_META, D_MODEL))
    h = jnp.concatenate([meta, x], axis=1)
    for l in range(DEPTH):
        z = rmsnorm(h, g_mix[l]) @ w_in[l]
        conv_val, conv_gate, rwkv_in, gate_logits = jnp.split(z, IN_SPLITS, axis=-1)
        y_a = conformer_conv(conv_val, conv_gate, conv_w[l], conv_b[l], conv_ln_g[l], conv_ln_b[l], w_conv_out[l])
        y_b = rwkv7_mix(rwkv_in, mu_shift[l], w0[l], w_up[l], a0[l], a_up[l], g_up[l],
                        k_k[l], k_a[l], r_k[l], gn_g[l], gn_b[l], w_rwkv_out[l])
        gate_a, gate_b = jnp.split(jax.nn.sigmoid(gate_logits), N_BRANCH, axis=-1)
        h = h + (gate_a * y_a + gate_b * y_b) @ w_o[l]
        h = h + peer_ffn(rmsnorm(h, g_ffn[l]), w_q[l], sub_keys[l], expert_u[l], expert_v[l])
    return rmsnorm(h, g_final)[:, N_META:]
```

```cpp
#include <hip/hip_runtime.h>
#include <hip/hip_cooperative_groups.h>
#include <cstdio>
#include <cstdint>
namespace cg = cooperative_groups;

#ifndef MK_ONE_LAUNCH
#define MK_ONE_LAUNCH 0
#endif

#define LAS __attribute__((address_space(3)))
#define LDS_WAIT() asm volatile("s_waitcnt lgkmcnt(0)" ::: "memory")

namespace pg8 {
#define PG8_LAS __attribute__((address_space(3)))
typedef unsigned short bf16_t;
typedef short bf16x8 __attribute__((ext_vector_type(8)));
typedef float f32x4 __attribute__((ext_vector_type(4)));
typedef unsigned u32x4 __attribute__((ext_vector_type(4)));
constexpr int BM = 256, BK = 64, HALF = 128, HTB = HALF * BK * 2  , STAGE_BYTES = 8 * HTB, NXCD = 8, WGM = 8;

__host__ __device__ __forceinline__ int lds_byte(int r, int c) { const int st = (r >> 4) * 2 + (c >> 5), rr = r & 15, cc = c & 31, ob = rr * 64 + cc * 2; return st * 1024 + (ob ^ (((ob >> 9) & 1) << 5)); }
__host__ __device__ __forceinline__ void stage_rc(int b, int& R, int& C) { const int st = b / 1024, sb = b % 1024, swz = sb ^ (((sb >> 9) & 1) << 5); R = (st >> 1) * 16 + swz / 64; C = (st & 1) * 32 + (swz % 64) / 2; }
__host__ __device__ __forceinline__ int perm32(int rho) { const int n = rho >> 4, i = rho & 15; return 8 * (i >> 2) + 4 * n + (i & 3); }

struct Unit { int pm, pn; };
struct Gemm { const bf16_t* A; const bf16_t* Bt; int M, N, K, lda, ldb; };

struct StaticOrder {
    int nM, nN, nwg, G, c;
    __host__ __device__ void init(int M, int N, int G_, int c_) { nM = M / BM; nN = N / BM; nwg = nM * nN; G = G_; c = c_; }
    __host__ __device__ bool next(int i, Unit& u) const {
        const long L = (long)i * G + c; if (L >= nwg) return false;
        int wgid = (int)L; { const int q = nwg / NXCD, r = nwg % NXCD, xcd = wgid % NXCD, off = wgid / NXCD; wgid = (xcd < r ? xcd * (q + 1) : r * (q + 1) + (xcd - r) * q) + off; }
        const int nig = WGM * nN, gid = wgid / nig, fm = gid * WGM, gsz = (nM - fm) < WGM ? (nM - fm) : WGM;
        u.pm = fm + ((wgid % nig) % gsz); u.pn = (wgid % nig) / gsz; return true;
    }
    __device__ __forceinline__ void a_ready(const Unit&) const {}
    __device__ __forceinline__ void done(const Unit&) const {}
};

__device__ __forceinline__ unsigned cvt_pk_bf16(float lo, float hi) { unsigned r; asm volatile("v_cvt_pk_bf16_f32 %0, %1, %2" : "=v"(r) : "v"(lo), "v"(hi)); return r; }
__device__ __forceinline__ void store8(bf16_t* p, const f32x4 v0, const f32x4 v1) {
    u32x4 w; w.x = cvt_pk_bf16(v0[0], v0[1]); w.y = cvt_pk_bf16(v0[2], v0[3]); w.z = cvt_pk_bf16(v1[0], v1[1]); w.w = cvt_pk_bf16(v1[2], v1[3]);
    *(u32x4*)p = w;
}
__device__ __forceinline__ float bflo(unsigned w) { return __builtin_bit_cast(float, w << 16); }
__device__ __forceinline__ float bfhi(unsigned w) { return __builtin_bit_cast(float, w & 0xffff0000u); }
__device__ __forceinline__ void load8(const bf16_t* p, f32x4& v0, f32x4& v1) {
    const u32x4 w = *(const u32x4*)p;
    v0 = (f32x4){bflo(w.x), bfhi(w.x), bflo(w.y), bfhi(w.y)}; v1 = (f32x4){bflo(w.z), bfhi(w.z), bflo(w.w), bfhi(w.w)};
}
__device__ __forceinline__ float sigm(float x) { return 1.f / (1.f + __expf(-x)); }
__device__ __forceinline__ void lane_ids(int& wr, int& wc, int& fr, int& fq) { int t = threadIdx.x; asm volatile("" : "+v"(t)); const int wid = t >> 6, lane = t & 63; wr = wid >> 2; wc = wid & 3; fr = lane & 15; fq = lane >> 4; }


struct EpiZ {
    static constexpr bool PERM = true, AFTER_DRAIN = false;
    bf16_t *Zc, *Zr, *Zg;
    __device__ __forceinline__ void operator()(const f32x4 (&acc)[2][2][4][2], const Unit& u, int, int, int, int) const {
        int wr, wc, fr, fq; lane_ids(wr, wc, fr, fq);
        bf16_t* base; int ldc, colt; const int pn = u.pn; bool sg = false;
        if (pn < 4) { base = Zc; ldc = 1024; colt = pn * 256; } else if (pn < 11) { base = Zr; ldc = 1792; colt = (pn - 4) * 256; } else { base = Zg; ldc = 2048; colt = (pn - 11) * 256; sg = true; }
        const int row0 = u.pm * BM + wr * 64 + fr, col0 = colt + wc * 32 + 8 * fq;
#pragma unroll
        for (int ai = 0; ai < 2; ++ai)
#pragma unroll
            for (int m = 0; m < 4; ++m) { bf16_t* rowp = base + (size_t)(row0 + ai * HALF + m * 16) * ldc + col0;
#pragma unroll
                for (int bj = 0; bj < 2; ++bj) { f32x4 v0 = acc[ai][bj][m][0], v1 = acc[ai][bj][m][1];
                    if (sg) {
#pragma unroll
                        for (int j = 0; j < 4; ++j) { v0[j] = sigm(v0[j]); v1[j] = sigm(v1[j]); } }
                    store8(rowp + bj * HALF, v0, v1); } }
    }
};

struct EpiSmall {
    static constexpr bool PERM = true, AFTER_DRAIN = false;
    const float *w0, *a0, *k_a; float* E; bf16_t *Kb, *Bb, *Gb; const bf16_t* KKb;
    __device__ __forceinline__ void operator()(const f32x4 (&acc)[2][2][4][2], const Unit& u, int, int, int, int) const {
        int wr, wc, fr, fq; lane_ids(wr, wc, fr, fq);
        const int pn = u.pn, kind = pn >> 1;
        const int row0 = u.pm * BM + wr * 64 + fr, col0 = (pn & 1) * 256 + wc * 32 + 8 * fq;
#pragma unroll
        for (int ai = 0; ai < 2; ++ai)
#pragma unroll
            for (int m = 0; m < 4; ++m) { const size_t rowoff = (size_t)(row0 + ai * HALF + m * 16) * 512;
#pragma unroll
                for (int bj = 0; bj < 2; ++bj) { const int c = col0 + bj * HALF; f32x4 v0 = acc[ai][bj][m][0], v1 = acc[ai][bj][m][1];
                    if (kind == 0) {
                        const f32x4 p0 = *(const f32x4*)(w0 + c), p1 = *(const f32x4*)(w0 + c + 4);
#pragma unroll
                        for (int j = 0; j < 4; ++j) { v0[j] = 0.60653065971f * sigm(p0[j] + v0[j]); v1[j] = 0.60653065971f * sigm(p1[j] + v1[j]); }
                        *(f32x4*)(E + rowoff + c) = v0; *(f32x4*)(E + rowoff + c + 4) = v1;
                    } else if (kind == 1) {
                        const f32x4 p0 = *(const f32x4*)(a0 + c), p1 = *(const f32x4*)(a0 + c + 4), q0 = *(const f32x4*)(k_a + c), q1 = *(const f32x4*)(k_a + c + 4);
                        f32x4 k0, k1, kk0, kk1; load8(Kb + rowoff + c, k0, k1); load8(KKb + rowoff + c, kk0, kk1);
                        f32x4 km0, km1, b0, b1;
#pragma unroll
                        for (int j = 0; j < 4; ++j) { const float a_0 = sigm(p0[j] + v0[j]), a_1 = sigm(p1[j] + v1[j]);
                            km0[j] = k0[j] * (1.f + (a_0 - 1.f) * q0[j]); km1[j] = k1[j] * (1.f + (a_1 - 1.f) * q1[j]); b0[j] = kk0[j] * a_0; b1[j] = kk1[j] * a_1; }
                        store8(Kb + rowoff + c, km0, km1); store8(Bb + rowoff + c, b0, b1);
                    } else {
                        store8(Gb + rowoff + c, v0, v1);
                    } } }
    }
};

__device__ __forceinline__ int mfull_of(int m2) { return m2 + 16 * ((m2 >> 12) + 1); }

template <int MODE> struct EpiMix {
    static constexpr bool PERM = true, AFTER_DRAIN = false;
    bf16_t* Mx; const bf16_t* Zg;
    __device__ __forceinline__ void operator()(const f32x4 (&acc)[2][2][4][2], const Unit& u, int, int, int, int) const {
        int wr, wc, fr, fq; lane_ids(wr, wc, fr, fq);
        const int row0 = u.pm * BM + wr * 64 + fr, col0 = u.pn * BM + wc * 32 + 8 * fq;
#pragma unroll
        for (int ai = 0; ai < 2; ++ai)
#pragma unroll
            for (int m = 0; m < 4; ++m) { const int row = row0 + ai * HALF + m * 16; const bf16_t* gp = Zg + (size_t)mfull_of(row) * 2048 + MODE * 1024 + col0; bf16_t* op = Mx + (size_t)row * 1024 + col0;
#pragma unroll
                for (int bj = 0; bj < 2; ++bj) { f32x4 g0, g1; load8(gp + bj * HALF, g0, g1); f32x4 v0 = acc[ai][bj][m][0] * g0, v1 = acc[ai][bj][m][1] * g1;
                    if (MODE == 1) { f32x4 o0, o1; load8(op + bj * HALF, o0, o1); v0 += o0; v1 += o1; }
                    store8(op + bj * HALF, v0, v1); } }
    }
};

struct EpiH1 {
    static constexpr bool PERM = true, AFTER_DRAIN = false;
    const float* X; float* H1; bf16_t* H1b; float* ssq;
    __device__ __forceinline__ void operator()(const f32x4 (&acc)[2][2][4][2], const Unit& u, int, int, int, int) const {
        int wr, wc, fr, fq; lane_ids(wr, wc, fr, fq);
        const int row0 = u.pm * BM + wr * 64 + fr, col0 = u.pn * BM + wc * 32 + 8 * fq;
#pragma unroll
        for (int ai = 0; ai < 2; ++ai)
#pragma unroll
            for (int m = 0; m < 4; ++m) { const int row = row0 + ai * HALF + m * 16; const size_t off = (size_t)row * 1024 + col0; float s = 0.f;
#pragma unroll
                for (int bj = 0; bj < 2; ++bj) { const f32x4 x0 = *(const f32x4*)(X + off + bj * HALF), x1 = *(const f32x4*)(X + off + bj * HALF + 4);
                    const f32x4 v0 = acc[ai][bj][m][0] + x0, v1 = acc[ai][bj][m][1] + x1;
                    *(f32x4*)(H1 + off + bj * HALF) = v0; *(f32x4*)(H1 + off + bj * HALF + 4) = v1; store8(H1b + off + bj * HALF, v0, v1);
                    s += (v0[0] * v0[0] + v0[1] * v0[1]) + (v0[2] * v0[2] + v0[3] * v0[3]) + (v1[0] * v1[0] + v1[1] * v1[1]) + (v1[2] * v1[2] + v1[3] * v1[3]); }
                s += __shfl_xor(s, 16); s += __shfl_xor(s, 32);
                if (fq == 0) atomicAdd(ssq + row, s); }
    }
};

struct EpiQ {
    static constexpr bool PERM = true, AFTER_DRAIN = false;
    bf16_t* Q; const float* ssq;
    __device__ __forceinline__ void operator()(const f32x4 (&acc)[2][2][4][2], const Unit& u, int, int, int, int) const {
        int wr, wc, fr, fq; lane_ids(wr, wc, fr, fq);
        const int row0 = u.pm * BM + wr * 64 + fr, col0 = u.pn * BM + wc * 32 + 8 * fq;
#pragma unroll
        for (int ai = 0; ai < 2; ++ai)
#pragma unroll
            for (int m = 0; m < 4; ++m) { const int row = row0 + ai * HALF + m * 16; const float rs = __builtin_amdgcn_rsqf(ssq[row] * (1.f / 1024.f) + 1e-6f); bf16_t* op = Q + (size_t)row * 2048 + col0;
#pragma unroll
                for (int bj = 0; bj < 2; ++bj) store8(op + bj * HALF, acc[ai][bj][m][0] * rs, acc[ai][bj][m][1] * rs); }
    }
};

template <class Epi, class Sched, bool ALIGN_EPI = false, bool SP2 = false>
__device__ __forceinline__ void gemm_phase(PG8_LAS unsigned char* lds, const Gemm g, const Sched& S, const Epi& E) {
    const int tid = threadIdx.x, wid = __builtin_amdgcn_readfirstlane(tid >> 6), lane = tid & 63, wr = wid >> 2, wc = wid & 3, fr = lane & 15, fq = lane >> 4;
    const int K = g.K, nt = K / BK;
    unsigned voffA[2], voffB[2];
#pragma unroll
    for (int i = 0; i < 2; ++i) { int R, C; stage_rc(tid * 16 + i * 8192, R, C); const int Rb = Epi::PERM ? ((R & ~31) + perm32(R & 31)) : R;
        voffA[i] = (unsigned)(R * g.lda + C) * 2u; voffB[i] = (unsigned)(Rb * g.ldb + C) * 2u; }
    const size_t kstep = (size_t)(BK * 2);
    const size_t hstepA = (size_t)HALF * g.lda * 2, hstepB = (size_t)HALF * g.ldb * 2;
    const size_t tstepA = 2 * hstepA, tstepB = 2 * hstepB;
    const unsigned ldsw = (unsigned)wid * 1024u;
    const int aoff = lds_byte(wr * 64 + fr, fq * 8), boff = lds_byte(wc * 32 + fr, fq * 8);
#define PG8_SA(b, h) (((b) * 2 + (h)) * HTB)
#define PG8_SB(b, h) ((4 + (b) * 2 + (h)) * HTB)
#define PG8_STAGE(bufoff, gbase, voff) do { _Pragma("unroll") for (int _i = 0; _i < 2; ++_i) \
        __builtin_amdgcn_global_load_lds((const unsigned*)((const char*)(gbase) + (voff)[_i]), (PG8_LAS unsigned*)(lds + (bufoff) + ldsw + _i * 8192), 16, 0, 0); } while (0)
#define PG8_LDA(dst, b, h) do { unsigned _ab = (unsigned)(PG8_SA(b, h) + aoff); asm volatile("" : "+v"(_ab)); _Pragma("unroll") for (int m = 0; m < 4; ++m) _Pragma("unroll") for (int k = 0; k < 2; ++k) dst[m][k] = *(const PG8_LAS bf16x8*)(lds + _ab + m * 2048 + k * 1024); } while (0)
#define PG8_LDB(dst, b, h) do { unsigned _bb = (unsigned)(PG8_SB(b, h) + boff); asm volatile("" : "+v"(_bb)); _Pragma("unroll") for (int n = 0; n < 2; ++n) _Pragma("unroll") for (int k = 0; k < 2; ++k) dst[n][k] = *(const PG8_LAS bf16x8*)(lds + _bb + n * 2048 + k * 1024); } while (0)
#define PG8_MMA(ai, bj, At, Bt) do { __builtin_amdgcn_s_setprio(1); _Pragma("unroll") for (int m = 0; m < 4; ++m) _Pragma("unroll") for (int n = 0; n < 2; ++n) _Pragma("unroll") for (int k = 0; k < 2; ++k) \
        acc[ai][bj][m][n] = __builtin_amdgcn_mfma_f32_16x16x32_bf16(Bt[n][k], At[m][k], acc[ai][bj][m][n], 0, 0, 0); __builtin_amdgcn_s_setprio(0); } while (0)
#define PG8_WAIT_V(n) asm volatile("s_waitcnt vmcnt(" #n ")" ::: "memory")
#define PG8_WAIT_L(n) asm volatile("s_waitcnt lgkmcnt(" #n ")" ::: "memory")
#define PG8_BAR __builtin_amdgcn_s_barrier()
#define PG8_SCHED __builtin_amdgcn_sched_barrier(0)
    Unit cur, nxt; int ui = 0;
    if (!S.next(0, cur)) return;
    f32x4 acc[2][2][4][2];
#pragma unroll
    for (int a = 0; a < 2; ++a)
#pragma unroll
        for (int b = 0; b < 2; ++b)
#pragma unroll
            for (int m = 0; m < 4; ++m)
#pragma unroll
                for (int n = 0; n < 2; ++n) acc[a][b][m][n] = (f32x4){0.f, 0.f, 0.f, 0.f};
    bf16x8 At[4][2], B0[2][2], B1[2][2];
    const char* cA = (const char*)g.A + (size_t)cur.pm * tstepA; const char* cB = (const char*)g.Bt + (size_t)cur.pn * tstepB;
    S.a_ready(cur);
    if constexpr (SP2) {
        PG8_STAGE(PG8_SB(0, 0), cB, voffB); PG8_STAGE(PG8_SB(0, 1), cB + hstepB, voffB); PG8_STAGE(PG8_SA(0, 0), cA, voffA); PG8_STAGE(PG8_SA(0, 1), cA + hstepA, voffA);
        if (wr == 1) PG8_BAR;
        PG8_WAIT_V(2); PG8_BAR;
        PG8_STAGE(PG8_SB(1, 0), cB + kstep, voffB); PG8_STAGE(PG8_SA(1, 0), cA + kstep, voffA); PG8_STAGE(PG8_SB(1, 1), cB + hstepB + kstep, voffB);
        PG8_WAIT_V(6); PG8_BAR;
    } else {
        PG8_STAGE(PG8_SB(0, 0), cB, voffB); PG8_STAGE(PG8_SA(0, 0), cA, voffA); PG8_STAGE(PG8_SB(0, 1), cB + hstepB, voffB); PG8_STAGE(PG8_SA(0, 1), cA + hstepA, voffA);
        if (wr == 1) PG8_BAR;
        PG8_WAIT_V(4); PG8_BAR;
        PG8_STAGE(PG8_SB(1, 0), cB + kstep, voffB); PG8_STAGE(PG8_SA(1, 0), cA + kstep, voffA); PG8_STAGE(PG8_SB(1, 1), cB + hstepB + kstep, voffB);
        PG8_WAIT_V(6); PG8_BAR;
    }
    for (;;) {
        const bool has_next = S.next(ui + 1, nxt);
        const char* nA = has_next ? (const char*)g.A + (size_t)nxt.pm * tstepA : cA; const char* nB = has_next ? (const char*)g.Bt + (size_t)nxt.pn * tstepB : cB;
        for (int t = 0; t < nt; t += 2) {
            const bool last = (t == nt - 2);
            const char* a1 = cA + (size_t)(t + 1) * kstep;
            const char* a2 = last ? nA : cA + (size_t)(t + 2) * kstep; const char* b2 = last ? nB : cB + (size_t)(t + 2) * kstep;
            const char* a3 = a2 + kstep; const char* b3 = b2 + kstep;
            if (last && has_next) S.a_ready(nxt);
            if constexpr (SP2) {
            PG8_LDB(B0, 0, 0); PG8_LDB(B1, 0, 1); PG8_SCHED; PG8_LDA(At, 0, 0); PG8_STAGE(PG8_SA(1, 1), a1 + hstepA, voffA);
            PG8_WAIT_V(8); PG8_WAIT_L(0); PG8_BAR; PG8_MMA(0, 0, At, B0); PG8_MMA(0, 1, At, B1); PG8_BAR; PG8_SCHED;
            PG8_LDA(At, 0, 1); PG8_STAGE(PG8_SB(0, 0), b2, voffB); PG8_STAGE(PG8_SB(0, 1), b2 + hstepB, voffB); PG8_STAGE(PG8_SA(0, 0), a2, voffA);
            PG8_WAIT_V(8); PG8_WAIT_L(0); PG8_BAR; PG8_MMA(1, 0, At, B0); PG8_MMA(1, 1, At, B1); PG8_BAR; PG8_SCHED;
            PG8_LDB(B0, 1, 0); PG8_LDB(B1, 1, 1); PG8_SCHED; PG8_LDA(At, 1, 0); PG8_STAGE(PG8_SA(0, 1), a2 + hstepA, voffA);
            PG8_WAIT_V(8); PG8_WAIT_L(0); PG8_BAR; PG8_MMA(0, 0, At, B0); PG8_MMA(0, 1, At, B1); PG8_BAR; PG8_SCHED;
            PG8_LDA(At, 1, 1); PG8_STAGE(PG8_SB(1, 0), b3, voffB); PG8_STAGE(PG8_SB(1, 1), b3 + hstepB, voffB); PG8_STAGE(PG8_SA(1, 0), a3, voffA);
            PG8_WAIT_V(8); PG8_WAIT_L(0); PG8_BAR; PG8_MMA(1, 0, At, B0); PG8_MMA(1, 1, At, B1); PG8_BAR; PG8_SCHED;
            } else {
            PG8_LDB(B0, 0, 0); PG8_SCHED; PG8_LDA(At, 0, 0); PG8_STAGE(PG8_SA(1, 1), a1 + hstepA, voffA);
            PG8_WAIT_L(8); PG8_BAR; PG8_WAIT_L(0); PG8_MMA(0, 0, At, B0); PG8_BAR; PG8_SCHED;
            PG8_LDB(B1, 0, 1); PG8_STAGE(PG8_SB(0, 0), b2, voffB);
            PG8_BAR; PG8_WAIT_L(0); PG8_MMA(0, 1, At, B1); PG8_BAR;
            PG8_LDA(At, 0, 1); PG8_STAGE(PG8_SA(0, 0), a2, voffA);
            PG8_BAR; PG8_WAIT_L(0); PG8_MMA(1, 0, At, B0); PG8_BAR; PG8_SCHED;
            PG8_STAGE(PG8_SB(0, 1), b2 + hstepB, voffB);
            PG8_WAIT_V(6); PG8_BAR; PG8_MMA(1, 1, At, B1); PG8_BAR;
            PG8_LDB(B0, 1, 0); PG8_SCHED; PG8_LDA(At, 1, 0); PG8_STAGE(PG8_SA(0, 1), a2 + hstepA, voffA);
            PG8_WAIT_L(8); PG8_BAR; PG8_WAIT_L(0); PG8_MMA(0, 0, At, B0); PG8_BAR; PG8_SCHED;
            PG8_LDB(B1, 1, 1); PG8_STAGE(PG8_SB(1, 0), b3, voffB);
            PG8_BAR; PG8_WAIT_L(0); PG8_MMA(0, 1, At, B1); PG8_BAR;
            PG8_LDA(At, 1, 1); PG8_STAGE(PG8_SA(1, 0), a3, voffA);
            PG8_BAR; PG8_WAIT_L(0); PG8_MMA(1, 0, At, B0); PG8_BAR; PG8_SCHED;
            PG8_STAGE(PG8_SB(1, 1), b3 + hstepB, voffB);
            PG8_WAIT_V(6); PG8_BAR; PG8_MMA(1, 1, At, B1); PG8_BAR;
            }
        }
        if constexpr (ALIGN_EPI) { if (wr == 0) PG8_BAR; }
        if constexpr (!Epi::AFTER_DRAIN) { E(acc, cur, wr, wc, fr, fq); S.done(cur); }
        if (!has_next) break;
#pragma unroll
        for (int a = 0; a < 2; ++a)
#pragma unroll
            for (int b = 0; b < 2; ++b)
#pragma unroll
                for (int m = 0; m < 4; ++m)
#pragma unroll
                    for (int n = 0; n < 2; ++n) acc[a][b][m][n] = (f32x4){0.f, 0.f, 0.f, 0.f};
        cur = nxt; cA = nA; cB = nB; ++ui;
        if constexpr (ALIGN_EPI) { if (wr == 1) PG8_BAR; }
    }
    PG8_WAIT_V(0);
    if constexpr (!ALIGN_EPI) { if (wr == 0) PG8_BAR; }
    PG8_BAR;
    if constexpr (Epi::AFTER_DRAIN) { E.fused(acc, cur, wr, wc, fr, fq, lds, wid, lane); S.done(cur); }
#undef PG8_SA
#undef PG8_SB
#undef PG8_STAGE
#undef PG8_LDA
#undef PG8_LDB
#undef PG8_MMA
#undef PG8_WAIT_V
#undef PG8_WAIT_L
#undef PG8_BAR
#undef PG8_SCHED
}
}

typedef pg8::bf16_t bf16_t;
typedef pg8::f32x4 f32x4;
typedef pg8::u32x4 u32x4;
typedef pg8::bf16x8 bf16x8;
typedef unsigned u32x2 __attribute__((ext_vector_type(2)));
using pg8::bflo; using pg8::bfhi; using pg8::cvt_pk_bf16; using pg8::sigm; using pg8::load8; using pg8::store8;

constexpr int D = 1024, NB = 8, SEQ = 4096, NMETA = 16, T = SEQ + NMETA  , MT = NB * T  , MP = 33024  , M2 = NB * SEQ  ;
constexpr int INTOT = 4864, CCH = 512, RWW = 512, RWIN = 1792, NHEAD = 8;
constexpr int PH = 8, PK = 128, PDH = 128, PTOPK = 16, NEXP = 16384;
constexpr int NWAVES = 8, NTHR = 512;
constexpr int LDS_BYTES = 147456;

constexpr size_t MiB = 1u << 20;
constexpr size_t WS_CTL = 0, CTL_ZERO_BYTES = 1 * MiB;
constexpr size_t WS_SSQ = 256 * 1024;
constexpr size_t WS_WIN = 1 * MiB;
constexpr size_t WS_WCR = 11 * MiB;
constexpr size_t WS_WO = 13 * MiB;
constexpr size_t WS_WQ = 15 * MiB;
constexpr size_t WS_SK = 19 * MiB;
constexpr size_t WS_WSM = 19 * MiB + 512 * 1024;
constexpr size_t WS_EU = 21 * MiB, WS_EV = 53 * MiB;
constexpr size_t WS_XN = 85 * MiB;
constexpr size_t WS_ZG = 150 * MiB;
constexpr size_t WS_ZR = 279 * MiB;
constexpr size_t WS_ZC = 392 * MiB;
constexpr size_t WS_KK = 457 * MiB;
constexpr size_t WS_A2 = 490 * MiB;
constexpr size_t WS_END = 507 * MiB;

struct Args { const float* in[28]; float* out; unsigned char* ws; int ph_lo, ph_hi; };

__device__ __forceinline__ float dpp_f(float x, const int ctrl_sel) { return x; }
#define DPP_ADD(x, ctrl) ((x) + __builtin_bit_cast(float, __builtin_amdgcn_update_dpp(0, __builtin_bit_cast(int, (x)), (ctrl), 0xf, 0xf, true)))
__device__ __forceinline__ float red8(float x) {
    x = DPP_ADD(x, 0xB1); x = DPP_ADD(x, 0x4E); x = DPP_ADD(x, 0x141); return x;
}
__device__ __forceinline__ float red16(float x) { x = red8(x); x = DPP_ADD(x, 0x140); return x; }
__device__ __forceinline__ float wave_sum(float x) {
    x = red16(x);
    const int xi = __builtin_bit_cast(int, x);
    const float a = __builtin_bit_cast(float, __builtin_amdgcn_readlane(xi, 0)), b = __builtin_bit_cast(float, __builtin_amdgcn_readlane(xi, 16)), c = __builtin_bit_cast(float, __builtin_amdgcn_readlane(xi, 32)), d = __builtin_bit_cast(float, __builtin_amdgcn_readlane(xi, 48));
    return (a + b) + (c + d);
}

__device__ __forceinline__ void p0_transpose_item(const float* W, int ldw, bf16_t* WT, int ldt, int koff, const float* kscale, int nblk, LAS float* scr, int item, int lane) {
    const int kb = item / nblk, nb = item % nblk, k0 = 64 * kb, n0 = 32 * nb;
#pragma unroll 8
    for (int i = 0; i < 32; ++i) { const int kk = 2 * i + (lane >> 5); float w = W[(size_t)(k0 + kk) * ldw + n0 + (lane & 31)]; if (kscale) w *= kscale[k0 + kk]; scr[kk * 33 + (lane & 31)] = w; }
    LDS_WAIT(); asm volatile("" ::: "memory");
    const int c = lane & 7;
#pragma unroll
    for (int j = 0; j < 4; ++j) { const int n = (lane >> 3) + 8 * j; const LAS float* s = scr + (8 * c) * 33 + n;
        u32x4 o; o.x = cvt_pk_bf16(s[0 * 33], s[1 * 33]); o.y = cvt_pk_bf16(s[2 * 33], s[3 * 33]); o.z = cvt_pk_bf16(s[4 * 33], s[5 * 33]); o.w = cvt_pk_bf16(s[6 * 33], s[7 * 33]);
        *(u32x4*)(WT + (size_t)(n0 + n) * ldt + koff + k0 + 8 * c) = o; }
    LDS_WAIT(); asm volatile("" ::: "memory");
}

__device__ __forceinline__ void p0_prologue(const Args& a, LAS unsigned char* lds, int G) {
    const int tid = threadIdx.x, lane = tid & 63, wave = __builtin_amdgcn_readfirstlane(tid >> 6);
    unsigned char* ws = a.ws;
    LAS float* scr = (LAS float*)(lds + wave * 16384);
    const int gw = blockIdx.x * NWAVES + wave, NGW = G * NWAVES;
    const int gt = blockIdx.x * NTHR + tid, NGT = G * NTHR;
    constexpr int I_IN = (1024 / 64) * (INTOT / 32), I_C = (512 / 64) * (1024 / 32), I_O = (1024 / 64) * (1024 / 32), I_Q = (1024 / 64) * (2048 / 32);
    constexpr int NITEMS = I_IN + 2 * I_C + I_O + I_Q;
    for (int it = gw; it < NITEMS; it += NGW) {
        int r = it;
        if (r < I_IN) { p0_transpose_item(a.in[3], INTOT, (bf16_t*)(ws + WS_WIN), 1024, 0, nullptr, INTOT / 32, scr, r, lane); continue; } r -= I_IN;
        if (r < I_C) { p0_transpose_item(a.in[8], 1024, (bf16_t*)(ws + WS_WCR), 1024, 0, nullptr, 32, scr, r, lane); continue; } r -= I_C;
        if (r < I_C) { p0_transpose_item(a.in[20], 1024, (bf16_t*)(ws + WS_WCR), 1024, 512, nullptr, 32, scr, r, lane); continue; } r -= I_C;
        if (r < I_O) { p0_transpose_item(a.in[21], 1024, (bf16_t*)(ws + WS_WO), 1024, 0, nullptr, 32, scr, r, lane); continue; } r -= I_O;
        p0_transpose_item(a.in[23], 2048, (bf16_t*)(ws + WS_WQ), 1024, 0, a.in[22], 64, scr, r, lane);
    }
    { const float* sk = a.in[24]; bf16_t* o = (bf16_t*)(ws + WS_SK);
      for (int i = gt; i < 16 * 128 * 128 / 8; i += NGT) { const f32x4 x0 = *(const f32x4*)(sk + (size_t)i * 8), x1 = *(const f32x4*)(sk + (size_t)i * 8 + 4); store8(o + (size_t)i * 8, x0, x1); } }
    { const float* w_up = a.in[11]; const float* a_up = a.in[13]; const float* g_up = a.in[14]; bf16_t* o = (bf16_t*)(ws + WS_WSM);
      for (int i = gt; i < 1536 * 32; i += NGT) { const int n = i >> 5, k8 = (i & 31) * 8; float v[8];
#pragma unroll
          for (int j = 0; j < 8; ++j) { const int k = k8 + j; float x = 0.f;
              if (n < 512) { if (k < 64) x = w_up[k * 512 + n]; }
              else if (n < 1024) { if (k >= 64 && k < 128) x = a_up[(k - 64) * 512 + (n - 512)]; }
              else { if (k >= 128) x = g_up[(k - 128) * 512 + (n - 1024)]; }
              v[j] = x; }
          store8(o + (size_t)n * 256 + k8, (f32x4){v[0], v[1], v[2], v[3]}, (f32x4){v[4], v[5], v[6], v[7]}); } }
    { const float* eu = a.in[25]; const float* ev = a.in[26]; const float* gf = a.in[22]; bf16_t* ou = (bf16_t*)(ws + WS_EU); bf16_t* ov = (bf16_t*)(ws + WS_EV);
      for (int i = gt; i < NEXP * 1024 / 8; i += NGT) { const size_t e = (size_t)i * 8; const int k = (int)(e & 1023);
          const f32x4 g0 = *(const f32x4*)(gf + k), g1 = *(const f32x4*)(gf + k + 4);
          const f32x4 u0 = *(const f32x4*)(eu + e), u1 = *(const f32x4*)(eu + e + 4); store8(ou + e, u0 * g0, u1 * g1);
          const f32x4 v0 = *(const f32x4*)(ev + e), v1 = *(const f32x4*)(ev + e + 4); store8(ov + e, v0, v1); } }
    { const float* x = a.in[0]; const float* meta = a.in[1]; const float* gm = a.in[2]; bf16_t* XN = (bf16_t*)(ws + WS_XN);
      for (int m = gw; m < MP; m += NGW) {
          bf16_t* o = XN + (size_t)m * 1024;
          if (m >= MT) { const u32x4 z = {0u, 0u, 0u, 0u}; ((u32x4*)o)[lane] = z; ((u32x4*)o)[lane + 64] = z; continue; }
          const int b = m / T, t = m - b * T;
          const float* src = (t < NMETA) ? meta + (size_t)t * 1024 : x + ((size_t)b * SEQ + (t - NMETA)) * 1024;
          f32x4 v[4]; float s = 0.f;
#pragma unroll
          for (int j = 0; j < 4; ++j) { v[j] = ((const f32x4*)src)[lane + 64 * j]; s += (v[j][0] * v[j][0] + v[j][1] * v[j][1]) + (v[j][2] * v[j][2] + v[j][3] * v[j][3]); }
          const float rs = 1.f / sqrtf(wave_sum(s) * (1.f / 1024.f) + 1e-6f);
#pragma unroll
          for (int j = 0; j < 4; ++j) { const f32x4 g = ((const f32x4*)gm)[lane + 64 * j]; const f32x4 y = v[j] * rs * g;
              u32x2 w; w.x = cvt_pk_bf16(y[0], y[1]); w.y = cvt_pk_bf16(y[2], y[3]); ((u32x2*)o)[lane + 64 * j] = w; }
      } }
}

__device__ __forceinline__ void p2_conv(const Args& a, LAS unsigned char* lds, int G) {
    const int tid = threadIdx.x, lane = tid & 63, wave = __builtin_amdgcn_readfirstlane(tid >> 6);
    const bf16_t* Zc = (const bf16_t*)(a.ws + WS_ZC); bf16_t* AC = (bf16_t*)(a.ws + WS_XN);
    const float* conv_w = a.in[4]; const float* conv_b = a.in[5]; const float* ln_g = a.in[6]; const float* ln_b = a.in[7];
    LAS float* yl = (LAS float*)lds;
    constexpr int CT = 32, TPB = (T + CT - 1) / CT;
    const int c = tid;
    float w[31];
#pragma unroll
    for (int j = 0; j < 31; ++j) w[j] = conv_w[j * 512 + c];
    const float bias = conv_b[c];
    for (int it = blockIdx.x; it < NB * TPB; it += G) {
        const int b = it / TPB, t0 = (it - b * TPB) * CT;
        float u[CT + 30];
#pragma unroll
        for (int s = 0; s < CT + 30; ++s) {
            const int ti = t0 - 30 + s; float uu = 0.f;
            if (ti >= 0 && ti < T) { const bf16_t* row = Zc + (size_t)(b * T + ti) * 1024; const float val = __builtin_bit_cast(float, (unsigned)row[c] << 16), gt = __builtin_bit_cast(float, (unsigned)row[512 + c] << 16); uu = val * sigm(gt); }
            u[s] = uu;
        }
#pragma unroll
        for (int o = 0; o < CT; ++o) {
            float acc = bias;
#pragma unroll
            for (int j = 0; j < 31; ++j) acc = fmaf(w[j], u[o + j], acc);
            yl[o * 512 + c] = acc;
        }
        __syncthreads();
#pragma unroll
        for (int q = 0; q < 4; ++q) {
            const int o = wave * 4 + q, t = t0 + o;
            if (t >= NMETA && t < T) {
                const f32x4 y0 = *(const LAS f32x4*)(yl + o * 512 + 8 * lane), y1 = *(const LAS f32x4*)(yl + o * 512 + 8 * lane + 4);
                const float mean = wave_sum((y0[0] + y0[1]) + (y0[2] + y0[3]) + (y1[0] + y1[1]) + (y1[2] + y1[3])) * (1.f / 512.f);
                const f32x4 d0 = y0 - mean, d1 = y1 - mean;
                const float var = wave_sum((d0[0] * d0[0] + d0[1] * d0[1]) + (d0[2] * d0[2] + d0[3] * d0[3]) + (d1[0] * d1[0] + d1[1] * d1[1]) + (d1[2] * d1[2] + d1[3] * d1[3])) * (1.f / 512.f);
                const float rstd = 1.f / sqrtf(var + 1e-5f);
                const f32x4 g0 = *(const f32x4*)(ln_g + 8 * lane), g1 = *(const f32x4*)(ln_g + 8 * lane + 4), b0 = *(const f32x4*)(ln_b + 8 * lane), b1 = *(const f32x4*)(ln_b + 8 * lane + 4);
                f32x4 z0 = d0 * rstd * g0 + b0, z1 = d1 * rstd * g1 + b1;
#pragma unroll
                for (int j = 0; j < 4; ++j) { z0[j] = z0[j] * sigm(z0[j]); z1[j] = z1[j] * sigm(z1[j]); }
                store8(AC + ((size_t)b * SEQ + (t - NMETA)) * 1024 + 8 * lane, z0, z1);
            }
        }
        __syncthreads();
    }
}

__device__ __forceinline__ void p2_rwkv(const Args& a, int G) {
    const int tid = threadIdx.x, lane = tid & 63, wave = __builtin_amdgcn_readfirstlane(tid >> 6);
    const bf16_t* Zr = (const bf16_t*)(a.ws + WS_ZR);
    bf16_t* Rb = (bf16_t*)a.out; bf16_t* Vb = (bf16_t*)((unsigned char*)a.out + 33 * MiB); bf16_t* Kb = (bf16_t*)((unsigned char*)a.out + 66 * MiB);
    bf16_t* KKb = (bf16_t*)(a.ws + WS_KK); bf16_t* A2 = (bf16_t*)(a.ws + WS_A2);
    const float* mu = a.in[9]; const float* k_k = a.in[15];
    const int gw = blockIdx.x * NWAVES + wave, NGW = G * NWAVES;
    for (int m = gw; m < MT; m += NGW) {
        const int b = m / T, t = m - b * T;
        const bf16_t* cur = Zr + (size_t)m * RWIN; const bf16_t* prv = cur - RWIN; const bool hp = (t > 0);
#pragma unroll
        for (int s = 0; s < 3; ++s) {
            const int c = s * 512 + 8 * lane;
            f32x4 c0, c1, p0 = {0.f, 0.f, 0.f, 0.f}, p1 = {0.f, 0.f, 0.f, 0.f}; load8(cur + c, c0, c1); if (hp) load8(prv + c, p0, p1);
            const f32x4 m0 = *(const f32x4*)(mu + c), m1 = *(const f32x4*)(mu + c + 4);
            const f32x4 z0 = c0 + (p0 - c0) * m0, z1 = c1 + (p1 - c1) * m1;
            if (s == 0) store8(Rb + (size_t)m * 512 + 8 * lane, z0, z1);
            else if (s == 2) store8(Vb + (size_t)m * 512 + 8 * lane, z0, z1);
            else {
                store8(Kb + (size_t)m * 512 + 8 * lane, z0, z1);
                const f32x4 q0 = *(const f32x4*)(k_k + 8 * lane), q1 = *(const f32x4*)(k_k + 8 * lane + 4);
                const f32x4 k0 = z0 * q0, k1 = z1 * q1;
                float ss = (k0[0] * k0[0] + k0[1] * k0[1]) + (k0[2] * k0[2] + k0[3] * k0[3]) + (k1[0] * k1[0] + k1[1] * k1[1]) + (k1[2] * k1[2] + k1[3] * k1[3]);
                ss = red8(ss);
                const float rn = 1.f / sqrtf(fmaxf(ss, 1e-24f));
                store8(KKb + (size_t)m * 512 + 8 * lane, k0 * rn, k1 * rn);
            }
        }
        {
            const int c = 1536 + 4 * lane;
            const u32x2 cw = *(const u32x2*)(cur + c); u32x2 pw = {0u, 0u}; if (hp) pw = *(const u32x2*)(prv + c);
            const f32x4 cv = {bflo(cw.x), bfhi(cw.x), bflo(cw.y), bfhi(cw.y)}, pv = {bflo(pw.x), bfhi(pw.x), bflo(pw.y), bfhi(pw.y)};
            const f32x4 mv = *(const f32x4*)(mu + c);
            f32x4 z = cv + (pv - cv) * mv;
#pragma unroll
            for (int j = 0; j < 4; ++j) { if (lane < 16) z[j] = tanhf(z[j]); else if (lane >= 32) z[j] = sigm(z[j]); }
            u32x2 w; w.x = cvt_pk_bf16(z[0], z[1]); w.y = cvt_pk_bf16(z[2], z[3]); *(u32x2*)(A2 + (size_t)m * 256 + 4 * lane) = w;
        }
    }
}

__device__ __forceinline__ void p4_scan(const Args& a, LAS unsigned char* lds, int G) {
    const int tid = threadIdx.x, lane = tid & 63, wave = __builtin_amdgcn_readfirstlane(tid >> 6);
    const bf16_t* Rb = (const bf16_t*)a.out; const bf16_t* Vb = (const bf16_t*)((unsigned char*)a.out + 33 * MiB); const bf16_t* Kb = (const bf16_t*)((unsigned char*)a.out + 66 * MiB);
    const bf16_t* KKb = (const bf16_t*)(a.ws + WS_KK); const bf16_t* Bb = (const bf16_t*)(a.ws + WS_ZR); const bf16_t* Gb = (const bf16_t*)(a.ws + WS_ZR + 33 * MiB);
    const float* E = (const float*)(a.ws + WS_ZC); bf16_t* AC = (bf16_t*)(a.ws + WS_XN);
    const float* r_k = a.in[17]; const float* gn_g = a.in[18]; const float* gn_b = a.in[19];
    constexpr int CH = 16, NCH = T / CH;
    constexpr int STEPF = 6 * 64;
    LAS float* buf0 = (LAS float*)lds; LAS float* buf1 = buf0 + CH * STEPF; LAS float* obuf = buf1 + CH * STEPF;
    const int r8 = lane >> 3, ko = lane & 7, vrow = wave * 8 + r8;
    for (int it = blockIdx.x; it < NB * NHEAD; it += G) {
        const int b = it >> 3, h = it & 7;
        const size_t mbase = (size_t)b * T;
        float S[8];
#pragma unroll
        for (int i = 0; i < 8; ++i) S[i] = 0.f;
        u32x4 ld[2];
        auto issue = [&](int ch) {
#pragma unroll
            for (int i = 0; i < 2; ++i) { const int p = tid + i * 512; if (p < CH * 56) { const int st = p / 56, q = p - st * 56; const size_t row = mbase + (size_t)ch * CH + st;
                const unsigned char* src;
                if (q < 40) { const int arr = q >> 3, e8 = (q & 7) * 8; const bf16_t* base = (arr == 0) ? KKb : (arr == 1) ? Bb : (arr == 2) ? Kb : (arr == 3) ? Rb : Vb; src = (const unsigned char*)(base + row * 512 + h * 64 + e8); }
                else { src = (const unsigned char*)(E + row * 512 + h * 64 + (q - 40) * 4); }
                ld[i] = *(const u32x4*)src; } }
        };
        auto commit = [&](LAS float* buf) {
#pragma unroll
            for (int i = 0; i < 2; ++i) { const int p = tid + i * 512; if (p < CH * 56) { const int st = p / 56, q = p - st * 56; LAS float* dst = buf + st * STEPF;
                if (q < 40) { const int arr = q >> 3, e8 = (q & 7) * 8; const u32x4 w = ld[i];
                    *(LAS f32x4*)(dst + (arr + 1) * 64 + e8) = (f32x4){bflo(w.x), bfhi(w.x), bflo(w.y), bfhi(w.y)}; *(LAS f32x4*)(dst + (arr + 1) * 64 + e8 + 4) = (f32x4){bflo(w.z), bfhi(w.z), bflo(w.w), bfhi(w.w)}; }
                else { const f32x4 e = __builtin_bit_cast(f32x4, ld[i]); *(LAS f32x4*)(dst + (q - 40) * 4) = (f32x4){__expf(-e[0]), __expf(-e[1]), __expf(-e[2]), __expf(-e[3])}; } } }
        };
        issue(0); commit(buf0); __syncthreads();
        for (int ch = 0; ch < NCH; ++ch) {
            LAS float* cur = (ch & 1) ? buf1 : buf0; LAS float* nxt = (ch & 1) ? buf0 : buf1;
            if (ch + 1 < NCH) issue(ch + 1);
#pragma unroll 4
            for (int st = 0; st < CH; ++st) {
                const LAS float* sp = cur + st * STEPF;
                const f32x4 w0 = *(const LAS f32x4*)(sp + 0 * 64 + 8 * ko), w1 = *(const LAS f32x4*)(sp + 0 * 64 + 8 * ko + 4);
                const f32x4 k0 = *(const LAS f32x4*)(sp + 1 * 64 + 8 * ko), k1 = *(const LAS f32x4*)(sp + 1 * 64 + 8 * ko + 4);
                const f32x4 b0 = *(const LAS f32x4*)(sp + 2 * 64 + 8 * ko), b1 = *(const LAS f32x4*)(sp + 2 * 64 + 8 * ko + 4);
                const f32x4 m0 = *(const LAS f32x4*)(sp + 3 * 64 + 8 * ko), m1 = *(const LAS f32x4*)(sp + 3 * 64 + 8 * ko + 4);
                const f32x4 q0 = *(const LAS f32x4*)(sp + 4 * 64 + 8 * ko), q1 = *(const LAS f32x4*)(sp + 4 * 64 + 8 * ko + 4);
                const float vv = sp[5 * 64 + vrow];
                float sa = 0.f;
#pragma unroll
                for (int i = 0; i < 4; ++i) { sa = fmaf(S[i], k0[i], sa); sa = fmaf(S[4 + i], k1[i], sa); }
                sa = red8(sa);
                float o = 0.f;
#pragma unroll
                for (int i = 0; i < 4; ++i) {
                    S[i] = fmaf(S[i], w0[i], fmaf(vv, m0[i], -sa * b0[i])); S[4 + i] = fmaf(S[4 + i], w1[i], fmaf(vv, m1[i], -sa * b1[i]));
                    o = fmaf(S[i], q0[i], o); o = fmaf(S[4 + i], q1[i], o); }
                o = red8(o);
                if (ko == 0) obuf[st * 64 + vrow] = o;
            }
            __syncthreads();
#pragma unroll
            for (int q = 0; q < 2; ++q) {
                const int st = wave * 2 + q, t = ch * CH + st; const LAS float* sp = cur + st * STEPF;
                const float o = obuf[st * 64 + lane];
                const float mean = wave_sum(o) * (1.f / 64.f); const float d = o - mean; const float var = wave_sum(d * d) * (1.f / 64.f);
                const float rk = wave_sum(sp[4 * 64 + lane] * sp[3 * 64 + lane] * r_k[h * 64 + lane]);
                if (t >= NMETA) {
                    const float g = __builtin_bit_cast(float, (unsigned)Gb[(mbase + t) * 512 + h * 64 + lane] << 16);
                    const float res = (d * (1.f / sqrtf(var + 64e-5f)) * gn_g[h * 64 + lane] + gn_b[h * 64 + lane] + rk * sp[5 * 64 + lane]) * g;
                    AC[((size_t)b * SEQ + (t - NMETA)) * 1024 + 512 + h * 64 + lane] = (bf16_t)(cvt_pk_bf16(res, 0.f) & 0xffffu);
                }
            }
            if (ch + 1 < NCH) commit(nxt);
            __syncthreads();
        }
    }
}

#define CE_DESC(x, y) do { const float _hi = fmaxf((x), (y)), _lo = fminf((x), (y)); (x) = _hi; (y) = _lo; } while (0)
__device__ __forceinline__ void sort16_desc(float (&v)[16]) {
#pragma unroll
    for (int k = 2; k <= 16; k <<= 1) {
#pragma unroll
        for (int j = k >> 1; j > 0; j >>= 1) {
#pragma unroll
            for (int i = 0; i < 16; ++i) { const int l = i ^ j; if (l > i) { if ((i & k) == 0) CE_DESC(v[i], v[l]); else CE_DESC(v[l], v[i]); } }
        }
    }
}
__device__ __forceinline__ void merge16(float (&x)[16], const float (&y)[16]) {
#pragma unroll
    for (int i = 0; i < 16; ++i) x[i] = fmaxf(x[i], y[15 - i]);
#pragma unroll
    for (int j = 8; j > 0; j >>= 1) {
#pragma unroll
        for (int i = 0; i < 16; ++i) { const int l = i ^ j; if (l > i) CE_DESC(x[i], x[l]); }
    }
}
__device__ __forceinline__ void xmerge16(float (&x)[16], int mask) {
    float y[16];
#pragma unroll
    for (int i = 0; i < 16; ++i) y[i] = __shfl_xor(x[i], mask);
    merge16(x, y);
}
__device__ __forceinline__ float pk_low(float x, unsigned code, unsigned keep_mask) { return __builtin_bit_cast(float, (__builtin_bit_cast(unsigned, x) & keep_mask) | code); }

__device__ __forceinline__ void p9_topk(const Args& a, LAS unsigned char* lds, int G) {
    const int tid = threadIdx.x, lane = tid & 63, wave = __builtin_amdgcn_readfirstlane(tid >> 6);
    const bf16_t* Q = (const bf16_t*)(a.ws + WS_ZG); const bf16_t* SK = (const bf16_t*)(a.ws + WS_SK);
    int* TKid = (int*)(a.ws + WS_KK); float* TKg = (float*)(a.ws + WS_KK + 16 * MiB);
    LAS unsigned char* wl = lds + wave * 512;
    const int fr = lane & 15, fq = lane >> 4;
    const int gw = blockIdx.x * NWAVES + wave, NGW = G * NWAVES;
    constexpr int NUNITS = (M2 / 16) * PH;
    for (int un = gw; un < NUNITS; un += NGW) {
        const int h = un & 7, tok0 = (un >> 3) * 16;
        float top[2][16];
#pragma unroll
        for (int c = 0; c < 2; ++c) {
            f32x4 acc[8];
#pragma unroll
            for (int nt = 0; nt < 8; ++nt) acc[nt] = (f32x4){0.f, 0.f, 0.f, 0.f};
            const bf16_t* qrow = Q + (size_t)(tok0 + fr) * 2048 + h * 256 + c * 128 + fq * 8;
            bf16x8 qf[4];
#pragma unroll
            for (int ks = 0; ks < 4; ++ks) qf[ks] = *(const bf16x8*)(qrow + ks * 32);
            const bf16_t* skb = SK + (size_t)((h * 2 + c) * 128) * 128 + (size_t)fr * 128 + fq * 8;
#pragma unroll
            for (int nt = 0; nt < 8; ++nt)
#pragma unroll
                for (int ks = 0; ks < 4; ++ks) { const bf16x8 kf = *(const bf16x8*)(skb + (size_t)nt * 16 * 128 + ks * 32);
                    acc[nt] = __builtin_amdgcn_mfma_f32_16x16x32_bf16(kf, qf[ks], acc[nt], 0, 0, 0); }
            float lo[16], hi[16];
#pragma unroll
            for (int nt = 0; nt < 4; ++nt)
#pragma unroll
                for (int r = 0; r < 4; ++r) { lo[nt * 4 + r] = pk_low(acc[nt][r], (unsigned)(16 * nt + 4 * fq + r), 0xffffff80u); hi[nt * 4 + r] = pk_low(acc[nt + 4][r], (unsigned)(16 * (nt + 4) + 4 * fq + r), 0xffffff80u); }
            sort16_desc(lo); sort16_desc(hi); merge16(lo, hi); xmerge16(lo, 16); xmerge16(lo, 32);
#pragma unroll
            for (int i = 0; i < 16; ++i) top[c][i] = lo[i];
        }
        float cand[16];
        const float PAD = -3.0e38f;
#pragma unroll
        for (int s = 0; s < 16; ++s) {
            const int i1 = (s < 8) ? 1 : (s < 13) ? 2 : 4, j1 = (s < 8) ? s : (s < 13) ? s - 8 : s - 13;
            const int i2 = (s < 4) ? 3 : (s < 6) ? 5 : (s < 8) ? 6 : 7, j2 = (s < 4) ? s : (s < 6) ? s - 4 : (s < 8) ? s - 6 : s - 8;
            const float c0 = pk_low(top[0][0] + top[1][s], (unsigned)s, 0xffffff00u);
            const float c1 = pk_low(top[0][i1] + top[1][j1], (unsigned)(i1 * 16 + j1), 0xffffff00u);
            const float c2 = (s < 10) ? pk_low(top[0][i2] + top[1][j2], (unsigned)(i2 * 16 + j2), 0xffffff00u) : PAD;
            const float c3 = (s < 8) ? pk_low(top[0][8 + s] + top[1][0], (unsigned)((8 + s) * 16), 0xffffff00u) : PAD;
            cand[s] = (fq == 0) ? c0 : (fq == 1) ? c1 : (fq == 2) ? c2 : c3;
        }
        sort16_desc(cand); xmerge16(cand, 16); xmerge16(cand, 32);
        if (fq == 0) {
            u32x4 wa, wb; unsigned pa[4], pb[4];
#pragma unroll
            for (int g = 0; g < 4; ++g) { pa[g] = 0u; pb[g] = 0u;
#pragma unroll
                for (int j = 0; j < 4; ++j) { pa[g] |= (__builtin_bit_cast(unsigned, top[0][4 * g + j]) & 0x7fu) << (8 * j); pb[g] |= (__builtin_bit_cast(unsigned, top[1][4 * g + j]) & 0x7fu) << (8 * j); } }
            wa.x = pa[0]; wa.y = pa[1]; wa.z = pa[2]; wa.w = pa[3]; wb.x = pb[0]; wb.y = pb[1]; wb.z = pb[2]; wb.w = pb[3];
            *(LAS u32x4*)(wl + fr * 32) = wa; *(LAS u32x4*)(wl + fr * 32 + 16) = wb;
            LDS_WAIT();
            float p[16], sum = 0.f; int eid[16];
            const float mx = cand[0];
#pragma unroll
            for (int i = 0; i < 16; ++i) { p[i] = __expf(cand[i] - mx); sum += p[i];
                const unsigned code = __builtin_bit_cast(unsigned, cand[i]) & 0xffu;
                const int i1 = wl[fr * 32 + (code >> 4)], i2 = wl[fr * 32 + 16 + (code & 15u)];
                eid[i] = i1 * PK + i2; }
            const float inv = 1.f / sum;
            int* ip = TKid + (size_t)(tok0 + fr) * 128 + h * 16; float* gp = TKg + (size_t)(tok0 + fr) * 128 + h * 16;
#pragma unroll
            for (int g = 0; g < 4; ++g) { *(int4*)(ip + 4 * g) = make_int4(eid[4 * g], eid[4 * g + 1], eid[4 * g + 2], eid[4 * g + 3]);
                *(f32x4*)(gp + 4 * g) = (f32x4){p[4 * g] * inv, p[4 * g + 1] * inv, p[4 * g + 2] * inv, p[4 * g + 3] * inv}; }
            LDS_WAIT();
        }
    }
}

typedef __bf16 bf16v2 __attribute__((ext_vector_type(2)));
__device__ __forceinline__ float dot2bf(unsigned x, unsigned y, float acc) { return __builtin_amdgcn_fdot2_f32_bf16(__builtin_bit_cast(bf16v2, x), __builtin_bit_cast(bf16v2, y), acc, false); }
__device__ __forceinline__ float gelu_exact(float x) { return 0.5f * x * (1.f + erff(x * 0.70710678118f)); }

__device__ __forceinline__ void p10_peer(const Args& a, int G) {
    const int tid = threadIdx.x, lane = tid & 63, wave = __builtin_amdgcn_readfirstlane(tid >> 6);
    const bf16_t* H1b = (const bf16_t*)(a.ws + WS_ZC); const float* ssq = (const float*)(a.ws + WS_SSQ);
    const int* TKid = (const int*)(a.ws + WS_KK); const float* TKg = (const float*)(a.ws + WS_KK + 16 * MiB);
    const bf16_t* EU = (const bf16_t*)(a.ws + WS_EU); const bf16_t* EV = (const bf16_t*)(a.ws + WS_EV);
    const float* gfin = a.in[27]; float* H1 = a.out;
    const int gw = blockIdx.x * NWAVES + wave, NGW = G * NWAVES;
    for (int tok = gw; tok < M2; tok += NGW) {
        const u32x4 x0 = *(const u32x4*)(H1b + (size_t)tok * 1024 + 8 * lane), x1 = *(const u32x4*)(H1b + (size_t)tok * 1024 + 512 + 8 * lane);
        const float rs = 1.f / sqrtf(ssq[tok] * (1.f / 1024.f) + 1e-6f);
        const int id0 = TKid[(size_t)tok * 128 + lane], id1 = TKid[(size_t)tok * 128 + 64 + lane];
        const float gt0 = TKg[(size_t)tok * 128 + lane], gt1 = TKg[(size_t)tok * 128 + 64 + lane];
        float y[16];
#pragma unroll
        for (int i = 0; i < 16; ++i) y[i] = 0.f;
#pragma unroll 1
        for (int e0 = 0; e0 < 128; e0 += 4) {
            u32x4 u0[4], u1[4], v0[4], v1[4]; float gg[4];
#pragma unroll
            for (int j = 0; j < 4; ++j) { const int e = e0 + j;
                const int id = (e0 < 64) ? __builtin_amdgcn_readlane(id0, e & 63) : __builtin_amdgcn_readlane(id1, e & 63);
                gg[j] = __builtin_bit_cast(float, (e0 < 64) ? __builtin_amdgcn_readlane(__builtin_bit_cast(int, gt0), e & 63) : __builtin_amdgcn_readlane(__builtin_bit_cast(int, gt1), e & 63));
                const bf16_t* ur = EU + (size_t)id * 1024 + 8 * lane; const bf16_t* vr = EV + (size_t)id * 1024 + 8 * lane;
                u0[j] = *(const u32x4*)ur; u1[j] = *(const u32x4*)(ur + 512); v0[j] = *(const u32x4*)vr; v1[j] = *(const u32x4*)(vr + 512); }
#pragma unroll
            for (int j = 0; j < 4; ++j) {
                float d = 0.f;
                d = dot2bf(u0[j].x, x0.x, d); d = dot2bf(u0[j].y, x0.y, d); d = dot2bf(u0[j].z, x0.z, d); d = dot2bf(u0[j].w, x0.w, d);
                d = dot2bf(u1[j].x, x1.x, d); d = dot2bf(u1[j].y, x1.y, d); d = dot2bf(u1[j].z, x1.z, d); d = dot2bf(u1[j].w, x1.w, d);
                d = wave_sum(d);
                const float cf = gg[j] * gelu_exact(d * rs);
                y[0] = fmaf(cf, bflo(v0[j].x), y[0]); y[1] = fmaf(cf, bfhi(v0[j].x), y[1]); y[2] = fmaf(cf, bflo(v0[j].y), y[2]); y[3] = fmaf(cf, bfhi(v0[j].y), y[3]);
                y[4] = fmaf(cf, bflo(v0[j].z), y[4]); y[5] = fmaf(cf, bfhi(v0[j].z), y[5]); y[6] = fmaf(cf, bflo(v0[j].w), y[6]); y[7] = fmaf(cf, bfhi(v0[j].w), y[7]);
                y[8] = fmaf(cf, bflo(v1[j].x), y[8]); y[9] = fmaf(cf, bfhi(v1[j].x), y[9]); y[10] = fmaf(cf, bflo(v1[j].y), y[10]); y[11] = fmaf(cf, bfhi(v1[j].y), y[11]);
                y[12] = fmaf(cf, bflo(v1[j].z), y[12]); y[13] = fmaf(cf, bfhi(v1[j].z), y[13]); y[14] = fmaf(cf, bflo(v1[j].w), y[14]); y[15] = fmaf(cf, bfhi(v1[j].w), y[15]);
            }
        }
        float* hp = H1 + (size_t)tok * 1024 + 8 * lane;
        f32x4 h0 = *(const f32x4*)hp, h1 = *(const f32x4*)(hp + 4), h2 = *(const f32x4*)(hp + 512), h3 = *(const f32x4*)(hp + 516);
        h0 += (f32x4){y[0], y[1], y[2], y[3]}; h1 += (f32x4){y[4], y[5], y[6], y[7]}; h2 += (f32x4){y[8], y[9], y[10], y[11]}; h3 += (f32x4){y[12], y[13], y[14], y[15]};
        float s = 0.f;
#pragma unroll
        for (int j = 0; j < 4; ++j) s += h0[j] * h0[j] + h1[j] * h1[j] + h2[j] * h2[j] + h3[j] * h3[j];
        const float rf = 1.f / sqrtf(wave_sum(s) * (1.f / 1024.f) + 1e-6f);
        const f32x4 g0 = *(const f32x4*)(gfin + 8 * lane), g1 = *(const f32x4*)(gfin + 8 * lane + 4), g2 = *(const f32x4*)(gfin + 512 + 8 * lane), g3 = *(const f32x4*)(gfin + 516 + 8 * lane);
        *(f32x4*)hp = h0 * rf * g0; *(f32x4*)(hp + 4) = h1 * rf * g1; *(f32x4*)(hp + 512) = h2 * rf * g2; *(f32x4*)(hp + 516) = h3 * rf * g3;
    }
}

constexpr int NPH = 10;
__global__ void __launch_bounds__(NTHR, 2) fwd_kernel(Args a) {
    __shared__ __attribute__((aligned(16))) unsigned char lds_raw[LDS_BYTES];
    LAS unsigned char* lds = (LAS unsigned char*)lds_raw;
    const int G = gridDim.x;
    const int lo = a.ph_lo, hi = a.ph_hi;
#define IN(k) (lo <= (k) && (k) < hi)
#if MK_ONE_LAUNCH
#define SEAM(k) do { if (IN(k) && IN((k) + 1)) cg::this_grid().sync(); } while (0)
#else
#define SEAM(k) do { } while (0)
#endif
    unsigned char* ws = a.ws;
    bf16_t* XN = (bf16_t*)(ws + WS_XN);
    if (IN(0)) { p0_prologue(a, lds, G); } SEAM(0);
    if (IN(1)) {
        pg8::Gemm g{XN, (const bf16_t*)(ws + WS_WIN), MP, INTOT, 1024, 1024, 1024}; pg8::StaticOrder S; S.init(MP, INTOT, G, (int)blockIdx.x);
        pg8::EpiZ E{(bf16_t*)(ws + WS_ZC), (bf16_t*)(ws + WS_ZR), (bf16_t*)(ws + WS_ZG)};
        pg8::gemm_phase<pg8::EpiZ, pg8::StaticOrder, true, true>(lds, g, S, E);
    } SEAM(1);
    if (IN(2)) { p2_conv(a, lds, G); p2_rwkv(a, G); } SEAM(2);
    if (IN(3)) {
        pg8::Gemm g{(const bf16_t*)(ws + WS_A2), (const bf16_t*)(ws + WS_WSM), MP, 1536, 256, 256, 256}; pg8::StaticOrder S; S.init(MP, 1536, G, (int)blockIdx.x);
        pg8::EpiSmall E{a.in[10], a.in[12], a.in[16], (float*)(ws + WS_ZC), (bf16_t*)((unsigned char*)a.out + 66 * MiB), (bf16_t*)(ws + WS_ZR), (bf16_t*)(ws + WS_ZR + 33 * MiB), (const bf16_t*)(ws + WS_KK)};
        pg8::gemm_phase<pg8::EpiSmall, pg8::StaticOrder, true, true>(lds, g, S, E);
    } SEAM(3);
    if (IN(4)) { p4_scan(a, lds, G); } SEAM(4);
    if (IN(5)) {
        bf16_t* Mx = (bf16_t*)(ws + WS_ZR); const bf16_t* Zg = (const bf16_t*)(ws + WS_ZG);
        { pg8::Gemm g{XN, (const bf16_t*)(ws + WS_WCR), M2, 1024, 512, 1024, 1024}; pg8::StaticOrder S; S.init(M2, 1024, G, (int)blockIdx.x);
          pg8::EpiMix<0> E{Mx, Zg}; pg8::gemm_phase<pg8::EpiMix<0>, pg8::StaticOrder, true, true>(lds, g, S, E); }
        asm volatile("s_waitcnt vmcnt(0)" ::: "memory"); __syncthreads();
        { pg8::Gemm g{XN + 512, (const bf16_t*)(ws + WS_WCR) + 512, M2, 1024, 512, 1024, 1024}; pg8::StaticOrder S; S.init(M2, 1024, G, (int)blockIdx.x);
          pg8::EpiMix<1> E{Mx, Zg}; pg8::gemm_phase<pg8::EpiMix<1>, pg8::StaticOrder, true, true>(lds, g, S, E); }
    } SEAM(5);
    if (IN(6)) {
        pg8::Gemm g{(const bf16_t*)(ws + WS_ZR), (const bf16_t*)(ws + WS_WO), M2, 1024, 1024, 1024, 1024}; pg8::StaticOrder S; S.init(M2, 1024, G, (int)blockIdx.x);
        pg8::EpiH1 E{a.in[0], a.out, (bf16_t*)(ws + WS_ZC), (float*)(ws + WS_SSQ)};
        pg8::gemm_phase<pg8::EpiH1, pg8::StaticOrder, true, true>(lds, g, S, E);
    } SEAM(6);
    if (IN(7)) {
        pg8::Gemm g{(const bf16_t*)(ws + WS_ZC), (const bf16_t*)(ws + WS_WQ), M2, 2048, 1024, 1024, 1024}; pg8::StaticOrder S; S.init(M2, 2048, G, (int)blockIdx.x);
        pg8::EpiQ E{(bf16_t*)(ws + WS_ZG), (const float*)(ws + WS_SSQ)};
        pg8::gemm_phase<pg8::EpiQ, pg8::StaticOrder, true, true>(lds, g, S, E);
    } SEAM(7);
    if (IN(8)) { p9_topk(a, lds, G); } SEAM(8);
    if (IN(9)) { p10_peer(a, G); }
#undef IN
#undef SEAM
}

extern "C" void kernel_launch(void* const* d_in, const int* in_sizes, int n_in, void* d_out, int out_size, void* d_ws, size_t ws_size, hipStream_t stream) {
    static int grid = 0;
    if (grid == 0) {
        if (n_in != 28 || out_size != M2 * D || ws_size < WS_END) { fprintf(stderr, "kernel_launch: unexpected shapes (n_in %d out %d ws %zu)\n", n_in, out_size, ws_size); grid = -1; return; }
        int dev = 0, cus = 0, per_cu = 0;
        if (hipGetDevice(&dev) != hipSuccess || hipDeviceGetAttribute(&cus, hipDeviceAttributeMultiprocessorCount, dev) != hipSuccess) { grid = -1; return; }
        if (hipOccupancyMaxActiveBlocksPerMultiprocessor(&per_cu, (const void*)fwd_kernel, NTHR, 0) != hipSuccess || per_cu < 1) { fprintf(stderr, "kernel_launch: occupancy query says %d blocks per CU\n", per_cu); (void)hipGetLastError(); grid = -1; return; }
        grid = cus;
    }
    if (grid < 0) return;
    (void)hipMemsetAsync((char*)d_ws + WS_CTL, 0, CTL_ZERO_BYTES, stream);
    Args a{};
    for (int i = 0; i < 28; ++i) a.in[i] = (const float*)d_in[i];
    a.out = (float*)d_out; a.ws = (unsigned char*)d_ws;
#if MK_ONE_LAUNCH
    a.ph_lo = 0; a.ph_hi = NPH;
    void* args[] = {&a};
    hipError_t e = hipLaunchCooperativeKernel((const void*)fwd_kernel, dim3(grid), dim3(NTHR), args, 0, stream);
    if (e != hipSuccess) fprintf(stderr, "kernel_launch: cooperative launch failed: %s (grid %d)\n", hipGetErrorString(e), grid);
#else
#ifndef MK_PH_HI
#define MK_PH_HI NPH
#endif
#ifndef MK_PH_LO
#define MK_PH_LO 0
#endif
    for (int ph = MK_PH_LO; ph < MK_PH_HI; ++ph) { a.ph_lo = ph; a.ph_hi = ph + 1; hipLaunchKernelGGL(fwd_kernel, dim3(grid), dim3(NTHR), 0, stream, a); }
#endif
}
```

```cpp
#include <hip/hip_runtime.h>
#include <hip/hip_cooperative_groups.h>
#include <cstdio>
#include <cstdint>
namespace cg = cooperative_groups;

#ifndef MK_ONE_LAUNCH
#define MK_ONE_LAUNCH 1
#endif

#define LAS __attribute__((address_space(3)))
#define LDS_WAIT() asm volatile("s_waitcnt lgkmcnt(0)" ::: "memory")

namespace pg8 {
#define PG8_LAS __attribute__((address_space(3)))
typedef unsigned short bf16_t;
typedef short bf16x8 __attribute__((ext_vector_type(8)));
typedef float f32x4 __attribute__((ext_vector_type(4)));
typedef unsigned u32x4 __attribute__((ext_vector_type(4)));
constexpr int BM = 256, BK = 64, HALF = 128, HTB = HALF * BK * 2  , STAGE_BYTES = 8 * HTB, NXCD = 8, WGM = 8;

__host__ __device__ __forceinline__ int lds_byte(int r, int c) { const int st = (r >> 4) * 2 + (c >> 5), rr = r & 15, cc = c & 31, ob = rr * 64 + cc * 2; return st * 1024 + (ob ^ (((ob >> 9) & 1) << 5)); }
__host__ __device__ __forceinline__ void stage_rc(int b, int& R, int& C) { const int st = b / 1024, sb = b % 1024, swz = sb ^ (((sb >> 9) & 1) << 5); R = (st >> 1) * 16 + swz / 64; C = (st & 1) * 32 + (swz % 64) / 2; }
__host__ __device__ __forceinline__ int perm32(int rho) { const int n = rho >> 4, i = rho & 15; return 8 * (i >> 2) + 4 * n + (i & 3); }

struct Unit { int pm, pn; };
struct Gemm { const bf16_t* A; const bf16_t* Bt; int M, N, K, lda, ldb; };

struct StaticOrder {
    int nM, nN, nwg, G, c;
    __host__ __device__ void init(int M, int N, int G_, int c_) { nM = M / BM; nN = N / BM; nwg = nM * nN; G = G_; c = c_; }
    __host__ __device__ bool next(int i, Unit& u) const {
        const long L = (long)i * G + c; if (L >= nwg) return false;
        int wgid = (int)L; { const int q = nwg / NXCD, r = nwg % NXCD, xcd = wgid % NXCD, off = wgid / NXCD; wgid = (xcd < r ? xcd * (q + 1) : r * (q + 1) + (xcd - r) * q) + off; }
        const int nig = WGM * nN, gid = wgid / nig, fm = gid * WGM, gsz = (nM - fm) < WGM ? (nM - fm) : WGM;
        u.pm = fm + ((wgid % nig) % gsz); u.pn = (wgid % nig) / gsz; return true;
    }
    __device__ __forceinline__ void a_ready(const Unit&) const {}
    __device__ __forceinline__ void done(const Unit&) const {}
};

__device__ __forceinline__ unsigned cvt_pk_bf16(float lo, float hi) { unsigned r; asm volatile("v_cvt_pk_bf16_f32 %0, %1, %2" : "=v"(r) : "v"(lo), "v"(hi)); return r; }
__device__ __forceinline__ void store8(bf16_t* p, const f32x4 v0, const f32x4 v1) {
    u32x4 w; w.x = cvt_pk_bf16(v0[0], v0[1]); w.y = cvt_pk_bf16(v0[2], v0[3]); w.z = cvt_pk_bf16(v1[0], v1[1]); w.w = cvt_pk_bf16(v1[2], v1[3]);
    *(u32x4*)p = w;
}
__device__ __forceinline__ float bflo(unsigned w) { return __builtin_bit_cast(float, w << 16); }
__device__ __forceinline__ float bfhi(unsigned w) { return __builtin_bit_cast(float, w & 0xffff0000u); }
__device__ __forceinline__ void load8(const bf16_t* p, f32x4& v0, f32x4& v1) {
    const u32x4 w = *(const u32x4*)p;
    v0 = (f32x4){bflo(w.x), bfhi(w.x), bflo(w.y), bfhi(w.y)}; v1 = (f32x4){bflo(w.z), bfhi(w.z), bflo(w.w), bfhi(w.w)};
}
__device__ __forceinline__ float sigm(float x) { return 1.f / (1.f + __expf(-x)); }
__device__ __forceinline__ int get_lane() { unsigned m = 0xffffffffu; asm volatile("" : "+s"(m)); return (int)__builtin_amdgcn_mbcnt_hi(m, __builtin_amdgcn_mbcnt_lo(m, 0u)); }
__device__ __forceinline__ void lane_ids(int& fr, int& fq) { const int lane = get_lane(); fr = lane & 15; fq = lane >> 4; }


struct EpiZ {
    static constexpr bool PERM = true, AFTER_DRAIN = false;
    bf16_t *Zc, *Zr, *Zg;
    __device__ __forceinline__ void operator()(const f32x4 (&acc)[2][2][4][2], const Unit& u, int wr, int wc, int, int) const {
        int fr, fq; lane_ids(fr, fq);
        bf16_t* base; int ldc, colt; const int pn = u.pn; bool sg = false;
        if (pn < 4) { base = Zc; ldc = 1024; colt = pn * 256; } else if (pn < 11) { base = Zr; ldc = 1792; colt = (pn - 4) * 256; } else { base = Zg; ldc = 2048; colt = (pn - 11) * 256; sg = true; }
        const int row0 = u.pm * BM + wr * 64 + fr, col0 = colt + wc * 32 + 8 * fq;
#pragma unroll
        for (int ai = 0; ai < 2; ++ai)
#pragma unroll
            for (int m = 0; m < 4; ++m) { bf16_t* rowp = base + (size_t)(row0 + ai * HALF + m * 16) * ldc + col0;
#pragma unroll
                for (int bj = 0; bj < 2; ++bj) { f32x4 v0 = acc[ai][bj][m][0], v1 = acc[ai][bj][m][1];
                    if (sg) {
#pragma unroll
                        for (int j = 0; j < 4; ++j) { v0[j] = sigm(v0[j]); v1[j] = sigm(v1[j]); } }
                    store8(rowp + bj * HALF, v0, v1); } }
    }
};

struct EpiSmall {
    static constexpr bool PERM = true, AFTER_DRAIN = false;
    const float *w0, *a0, *k_a; float* E; bf16_t *Kb, *Bb, *Gb; const bf16_t* KKb;
    __device__ __forceinline__ void operator()(const f32x4 (&acc)[2][2][4][2], const Unit& u, int wr, int wc, int, int) const {
        int fr, fq; lane_ids(fr, fq);
        const int pn = u.pn, kind = pn >> 1;
        const int row0 = u.pm * BM + wr * 64 + fr, col0 = (pn & 1) * 256 + wc * 32 + 8 * fq;
#pragma unroll
        for (int ai = 0; ai < 2; ++ai)
#pragma unroll
            for (int m = 0; m < 4; ++m) { const size_t rowoff = (size_t)(row0 + ai * HALF + m * 16) * 512;
#pragma unroll
                for (int bj = 0; bj < 2; ++bj) { const int c = col0 + bj * HALF; f32x4 v0 = acc[ai][bj][m][0], v1 = acc[ai][bj][m][1];
                    if (kind == 0) {
                        const f32x4 p0 = *(const f32x4*)(w0 + c), p1 = *(const f32x4*)(w0 + c + 4);
#pragma unroll
                        for (int j = 0; j < 4; ++j) { v0[j] = 0.60653065971f * sigm(p0[j] + v0[j]); v1[j] = 0.60653065971f * sigm(p1[j] + v1[j]); }
                        *(f32x4*)(E + rowoff + c) = v0; *(f32x4*)(E + rowoff + c + 4) = v1;
                    } else if (kind == 1) {
                        const f32x4 p0 = *(const f32x4*)(a0 + c), p1 = *(const f32x4*)(a0 + c + 4), q0 = *(const f32x4*)(k_a + c), q1 = *(const f32x4*)(k_a + c + 4);
                        f32x4 k0, k1, kk0, kk1; load8(Kb + rowoff + c, k0, k1); load8(KKb + rowoff + c, kk0, kk1);
                        f32x4 km0, km1, b0, b1;
#pragma unroll
                        for (int j = 0; j < 4; ++j) { const float a_0 = sigm(p0[j] + v0[j]), a_1 = sigm(p1[j] + v1[j]);
                            km0[j] = k0[j] * (1.f + (a_0 - 1.f) * q0[j]); km1[j] = k1[j] * (1.f + (a_1 - 1.f) * q1[j]); b0[j] = kk0[j] * a_0; b1[j] = kk1[j] * a_1; }
                        store8(Kb + rowoff + c, km0, km1); store8(Bb + rowoff + c, b0, b1);
                    } else {
                        store8(Gb + rowoff + c, v0, v1);
                    } } }
    }
};

__device__ __forceinline__ int mfull_of(int m2) { return m2 + 16 * ((m2 >> 12) + 1); }

template <int MODE> struct EpiMix {
    static constexpr bool PERM = true, AFTER_DRAIN = false;
    bf16_t* Mx; const bf16_t* Zg;
    __device__ __forceinline__ void operator()(const f32x4 (&acc)[2][2][4][2], const Unit& u, int wr, int wc, int, int) const {
        int fr, fq; lane_ids(fr, fq);
        const int row0 = u.pm * BM + wr * 64 + fr, col0 = u.pn * BM + wc * 32 + 8 * fq;
#pragma unroll
        for (int ai = 0; ai < 2; ++ai)
#pragma unroll
            for (int m = 0; m < 4; ++m) { const int row = row0 + ai * HALF + m * 16; const bf16_t* gp = Zg + (size_t)mfull_of(row) * 2048 + MODE * 1024 + col0; bf16_t* op = Mx + (size_t)row * 1024 + col0;
#pragma unroll
                for (int bj = 0; bj < 2; ++bj) { f32x4 g0, g1; load8(gp + bj * HALF, g0, g1); f32x4 v0 = acc[ai][bj][m][0] * g0, v1 = acc[ai][bj][m][1] * g1;
                    if (MODE == 1) { f32x4 o0, o1; load8(op + bj * HALF, o0, o1); v0 += o0; v1 += o1; }
                    store8(op + bj * HALF, v0, v1); } }
    }
};

struct EpiH1 {
    static constexpr bool PERM = true, AFTER_DRAIN = false;
    const float* X; float* H1; bf16_t* H1b; float* ssq;
    __device__ __forceinline__ void operator()(const f32x4 (&acc)[2][2][4][2], const Unit& u, int wr, int wc, int, int) const {
        int fr, fq; lane_ids(fr, fq);
        const int row0 = u.pm * BM + wr * 64 + fr, col0 = u.pn * BM + wc * 32 + 8 * fq;
#pragma unroll
        for (int ai = 0; ai < 2; ++ai)
#pragma unroll
            for (int m = 0; m < 4; ++m) { const int row = row0 + ai * HALF + m * 16; const size_t off = (size_t)row * 1024 + col0; float s = 0.f;
#pragma unroll
                for (int bj = 0; bj < 2; ++bj) { const f32x4 x0 = *(const f32x4*)(X + off + bj * HALF), x1 = *(const f32x4*)(X + off + bj * HALF + 4);
                    const f32x4 v0 = acc[ai][bj][m][0] + x0, v1 = acc[ai][bj][m][1] + x1;
                    *(f32x4*)(H1 + off + bj * HALF) = v0; *(f32x4*)(H1 + off + bj * HALF + 4) = v1; store8(H1b + off + bj * HALF, v0, v1);
                    s += (v0[0] * v0[0] + v0[1] * v0[1]) + (v0[2] * v0[2] + v0[3] * v0[3]) + (v1[0] * v1[0] + v1[1] * v1[1]) + (v1[2] * v1[2] + v1[3] * v1[3]); }
                s += __shfl_xor(s, 16); s += __shfl_xor(s, 32);
                if (fq == 0) atomicAdd(ssq + row, s); }
    }
};

struct EpiQ {
    static constexpr bool PERM = true, AFTER_DRAIN = false;
    bf16_t* Q; const float* ssq;
    __device__ __forceinline__ void operator()(const f32x4 (&acc)[2][2][4][2], const Unit& u, int wr, int wc, int, int) const {
        int fr, fq; lane_ids(fr, fq);
        const int row0 = u.pm * BM + wr * 64 + fr, col0 = u.pn * BM + wc * 32 + 8 * fq;
#pragma unroll
        for (int ai = 0; ai < 2; ++ai)
#pragma unroll
            for (int m = 0; m < 4; ++m) { const int row = row0 + ai * HALF + m * 16; const float rs = __builtin_amdgcn_rsqf(ssq[row] * (1.f / 1024.f) + 1e-6f); bf16_t* op = Q + (size_t)row * 2048 + col0;
#pragma unroll
                for (int bj = 0; bj < 2; ++bj) store8(op + bj * HALF, acc[ai][bj][m][0] * rs, acc[ai][bj][m][1] * rs); }
    }
};

template <class Epi, class Sched, bool ALIGN_EPI = false, bool SP2 = false>
__device__ __forceinline__ void gemm_phase(PG8_LAS unsigned char* lds, const Gemm g, const Sched& S, const Epi& E, const int wave_s) {
    const int wid = wave_s, lane = get_lane(), tid = wid * 64 + lane, wr = wid >> 2, wc = wid & 3, fr = lane & 15, fq = lane >> 4;
    const int K = g.K, nt = K / BK;
    unsigned voffA[2], voffB[2];
#pragma unroll
    for (int i = 0; i < 2; ++i) { int R, C; stage_rc(tid * 16 + i * 8192, R, C); const int Rb = Epi::PERM ? ((R & ~31) + perm32(R & 31)) : R;
        voffA[i] = (unsigned)(R * g.lda + C) * 2u; voffB[i] = (unsigned)(Rb * g.ldb + C) * 2u; }
    const size_t kstep = (size_t)(BK * 2);
    const size_t hstepA = (size_t)HALF * g.lda * 2, hstepB = (size_t)HALF * g.ldb * 2;
    const size_t tstepA = 2 * hstepA, tstepB = 2 * hstepB;
    const unsigned ldsw = (unsigned)wid * 1024u;
    const int aoff = lds_byte(wr * 64 + fr, fq * 8), boff = lds_byte(wc * 32 + fr, fq * 8);
#define PG8_SA(b, h) (((b) * 2 + (h)) * HTB)
#define PG8_SB(b, h) ((4 + (b) * 2 + (h)) * HTB)
#define PG8_STAGE(bufoff, gbase, voff) do { _Pragma("unroll") for (int _i = 0; _i < 2; ++_i) \
        __builtin_amdgcn_global_load_lds((const unsigned*)((const char*)(gbase) + (voff)[_i]), (PG8_LAS unsigned*)(lds + (bufoff) + ldsw + _i * 8192), 16, 0, 0); } while (0)
#define PG8_LDA(dst, b, h) do { unsigned _ab = (unsigned)(PG8_SA(b, h) + aoff); asm volatile("" : "+v"(_ab)); _Pragma("unroll") for (int m = 0; m < 4; ++m) _Pragma("unroll") for (int k = 0; k < 2; ++k) dst[m][k] = *(const PG8_LAS bf16x8*)(lds + _ab + m * 2048 + k * 1024); } while (0)
#define PG8_LDB(dst, b, h) do { unsigned _bb = (unsigned)(PG8_SB(b, h) + boff); asm volatile("" : "+v"(_bb)); _Pragma("unroll") for (int n = 0; n < 2; ++n) _Pragma("unroll") for (int k = 0; k < 2; ++k) dst[n][k] = *(const PG8_LAS bf16x8*)(lds + _bb + n * 2048 + k * 1024); } while (0)
#define PG8_MMA(ai, bj, At, Bt) do { __builtin_amdgcn_s_setprio(1); _Pragma("unroll") for (int m = 0; m < 4; ++m) _Pragma("unroll") for (int n = 0; n < 2; ++n) _Pragma("unroll") for (int k = 0; k < 2; ++k) \
        acc[ai][bj][m][n] = __builtin_amdgcn_mfma_f32_16x16x32_bf16(Bt[n][k], At[m][k], acc[ai][bj][m][n], 0, 0, 0); __builtin_amdgcn_s_setprio(0); } while (0)
#define PG8_WAIT_V(n) asm volatile("s_waitcnt vmcnt(" #n ")" ::: "memory")
#define PG8_WAIT_L(n) asm volatile("s_waitcnt lgkmcnt(" #n ")" ::: "memory")
#define PG8_BAR __builtin_amdgcn_s_barrier()
#define PG8_SCHED __builtin_amdgcn_sched_barrier(0)
    Unit cur, nxt; int ui = 0;
    if (!S.next(0, cur)) return;
    f32x4 acc[2][2][4][2];
#pragma unroll
    for (int a = 0; a < 2; ++a)
#pragma unroll
        for (int b = 0; b < 2; ++b)
#pragma unroll
            for (int m = 0; m < 4; ++m)
#pragma unroll
                for (int n = 0; n < 2; ++n) acc[a][b][m][n] = (f32x4){0.f, 0.f, 0.f, 0.f};
    bf16x8 At[4][2], B0[2][2], B1[2][2];
    const char* cA = (const char*)g.A + (size_t)cur.pm * tstepA; const char* cB = (const char*)g.Bt + (size_t)cur.pn * tstepB;
    S.a_ready(cur);
    if constexpr (SP2) {
        PG8_STAGE(PG8_SB(0, 0), cB, voffB); PG8_STAGE(PG8_SB(0, 1), cB + hstepB, voffB); PG8_STAGE(PG8_SA(0, 0), cA, voffA); PG8_STAGE(PG8_SA(0, 1), cA + hstepA, voffA);
        if (wr == 1) PG8_BAR;
        PG8_WAIT_V(2); PG8_BAR;
        PG8_STAGE(PG8_SB(1, 0), cB + kstep, voffB); PG8_STAGE(PG8_SA(1, 0), cA + kstep, voffA); PG8_STAGE(PG8_SB(1, 1), cB + hstepB + kstep, voffB);
        PG8_WAIT_V(6); PG8_BAR;
    } else {
        PG8_STAGE(PG8_SB(0, 0), cB, voffB); PG8_STAGE(PG8_SA(0, 0), cA, voffA); PG8_STAGE(PG8_SB(0, 1), cB + hstepB, voffB); PG8_STAGE(PG8_SA(0, 1), cA + hstepA, voffA);
        if (wr == 1) PG8_BAR;
        PG8_WAIT_V(4); PG8_BAR;
        PG8_STAGE(PG8_SB(1, 0), cB + kstep, voffB); PG8_STAGE(PG8_SA(1, 0), cA + kstep, voffA); PG8_STAGE(PG8_SB(1, 1), cB + hstepB + kstep, voffB);
        PG8_WAIT_V(6); PG8_BAR;
    }
    for (;;) {
        const bool has_next = S.next(ui + 1, nxt);
        const char* nA = has_next ? (const char*)g.A + (size_t)nxt.pm * tstepA : cA; const char* nB = has_next ? (const char*)g.Bt + (size_t)nxt.pn * tstepB : cB;
        for (int t = 0; t < nt; t += 2) {
            const bool last = (t == nt - 2);
            const char* a1 = cA + (size_t)(t + 1) * kstep;
            const char* a2 = last ? nA : cA + (size_t)(t + 2) * kstep; const char* b2 = last ? nB : cB + (size_t)(t + 2) * kstep;
            const char* a3 = a2 + kstep; const char* b3 = b2 + kstep;
            if (last && has_next) S.a_ready(nxt);
            if constexpr (SP2) {
            PG8_LDB(B0, 0, 0); PG8_LDB(B1, 0, 1); PG8_SCHED; PG8_LDA(At, 0, 0); PG8_STAGE(PG8_SA(1, 1), a1 + hstepA, voffA);
            PG8_WAIT_V(8); PG8_WAIT_L(0); PG8_BAR; PG8_MMA(0, 0, At, B0); PG8_MMA(0, 1, At, B1); PG8_BAR; PG8_SCHED;
            PG8_LDA(At, 0, 1); PG8_STAGE(PG8_SB(0, 0), b2, voffB); PG8_STAGE(PG8_SB(0, 1), b2 + hstepB, voffB); PG8_STAGE(PG8_SA(0, 0), a2, voffA);
            PG8_WAIT_V(8); PG8_WAIT_L(0); PG8_BAR; PG8_MMA(1, 0, At, B0); PG8_MMA(1, 1, At, B1); PG8_BAR; PG8_SCHED;
            PG8_LDB(B0, 1, 0); PG8_LDB(B1, 1, 1); PG8_SCHED; PG8_LDA(At, 1, 0); PG8_STAGE(PG8_SA(0, 1), a2 + hstepA, voffA);
            PG8_WAIT_V(8); PG8_WAIT_L(0); PG8_BAR; PG8_MMA(0, 0, At, B0); PG8_MMA(0, 1, At, B1); PG8_BAR; PG8_SCHED;
            PG8_LDA(At, 1, 1); PG8_STAGE(PG8_SB(1, 0), b3, voffB); PG8_STAGE(PG8_SB(1, 1), b3 + hstepB, voffB); PG8_STAGE(PG8_SA(1, 0), a3, voffA);
            PG8_WAIT_V(8); PG8_WAIT_L(0); PG8_BAR; PG8_MMA(1, 0, At, B0); PG8_MMA(1, 1, At, B1); PG8_BAR; PG8_SCHED;
            } else {
            PG8_LDB(B0, 0, 0); PG8_SCHED; PG8_LDA(At, 0, 0); PG8_STAGE(PG8_SA(1, 1), a1 + hstepA, voffA);
            PG8_WAIT_L(8); PG8_BAR; PG8_WAIT_L(0); PG8_MMA(0, 0, At, B0); PG8_BAR; PG8_SCHED;
            PG8_LDB(B1, 0, 1); PG8_STAGE(PG8_SB(0, 0), b2, voffB);
            PG8_BAR; PG8_WAIT_L(0); PG8_MMA(0, 1, At, B1); PG8_BAR;
            PG8_LDA(At, 0, 1); PG8_STAGE(PG8_SA(0, 0), a2, voffA);
            PG8_BAR; PG8_WAIT_L(0); PG8_MMA(1, 0, At, B0); PG8_BAR; PG8_SCHED;
            PG8_STAGE(PG8_SB(0, 1), b2 + hstepB, voffB);
            PG8_WAIT_V(6); PG8_BAR; PG8_MMA(1, 1, At, B1); PG8_BAR;
            PG8_LDB(B0, 1, 0); PG8_SCHED; PG8_LDA(At, 1, 0); PG8_STAGE(PG8_SA(0, 1), a2 + hstepA, voffA);
            PG8_WAIT_L(8); PG8_BAR; PG8_WAIT_L(0); PG8_MMA(0, 0, At, B0); PG8_BAR; PG8_SCHED;
            PG8_LDB(B1, 1, 1); PG8_STAGE(PG8_SB(1, 0), b3, voffB);
            PG8_BAR; PG8_WAIT_L(0); PG8_MMA(0, 1, At, B1); PG8_BAR;
            PG8_LDA(At, 1, 1); PG8_STAGE(PG8_SA(1, 0), a3, voffA);
            PG8_BAR; PG8_WAIT_L(0); PG8_MMA(1, 0, At, B0); PG8_BAR; PG8_SCHED;
            PG8_STAGE(PG8_SB(1, 1), b3 + hstepB, voffB);
            PG8_WAIT_V(6); PG8_BAR; PG8_MMA(1, 1, At, B1); PG8_BAR;
            }
        }
        if constexpr (ALIGN_EPI) { if (wr == 0) PG8_BAR; }
        if constexpr (!Epi::AFTER_DRAIN) { E(acc, cur, wr, wc, fr, fq); S.done(cur); }
        if (!has_next) break;
#pragma unroll
        for (int a = 0; a < 2; ++a)
#pragma unroll
            for (int b = 0; b < 2; ++b)
#pragma unroll
                for (int m = 0; m < 4; ++m)
#pragma unroll
                    for (int n = 0; n < 2; ++n) acc[a][b][m][n] = (f32x4){0.f, 0.f, 0.f, 0.f};
        cur = nxt; cA = nA; cB = nB; ++ui;
        if constexpr (ALIGN_EPI) { if (wr == 1) PG8_BAR; }
    }
    PG8_WAIT_V(0);
    if constexpr (!ALIGN_EPI) { if (wr == 0) PG8_BAR; }
    PG8_BAR;
    if constexpr (Epi::AFTER_DRAIN) { E.fused(acc, cur, wr, wc, fr, fq, lds, wid, lane); S.done(cur); }
#undef PG8_SA
#undef PG8_SB
#undef PG8_STAGE
#undef PG8_LDA
#undef PG8_LDB
#undef PG8_MMA
#undef PG8_WAIT_V
#undef PG8_WAIT_L
#undef PG8_BAR
#undef PG8_SCHED
}
}

typedef pg8::bf16_t bf16_t;
typedef pg8::f32x4 f32x4;
typedef pg8::u32x4 u32x4;
typedef pg8::bf16x8 bf16x8;
typedef unsigned u32x2 __attribute__((ext_vector_type(2)));
using pg8::bflo; using pg8::bfhi; using pg8::cvt_pk_bf16; using pg8::sigm; using pg8::load8; using pg8::store8;

constexpr int D = 1024, NB = 8, SEQ = 4096, NMETA = 16, T = SEQ + NMETA  , MT = NB * T  , MP = 33024  , M2 = NB * SEQ  ;
constexpr int INTOT = 4864, CCH = 512, RWW = 512, RWIN = 1792, NHEAD = 8;
constexpr int PH = 8, PK = 128, PDH = 128, PTOPK = 16, NEXP = 16384;
constexpr int NWAVES = 8, NTHR = 512;
constexpr int LDS_BYTES = 147456;

constexpr size_t MiB = 1u << 20;
constexpr size_t WS_CTL = 0, CTL_ZERO_BYTES = 1 * MiB;
constexpr size_t WS_SSQ = 256 * 1024;
constexpr size_t WS_WIN = 1 * MiB;
constexpr size_t WS_WCR = 11 * MiB;
constexpr size_t WS_WO = 13 * MiB;
constexpr size_t WS_WQ = 15 * MiB;
constexpr size_t WS_SK = 19 * MiB;
constexpr size_t WS_WSM = 19 * MiB + 512 * 1024;
constexpr size_t WS_EU = 21 * MiB, WS_EV = 53 * MiB;
constexpr size_t WS_XN = 85 * MiB;
constexpr size_t WS_ZG = 150 * MiB;
constexpr size_t WS_ZR = 279 * MiB;
constexpr size_t WS_ZC = 392 * MiB;
constexpr size_t WS_KK = 457 * MiB;
constexpr size_t WS_A2 = 490 * MiB;
constexpr size_t WS_END = 507 * MiB;

struct Args { const float* in[28]; float* out; unsigned char* ws; int ph_lo, ph_hi; };

__device__ __forceinline__ float dpp_f(float x, const int ctrl_sel) { return x; }
#define DPP_ADD(x, ctrl) ((x) + __builtin_bit_cast(float, __builtin_amdgcn_update_dpp(0, __builtin_bit_cast(int, (x)), (ctrl), 0xf, 0xf, true)))
__device__ __forceinline__ float red8(float x) {
    x = DPP_ADD(x, 0xB1); x = DPP_ADD(x, 0x4E); x = DPP_ADD(x, 0x141); return x;
}
__device__ __forceinline__ float red16(float x) { x = red8(x); x = DPP_ADD(x, 0x140); return x; }
__device__ __forceinline__ float wave_sum(float x) {
    x = red16(x);
    const int xi = __builtin_bit_cast(int, x);
    const float a = __builtin_bit_cast(float, __builtin_amdgcn_readlane(xi, 0)), b = __builtin_bit_cast(float, __builtin_amdgcn_readlane(xi, 16)), c = __builtin_bit_cast(float, __builtin_amdgcn_readlane(xi, 32)), d = __builtin_bit_cast(float, __builtin_amdgcn_readlane(xi, 48));
    return (a + b) + (c + d);
}

__device__ __forceinline__ void p0_transpose_item(const float* W, int ldw, bf16_t* WT, int ldt, int koff, const float* kscale, int nblk, LAS float* scr, int item, int lane) {
    const int kb = item / nblk, nb = item % nblk, k0 = 64 * kb, n0 = 32 * nb;
#pragma unroll 8
    for (int i = 0; i < 32; ++i) { const int kk = 2 * i + (lane >> 5); float w = W[(size_t)(k0 + kk) * ldw + n0 + (lane & 31)]; if (kscale) w *= kscale[k0 + kk]; scr[kk * 33 + (lane & 31)] = w; }
    LDS_WAIT(); asm volatile("" ::: "memory");
    const int c = lane & 7;
#pragma unroll
    for (int j = 0; j < 4; ++j) { const int n = (lane >> 3) + 8 * j; const LAS float* s = scr + (8 * c) * 33 + n;
        u32x4 o; o.x = cvt_pk_bf16(s[0 * 33], s[1 * 33]); o.y = cvt_pk_bf16(s[2 * 33], s[3 * 33]); o.z = cvt_pk_bf16(s[4 * 33], s[5 * 33]); o.w = cvt_pk_bf16(s[6 * 33], s[7 * 33]);
        *(u32x4*)(WT + (size_t)(n0 + n) * ldt + koff + k0 + 8 * c) = o; }
    LDS_WAIT(); asm volatile("" ::: "memory");
}

__device__ __forceinline__ void p0_prologue(const Args& a, LAS unsigned char* lds, int G, const int wave) {
    const int lane = pg8::get_lane(), tid = wave * 64 + lane;
    unsigned char* ws = a.ws;
    LAS float* scr = (LAS float*)(lds + wave * 16384);
    const int gw = blockIdx.x * NWAVES + wave, NGW = G * NWAVES;
    const int gt = blockIdx.x * NTHR + tid, NGT = G * NTHR;
    constexpr int I_IN = (1024 / 64) * (INTOT / 32), I_C = (512 / 64) * (1024 / 32), I_O = (1024 / 64) * (1024 / 32), I_Q = (1024 / 64) * (2048 / 32);
    constexpr int NITEMS = I_IN + 2 * I_C + I_O + I_Q;
    for (int it = gw; it < NITEMS; it += NGW) {
        int r = it;
        if (r < I_IN) { p0_transpose_item(a.in[3], INTOT, (bf16_t*)(ws + WS_WIN), 1024, 0, nullptr, INTOT / 32, scr, r, lane); continue; } r -= I_IN;
        if (r < I_C) { p0_transpose_item(a.in[8], 1024, (bf16_t*)(ws + WS_WCR), 1024, 0, nullptr, 32, scr, r, lane); continue; } r -= I_C;
        if (r < I_C) { p0_transpose_item(a.in[20], 1024, (bf16_t*)(ws + WS_WCR), 1024, 512, nullptr, 32, scr, r, lane); continue; } r -= I_C;
        if (r < I_O) { p0_transpose_item(a.in[21], 1024, (bf16_t*)(ws + WS_WO), 1024, 0, nullptr, 32, scr, r, lane); continue; } r -= I_O;
        p0_transpose_item(a.in[23], 2048, (bf16_t*)(ws + WS_WQ), 1024, 0, a.in[22], 64, scr, r, lane);
    }
    { const float* sk = a.in[24]; bf16_t* o = (bf16_t*)(ws + WS_SK);
      for (int i = gt; i < 16 * 128 * 128 / 8; i += NGT) { const f32x4 x0 = *(const f32x4*)(sk + (size_t)i * 8), x1 = *(const f32x4*)(sk + (size_t)i * 8 + 4); store8(o + (size_t)i * 8, x0, x1); } }
    { const float* w_up = a.in[11]; const float* a_up = a.in[13]; const float* g_up = a.in[14]; bf16_t* o = (bf16_t*)(ws + WS_WSM);
      for (int i = gt; i < 1536 * 32; i += NGT) { const int n = i >> 5, k8 = (i & 31) * 8; float v[8];
#pragma unroll
          for (int j = 0; j < 8; ++j) { const int k = k8 + j; float x = 0.f;
              if (n < 512) { if (k < 64) x = w_up[k * 512 + n]; }
              else if (n < 1024) { if (k >= 64 && k < 128) x = a_up[(k - 64) * 512 + (n - 512)]; }
              else { if (k >= 128) x = g_up[(k - 128) * 512 + (n - 1024)]; }
              v[j] = x; }
          store8(o + (size_t)n * 256 + k8, (f32x4){v[0], v[1], v[2], v[3]}, (f32x4){v[4], v[5], v[6], v[7]}); } }
    { const float* eu = a.in[25]; const float* ev = a.in[26]; const float* gf = a.in[22]; bf16_t* ou = (bf16_t*)(ws + WS_EU); bf16_t* ov = (bf16_t*)(ws + WS_EV);
      for (int i = gt; i < NEXP * 1024 / 8; i += NGT) { const size_t e = (size_t)i * 8; const int k = (int)(e & 1023);
          const f32x4 g0 = *(const f32x4*)(gf + k), g1 = *(const f32x4*)(gf + k + 4);
          const f32x4 u0 = *(const f32x4*)(eu + e), u1 = *(const f32x4*)(eu + e + 4); store8(ou + e, u0 * g0, u1 * g1);
          const f32x4 v0 = *(const f32x4*)(ev + e), v1 = *(const f32x4*)(ev + e + 4); store8(ov + e, v0, v1); } }
    { const float* x = a.in[0]; const float* meta = a.in[1]; const float* gm = a.in[2]; bf16_t* XN = (bf16_t*)(ws + WS_XN);
      for (int m = gw; m < MP; m += NGW) {
          bf16_t* o = XN + (size_t)m * 1024;
          if (m >= MT) { const u32x4 z = {0u, 0u, 0u, 0u}; ((u32x4*)o)[lane] = z; ((u32x4*)o)[lane + 64] = z; continue; }
          const int b = m / T, t = m - b * T;
          const float* src = (t < NMETA) ? meta + (size_t)t * 1024 : x + ((size_t)b * SEQ + (t - NMETA)) * 1024;
          f32x4 v[4]; float s = 0.f;
#pragma unroll
          for (int j = 0; j < 4; ++j) { v[j] = ((const f32x4*)src)[lane + 64 * j]; s += (v[j][0] * v[j][0] + v[j][1] * v[j][1]) + (v[j][2] * v[j][2] + v[j][3] * v[j][3]); }
          const float rs = 1.f / sqrtf(wave_sum(s) * (1.f / 1024.f) + 1e-6f);
#pragma unroll
          for (int j = 0; j < 4; ++j) { const f32x4 g = ((const f32x4*)gm)[lane + 64 * j]; const f32x4 y = v[j] * rs * g;
              u32x2 w; w.x = cvt_pk_bf16(y[0], y[1]); w.y = cvt_pk_bf16(y[2], y[3]); ((u32x2*)o)[lane + 64 * j] = w; }
      } }
}

__device__ __forceinline__ void p2_conv(const Args& a, LAS unsigned char* lds, int G, const int wave) {
    const int lane = pg8::get_lane(), tid = wave * 64 + lane;
    const bf16_t* Zc = (const bf16_t*)(a.ws + WS_ZC); bf16_t* AC = (bf16_t*)(a.ws + WS_XN);
    const float* conv_w = a.in[4]; const float* conv_b = a.in[5]; const float* ln_g = a.in[6]; const float* ln_b = a.in[7];
    LAS float* yl = (LAS float*)lds;
    constexpr int CT = 32, TPB = (T + CT - 1) / CT;
    const int c = tid;
    float w[31];
#pragma unroll
    for (int j = 0; j < 31; ++j) w[j] = conv_w[j * 512 + c];
    const float bias = conv_b[c];
    for (int it = blockIdx.x; it < NB * TPB; it += G) {
        const int b = it / TPB, t0 = (it - b * TPB) * CT;
        float u[CT + 30];
#pragma unroll
        for (int s = 0; s < CT + 30; ++s) {
            const int ti = t0 - 30 + s; float uu = 0.f;
            if (ti >= 0 && ti < T) { const bf16_t* row = Zc + (size_t)(b * T + ti) * 1024; const float val = __builtin_bit_cast(float, (unsigned)row[c] << 16), gt = __builtin_bit_cast(float, (unsigned)row[512 + c] << 16); uu = val * sigm(gt); }
            u[s] = uu;
        }
#pragma unroll
        for (int o = 0; o < CT; ++o) {
            float acc = bias;
#pragma unroll
            for (int j = 0; j < 31; ++j) acc = fmaf(w[j], u[o + j], acc);
            yl[o * 512 + c] = acc;
        }
        __syncthreads();
#pragma unroll
        for (int q = 0; q < 4; ++q) {
            const int o = wave * 4 + q, t = t0 + o;
            if (t >= NMETA && t < T) {
                const f32x4 y0 = *(const LAS f32x4*)(yl + o * 512 + 8 * lane), y1 = *(const LAS f32x4*)(yl + o * 512 + 8 * lane + 4);
                const float mean = wave_sum((y0[0] + y0[1]) + (y0[2] + y0[3]) + (y1[0] + y1[1]) + (y1[2] + y1[3])) * (1.f / 512.f);
                const f32x4 d0 = y0 - mean, d1 = y1 - mean;
                const float var = wave_sum((d0[0] * d0[0] + d0[1] * d0[1]) + (d0[2] * d0[2] + d0[3] * d0[3]) + (d1[0] * d1[0] + d1[1] * d1[1]) + (d1[2] * d1[2] + d1[3] * d1[3])) * (1.f / 512.f);
                const float rstd = 1.f / sqrtf(var + 1e-5f);
                const f32x4 g0 = *(const f32x4*)(ln_g + 8 * lane), g1 = *(const f32x4*)(ln_g + 8 * lane + 4), b0 = *(const f32x4*)(ln_b + 8 * lane), b1 = *(const f32x4*)(ln_b + 8 * lane + 4);
                f32x4 z0 = d0 * rstd * g0 + b0, z1 = d1 * rstd * g1 + b1;
#pragma unroll
                for (int j = 0; j < 4; ++j) { z0[j] = z0[j] * sigm(z0[j]); z1[j] = z1[j] * sigm(z1[j]); }
                store8(AC + ((size_t)b * SEQ + (t - NMETA)) * 1024 + 8 * lane, z0, z1);
            }
        }
        __syncthreads();
    }
}

__device__ __forceinline__ void p2_rwkv(const Args& a, int G, const int wave) {
    const int lane = pg8::get_lane(), tid = wave * 64 + lane;
    const bf16_t* Zr = (const bf16_t*)(a.ws + WS_ZR);
    bf16_t* Rb = (bf16_t*)a.out; bf16_t* Vb = (bf16_t*)((unsigned char*)a.out + 33 * MiB); bf16_t* Kb = (bf16_t*)((unsigned char*)a.out + 66 * MiB);
    bf16_t* KKb = (bf16_t*)(a.ws + WS_KK); bf16_t* A2 = (bf16_t*)(a.ws + WS_A2);
    const float* mu = a.in[9]; const float* k_k = a.in[15];
    const int gw = blockIdx.x * NWAVES + wave, NGW = G * NWAVES;
    for (int m = gw; m < MT; m += NGW) {
        const int b = m / T, t = m - b * T;
        const bf16_t* cur = Zr + (size_t)m * RWIN; const bf16_t* prv = cur - RWIN; const bool hp = (t > 0);
#pragma unroll
        for (int s = 0; s < 3; ++s) {
            const int c = s * 512 + 8 * lane;
            f32x4 c0, c1, p0 = {0.f, 0.f, 0.f, 0.f}, p1 = {0.f, 0.f, 0.f, 0.f}; load8(cur + c, c0, c1); if (hp) load8(prv + c, p0, p1);
            const f32x4 m0 = *(const f32x4*)(mu + c), m1 = *(const f32x4*)(mu + c + 4);
            const f32x4 z0 = c0 + (p0 - c0) * m0, z1 = c1 + (p1 - c1) * m1;
            if (s == 0) store8(Rb + (size_t)m * 512 + 8 * lane, z0, z1);
            else if (s == 2) store8(Vb + (size_t)m * 512 + 8 * lane, z0, z1);
            else {
                store8(Kb + (size_t)m * 512 + 8 * lane, z0, z1);
                const f32x4 q0 = *(const f32x4*)(k_k + 8 * lane), q1 = *(const f32x4*)(k_k + 8 * lane + 4);
                const f32x4 k0 = z0 * q0, k1 = z1 * q1;
                float ss = (k0[0] * k0[0] + k0[1] * k0[1]) + (k0[2] * k0[2] + k0[3] * k0[3]) + (k1[0] * k1[0] + k1[1] * k1[1]) + (k1[2] * k1[2] + k1[3] * k1[3]);
                ss = red8(ss);
                const float rn = 1.f / sqrtf(fmaxf(ss, 1e-24f));
                store8(KKb + (size_t)m * 512 + 8 * lane, k0 * rn, k1 * rn);
            }
        }
        {
            const int c = 1536 + 4 * lane;
            const u32x2 cw = *(const u32x2*)(cur + c); u32x2 pw = {0u, 0u}; if (hp) pw = *(const u32x2*)(prv + c);
            const f32x4 cv = {bflo(cw.x), bfhi(cw.x), bflo(cw.y), bfhi(cw.y)}, pv = {bflo(pw.x), bfhi(pw.x), bflo(pw.y), bfhi(pw.y)};
            const f32x4 mv = *(const f32x4*)(mu + c);
            f32x4 z = cv + (pv - cv) * mv;
#pragma unroll
            for (int j = 0; j < 4; ++j) { if (lane < 16) z[j] = tanhf(z[j]); else if (lane >= 32) z[j] = sigm(z[j]); }
            u32x2 w; w.x = cvt_pk_bf16(z[0], z[1]); w.y = cvt_pk_bf16(z[2], z[3]); *(u32x2*)(A2 + (size_t)m * 256 + 4 * lane) = w;
        }
    }
}

__device__ __forceinline__ void p4_scan(const Args& a, LAS unsigned char* lds, int G, const int wave) {
    const int lane = pg8::get_lane(), tid = wave * 64 + lane;
    const bf16_t* Rb = (const bf16_t*)a.out; const bf16_t* Vb = (const bf16_t*)((unsigned char*)a.out + 33 * MiB); const bf16_t* Kb = (const bf16_t*)((unsigned char*)a.out + 66 * MiB);
    const bf16_t* KKb = (const bf16_t*)(a.ws + WS_KK); const bf16_t* Bb = (const bf16_t*)(a.ws + WS_ZR); const bf16_t* Gb = (const bf16_t*)(a.ws + WS_ZR + 33 * MiB);
    const float* E = (const float*)(a.ws + WS_ZC); bf16_t* AC = (bf16_t*)(a.ws + WS_XN);
    const float* r_k = a.in[17]; const float* gn_g = a.in[18]; const float* gn_b = a.in[19];
    constexpr int CH = 16, NCH = T / CH;
    constexpr int STEPF = 6 * 64;
    LAS float* buf0 = (LAS float*)lds; LAS float* buf1 = buf0 + CH * STEPF; LAS float* obuf = buf1 + CH * STEPF;
    const int r8 = lane >> 3, ko = lane & 7, vrow = wave * 8 + r8;
    for (int it = blockIdx.x; it < NB * NHEAD; it += G) {
        const int b = it >> 3, h = it & 7;
        const size_t mbase = (size_t)b * T;
        float S[8];
#pragma unroll
        for (int i = 0; i < 8; ++i) S[i] = 0.f;
        u32x4 ld[2];
        auto issue = [&](int ch) {
#pragma unroll
            for (int i = 0; i < 2; ++i) { const int p = tid + i * 512; if (p < CH * 56) { const int st = p / 56, q = p - st * 56; const size_t row = mbase + (size_t)ch * CH + st;
                const unsigned char* src;
                if (q < 40) { const int arr = q >> 3, e8 = (q & 7) * 8; const bf16_t* base = (arr == 0) ? KKb : (arr == 1) ? Bb : (arr == 2) ? Kb : (arr == 3) ? Rb : Vb; src = (const unsigned char*)(base + row * 512 + h * 64 + e8); }
                else { src = (const unsigned char*)(E + row * 512 + h * 64 + (q - 40) * 4); }
                ld[i] = *(const u32x4*)src; } }
        };
        auto commit = [&](LAS float* buf) {
#pragma unroll
            for (int i = 0; i < 2; ++i) { const int p = tid + i * 512; if (p < CH * 56) { const int st = p / 56, q = p - st * 56; LAS float* dst = buf + st * STEPF;
                if (q < 40) { const int arr = q >> 3, e8 = (q & 7) * 8; const u32x4 w = ld[i];
                    *(LAS f32x4*)(dst + (arr + 1) * 64 + e8) = (f32x4){bflo(w.x), bfhi(w.x), bflo(w.y), bfhi(w.y)}; *(LAS f32x4*)(dst + (arr + 1) * 64 + e8 + 4) = (f32x4){bflo(w.z), bfhi(w.z), bflo(w.w), bfhi(w.w)}; }
                else { const f32x4 e = __builtin_bit_cast(f32x4, ld[i]); *(LAS f32x4*)(dst + (q - 40) * 4) = (f32x4){__expf(-e[0]), __expf(-e[1]), __expf(-e[2]), __expf(-e[3])}; } } }
        };
        issue(0); commit(buf0); __syncthreads();
        for (int ch = 0; ch < NCH; ++ch) {
            LAS float* cur = (ch & 1) ? buf1 : buf0; LAS float* nxt = (ch & 1) ? buf0 : buf1;
            if (ch + 1 < NCH) issue(ch + 1);
#pragma unroll 4
            for (int st = 0; st < CH; ++st) {
                const LAS float* sp = cur + st * STEPF;
                const f32x4 w0 = *(const LAS f32x4*)(sp + 0 * 64 + 8 * ko), w1 = *(const LAS f32x4*)(sp + 0 * 64 + 8 * ko + 4);
                const f32x4 k0 = *(const LAS f32x4*)(sp + 1 * 64 + 8 * ko), k1 = *(const LAS f32x4*)(sp + 1 * 64 + 8 * ko + 4);
                const f32x4 b0 = *(const LAS f32x4*)(sp + 2 * 64 + 8 * ko), b1 = *(const LAS f32x4*)(sp + 2 * 64 + 8 * ko + 4);
                const f32x4 m0 = *(const LAS f32x4*)(sp + 3 * 64 + 8 * ko), m1 = *(const LAS f32x4*)(sp + 3 * 64 + 8 * ko + 4);
                const f32x4 q0 = *(const LAS f32x4*)(sp + 4 * 64 + 8 * ko), q1 = *(const LAS f32x4*)(sp + 4 * 64 + 8 * ko + 4);
                const float vv = sp[5 * 64 + vrow];
                float sa = 0.f;
#pragma unroll
                for (int i = 0; i < 4; ++i) { sa = fmaf(S[i], k0[i], sa); sa = fmaf(S[4 + i], k1[i], sa); }
                sa = red8(sa);
                float o = 0.f;
#pragma unroll
                for (int i = 0; i < 4; ++i) {
                    S[i] = fmaf(S[i], w0[i], fmaf(vv, m0[i], -sa * b0[i])); S[4 + i] = fmaf(S[4 + i], w1[i], fmaf(vv, m1[i], -sa * b1[i]));
                    o = fmaf(S[i], q0[i], o); o = fmaf(S[4 + i], q1[i], o); }
                o = red8(o);
                if (ko == 0) obuf[st * 64 + vrow] = o;
            }
            __syncthreads();
#pragma unroll
            for (int q = 0; q < 2; ++q) {
                const int st = wave * 2 + q, t = ch * CH + st; const LAS float* sp = cur + st * STEPF;
                const float o = obuf[st * 64 + lane];
                const float mean = wave_sum(o) * (1.f / 64.f); const float d = o - mean; const float var = wave_sum(d * d) * (1.f / 64.f);
                const float rk = wave_sum(sp[4 * 64 + lane] * sp[3 * 64 + lane] * r_k[h * 64 + lane]);
                if (t >= NMETA) {
                    const float g = __builtin_bit_cast(float, (unsigned)Gb[(mbase + t) * 512 + h * 64 + lane] << 16);
                    const float res = (d * (1.f / sqrtf(var + 64e-5f)) * gn_g[h * 64 + lane] + gn_b[h * 64 + lane] + rk * sp[5 * 64 + lane]) * g;
                    AC[((size_t)b * SEQ + (t - NMETA)) * 1024 + 512 + h * 64 + lane] = (bf16_t)(cvt_pk_bf16(res, 0.f) & 0xffffu);
                }
            }
            if (ch + 1 < NCH) commit(nxt);
            __syncthreads();
        }
    }
}

#define CE_DESC(x, y) do { const float _hi = fmaxf((x), (y)), _lo = fminf((x), (y)); (x) = _hi; (y) = _lo; } while (0)
__device__ __forceinline__ void sort16_desc(float (&v)[16]) {
#pragma unroll
    for (int k = 2; k <= 16; k <<= 1) {
#pragma unroll
        for (int j = k >> 1; j > 0; j >>= 1) {
#pragma unroll
            for (int i = 0; i < 16; ++i) { const int l = i ^ j; if (l > i) { if ((i & k) == 0) CE_DESC(v[i], v[l]); else CE_DESC(v[l], v[i]); } }
        }
    }
}
__device__ __forceinline__ void merge16(float (&x)[16], const float (&y)[16]) {
#pragma unroll
    for (int i = 0; i < 16; ++i) x[i] = fmaxf(x[i], y[15 - i]);
#pragma unroll
    for (int j = 8; j > 0; j >>= 1) {
#pragma unroll
        for (int i = 0; i < 16; ++i) { const int l = i ^ j; if (l > i) CE_DESC(x[i], x[l]); }
    }
}
__device__ __forceinline__ void xmerge16(float (&x)[16], int mask) {
    float y[16];
#pragma unroll
    for (int i = 0; i < 16; ++i) y[i] = __shfl_xor(x[i], mask);
    merge16(x, y);
}
__device__ __forceinline__ float pk_low(float x, unsigned code, unsigned keep_mask) { return __builtin_bit_cast(float, (__builtin_bit_cast(unsigned, x) & keep_mask) | code); }

__device__ __forceinline__ void p9_topk(const Args& a, LAS unsigned char* lds, int G, const int wave) {
    const int lane = pg8::get_lane(), tid = wave * 64 + lane;
    const bf16_t* Q = (const bf16_t*)(a.ws + WS_ZG); const bf16_t* SK = (const bf16_t*)(a.ws + WS_SK);
    int* TKid = (int*)(a.ws + WS_KK); float* TKg = (float*)(a.ws + WS_KK + 16 * MiB);
    LAS unsigned char* wl = lds + wave * 512;
    const int fr = lane & 15, fq = lane >> 4;
    const int gw = blockIdx.x * NWAVES + wave, NGW = G * NWAVES;
    constexpr int NUNITS = (M2 / 16) * PH;
    for (int un = gw; un < NUNITS; un += NGW) {
        const int h = un & 7, tok0 = (un >> 3) * 16;
        float top[2][16];
#pragma unroll
        for (int c = 0; c < 2; ++c) {
            f32x4 acc[8];
#pragma unroll
            for (int nt = 0; nt < 8; ++nt) acc[nt] = (f32x4){0.f, 0.f, 0.f, 0.f};
            const bf16_t* qrow = Q + (size_t)(tok0 + fr) * 2048 + h * 256 + c * 128 + fq * 8;
            bf16x8 qf[4];
#pragma unroll
            for (int ks = 0; ks < 4; ++ks) qf[ks] = *(const bf16x8*)(qrow + ks * 32);
            const bf16_t* skb = SK + (size_t)((h * 2 + c) * 128) * 128 + (size_t)fr * 128 + fq * 8;
#pragma unroll
            for (int nt = 0; nt < 8; ++nt)
#pragma unroll
                for (int ks = 0; ks < 4; ++ks) { const bf16x8 kf = *(const bf16x8*)(skb + (size_t)nt * 16 * 128 + ks * 32);
                    acc[nt] = __builtin_amdgcn_mfma_f32_16x16x32_bf16(kf, qf[ks], acc[nt], 0, 0, 0); }
            float lo[16], hi[16];
#pragma unroll
            for (int nt = 0; nt < 4; ++nt)
#pragma unroll
                for (int r = 0; r < 4; ++r) { lo[nt * 4 + r] = pk_low(acc[nt][r], (unsigned)(16 * nt + 4 * fq + r), 0xffffff80u); hi[nt * 4 + r] = pk_low(acc[nt + 4][r], (unsigned)(16 * (nt + 4) + 4 * fq + r), 0xffffff80u); }
            sort16_desc(lo); sort16_desc(hi); merge16(lo, hi); xmerge16(lo, 16); xmerge16(lo, 32);
#pragma unroll
            for (int i = 0; i < 16; ++i) top[c][i] = lo[i];
        }
        float cand[16];
        const float PAD = -3.0e38f;
#pragma unroll
        for (int s = 0; s < 16; ++s) {
            const int i1 = (s < 8) ? 1 : (s < 13) ? 2 : 4, j1 = (s < 8) ? s : (s < 13) ? s - 8 : s - 13;
            const int i2 = (s < 4) ? 3 : (s < 6) ? 5 : (s < 8) ? 6 : 7, j2 = (s < 4) ? s : (s < 6) ? s - 4 : (s < 8) ? s - 6 : s - 8;
            const float c0 = pk_low(top[0][0] + top[1][s], (unsigned)s, 0xffffff00u);
            const float c1 = pk_low(top[0][i1] + top[1][j1], (unsigned)(i1 * 16 + j1), 0xffffff00u);
            const float c2 = (s < 10) ? pk_low(top[0][i2] + top[1][j2], (unsigned)(i2 * 16 + j2), 0xffffff00u) : PAD;
            const float c3 = (s < 8) ? pk_low(top[0][8 + s] + top[1][0], (unsigned)((8 + s) * 16), 0xffffff00u) : PAD;
            cand[s] = (fq == 0) ? c0 : (fq == 1) ? c1 : (fq == 2) ? c2 : c3;
        }
        sort16_desc(cand); xmerge16(cand, 16); xmerge16(cand, 32);
        if (fq == 0) {
            u32x4 wa, wb; unsigned pa[4], pb[4];
#pragma unroll
            for (int g = 0; g < 4; ++g) { pa[g] = 0u; pb[g] = 0u;
#pragma unroll
                for (int j = 0; j < 4; ++j) { pa[g] |= (__builtin_bit_cast(unsigned, top[0][4 * g + j]) & 0x7fu) << (8 * j); pb[g] |= (__builtin_bit_cast(unsigned, top[1][4 * g + j]) & 0x7fu) << (8 * j); } }
            wa.x = pa[0]; wa.y = pa[1]; wa.z = pa[2]; wa.w = pa[3]; wb.x = pb[0]; wb.y = pb[1]; wb.z = pb[2]; wb.w = pb[3];
            *(LAS u32x4*)(wl + fr * 32) = wa; *(LAS u32x4*)(wl + fr * 32 + 16) = wb;
            LDS_WAIT();
            float p[16], sum = 0.f; int eid[16];
            const float mx = cand[0];
#pragma unroll
            for (int i = 0; i < 16; ++i) { p[i] = __expf(cand[i] - mx); sum += p[i];
                const unsigned code = __builtin_bit_cast(unsigned, cand[i]) & 0xffu;
                const int i1 = wl[fr * 32 + (code >> 4)], i2 = wl[fr * 32 + 16 + (code & 15u)];
                eid[i] = i1 * PK + i2; }
            const float inv = 1.f / sum;
            int* ip = TKid + (size_t)(tok0 + fr) * 128 + h * 16; float* gp = TKg + (size_t)(tok0 + fr) * 128 + h * 16;
#pragma unroll
            for (int g = 0; g < 4; ++g) { *(int4*)(ip + 4 * g) = make_int4(eid[4 * g], eid[4 * g + 1], eid[4 * g + 2], eid[4 * g + 3]);
                *(f32x4*)(gp + 4 * g) = (f32x4){p[4 * g] * inv, p[4 * g + 1] * inv, p[4 * g + 2] * inv, p[4 * g + 3] * inv}; }
            LDS_WAIT();
        }
    }
}

typedef __bf16 bf16v2 __attribute__((ext_vector_type(2)));
__device__ __forceinline__ float dot2bf(unsigned x, unsigned y, float acc) { return __builtin_amdgcn_fdot2_f32_bf16(__builtin_bit_cast(bf16v2, x), __builtin_bit_cast(bf16v2, y), acc, false); }
__device__ __forceinline__ float gelu_exact(float x) { return 0.5f * x * (1.f + erff(x * 0.70710678118f)); }

__device__ __forceinline__ void p10_peer(const Args& a, int G, const int wave) {
    const int lane = pg8::get_lane(), tid = wave * 64 + lane;
    const bf16_t* H1b = (const bf16_t*)(a.ws + WS_ZC); const float* ssq = (const float*)(a.ws + WS_SSQ);
    const int* TKid = (const int*)(a.ws + WS_KK); const float* TKg = (const float*)(a.ws + WS_KK + 16 * MiB);
    const bf16_t* EU = (const bf16_t*)(a.ws + WS_EU); const bf16_t* EV = (const bf16_t*)(a.ws + WS_EV);
    const float* gfin = a.in[27]; float* H1 = a.out;
    const int gw = blockIdx.x * NWAVES + wave, NGW = G * NWAVES;
    for (int tok = gw; tok < M2; tok += NGW) {
        const u32x4 x0 = *(const u32x4*)(H1b + (size_t)tok * 1024 + 8 * lane), x1 = *(const u32x4*)(H1b + (size_t)tok * 1024 + 512 + 8 * lane);
        const float rs = 1.f / sqrtf(ssq[tok] * (1.f / 1024.f) + 1e-6f);
        const int id0 = TKid[(size_t)tok * 128 + lane], id1 = TKid[(size_t)tok * 128 + 64 + lane];
        const float gt0 = TKg[(size_t)tok * 128 + lane], gt1 = TKg[(size_t)tok * 128 + 64 + lane];
        float y[16];
#pragma unroll
        for (int i = 0; i < 16; ++i) y[i] = 0.f;
#pragma unroll 1
        for (int e0 = 0; e0 < 128; e0 += 4) {
            u32x4 u0[4], u1[4], v0[4], v1[4]; float gg[4];
#pragma unroll
            for (int j = 0; j < 4; ++j) { const int e = e0 + j;
                const int id = (e0 < 64) ? __builtin_amdgcn_readlane(id0, e & 63) : __builtin_amdgcn_readlane(id1, e & 63);
                gg[j] = __builtin_bit_cast(float, (e0 < 64) ? __builtin_amdgcn_readlane(__builtin_bit_cast(int, gt0), e & 63) : __builtin_amdgcn_readlane(__builtin_bit_cast(int, gt1), e & 63));
                const bf16_t* ur = EU + (size_t)id * 1024 + 8 * lane; const bf16_t* vr = EV + (size_t)id * 1024 + 8 * lane;
                u0[j] = *(const u32x4*)ur; u1[j] = *(const u32x4*)(ur + 512); v0[j] = *(const u32x4*)vr; v1[j] = *(const u32x4*)(vr + 512); }
#pragma unroll
            for (int j = 0; j < 4; ++j) {
                float d = 0.f;
                d = dot2bf(u0[j].x, x0.x, d); d = dot2bf(u0[j].y, x0.y, d); d = dot2bf(u0[j].z, x0.z, d); d = dot2bf(u0[j].w, x0.w, d);
                d = dot2bf(u1[j].x, x1.x, d); d = dot2bf(u1[j].y, x1.y, d); d = dot2bf(u1[j].z, x1.z, d); d = dot2bf(u1[j].w, x1.w, d);
                d = wave_sum(d);
                const float cf = gg[j] * gelu_exact(d * rs);
                y[0] = fmaf(cf, bflo(v0[j].x), y[0]); y[1] = fmaf(cf, bfhi(v0[j].x), y[1]); y[2] = fmaf(cf, bflo(v0[j].y), y[2]); y[3] = fmaf(cf, bfhi(v0[j].y), y[3]);
                y[4] = fmaf(cf, bflo(v0[j].z), y[4]); y[5] = fmaf(cf, bfhi(v0[j].z), y[5]); y[6] = fmaf(cf, bflo(v0[j].w), y[6]); y[7] = fmaf(cf, bfhi(v0[j].w), y[7]);
                y[8] = fmaf(cf, bflo(v1[j].x), y[8]); y[9] = fmaf(cf, bfhi(v1[j].x), y[9]); y[10] = fmaf(cf, bflo(v1[j].y), y[10]); y[11] = fmaf(cf, bfhi(v1[j].y), y[11]);
                y[12] = fmaf(cf, bflo(v1[j].z), y[12]); y[13] = fmaf(cf, bfhi(v1[j].z), y[13]); y[14] = fmaf(cf, bflo(v1[j].w), y[14]); y[15] = fmaf(cf, bfhi(v1[j].w), y[15]);
            }
        }
        float* hp = H1 + (size_t)tok * 1024 + 8 * lane;
        f32x4 h0 = *(const f32x4*)hp, h1 = *(const f32x4*)(hp + 4), h2 = *(const f32x4*)(hp + 512), h3 = *(const f32x4*)(hp + 516);
        h0 += (f32x4){y[0], y[1], y[2], y[3]}; h1 += (f32x4){y[4], y[5], y[6], y[7]}; h2 += (f32x4){y[8], y[9], y[10], y[11]}; h3 += (f32x4){y[12], y[13], y[14], y[15]};
        float s = 0.f;
#pragma unroll
        for (int j = 0; j < 4; ++j) s += h0[j] * h0[j] + h1[j] * h1[j] + h2[j] * h2[j] + h3[j] * h3[j];
        const float rf = 1.f / sqrtf(wave_sum(s) * (1.f / 1024.f) + 1e-6f);
        const f32x4 g0 = *(const f32x4*)(gfin + 8 * lane), g1 = *(const f32x4*)(gfin + 8 * lane + 4), g2 = *(const f32x4*)(gfin + 512 + 8 * lane), g3 = *(const f32x4*)(gfin + 516 + 8 * lane);
        *(f32x4*)hp = h0 * rf * g0; *(f32x4*)(hp + 4) = h1 * rf * g1; *(f32x4*)(hp + 512) = h2 * rf * g2; *(f32x4*)(hp + 516) = h3 * rf * g3;
    }
}

#define XB_TMO      128
#define XB_XCNT(j)  (256  + 64 * (j))
#define XB_XSUB(j)  (1280 + 64 * (j))
#define XB_XGEN(j)  (2304 + 64 * (j))
#define XB_TOP      3328
#define XB_TOPGEN   3392
#define XCD_BAR_WORDS 3456
#define XB_SPIN_CAP (1u << 23)
__device__ __forceinline__ unsigned xb_ld(unsigned* p)              { return __hip_atomic_load(p, __ATOMIC_RELAXED, __HIP_MEMORY_SCOPE_AGENT); }
__device__ __forceinline__ unsigned xb_add(unsigned* p, unsigned v) { return __hip_atomic_fetch_add(p, v, __ATOMIC_RELAXED, __HIP_MEMORY_SCOPE_AGENT); }
__device__ __forceinline__ unsigned xb_xcc_id() { return (unsigned)__builtin_amdgcn_s_getreg((3 << 11) | 20) & 0xFu; }
#define XB_SPIN(cond, bar) do { unsigned _sp = 0; while (cond) { __builtin_amdgcn_s_sleep(1); \
    if ((++_sp & 255u) == 0u) { if (xb_ld(&(bar)[XB_TMO])) break; if (_sp > XB_SPIN_CAP) { atomicAdd(&(bar)[XB_TMO], 1u); break; } } } } while (0)
struct XcdBarrier { unsigned* bar; unsigned x; volatile LAS unsigned* st; };
__device__ __forceinline__ void xcd_barrier_complete(unsigned* bar, unsigned x, unsigned G, unsigned& nloc, unsigned& nx) {
    unsigned sum, cnt, mine, sp = 0u;
    for (;;) {
        sum = 0u; cnt = 0u; mine = 0u;
#pragma unroll
        for (unsigned j = 0; j < 16; ++j) { const unsigned c = xb_ld(&bar[XB_XCNT(j)]); sum += c; cnt += (c > 0u) ? 1u : 0u; mine = (j == x) ? c : mine; }
        if (sum == G) break;
        __builtin_amdgcn_s_sleep(1);
        if ((++sp & 255u) == 0u) { if (xb_ld(&bar[XB_TMO])) break; if (sp > XB_SPIN_CAP) { atomicAdd(&bar[XB_TMO], 1u); break; } }
    }
    nloc = mine > 0u ? mine : 1u; nx = cnt > 0u ? cnt : 1u;
}
__device__ __forceinline__ void xcd_barrier(const XcdBarrier& b, const bool t0, const unsigned G) {
    asm volatile("s_waitcnt vmcnt(0)" ::: "memory");
    __syncthreads();
    if (t0) {
        unsigned* bar = b.bar;
        __builtin_amdgcn_s_waitcnt(0);
        unsigned nloc = b.st[0], nx = b.st[1];
        if (nloc == 0u) { xcd_barrier_complete(bar, b.x, G, nloc, nx); b.st[0] = nloc; b.st[1] = nx; }
        const unsigned old = xb_add(&bar[XB_XSUB(b.x)], 1u);
        const unsigned gen = old / nloc;
        if (old + 1u == (gen + 1u) * nloc) {
            __builtin_amdgcn_fence(__ATOMIC_RELEASE, "agent");
            asm volatile("s_waitcnt vmcnt(0)" ::: "memory");
            const unsigned og = xb_add(&bar[XB_TOP], 1u);
            const unsigned tg = og / nx;
            if (og + 1u == (tg + 1u) * nx) xb_add(&bar[XB_TOPGEN], 1u);
            else XB_SPIN(xb_ld(&bar[XB_TOPGEN]) == tg, bar);
            __builtin_amdgcn_fence(__ATOMIC_ACQUIRE, "agent");
            xb_add(&bar[XB_XGEN(b.x)], 1u);
            asm volatile("s_waitcnt vmcnt(0)" ::: "memory");
        } else {
            XB_SPIN(xb_ld(&bar[XB_XGEN(b.x)]) == gen, bar);
            __builtin_amdgcn_fence(__ATOMIC_ACQUIRE, "agent");
            asm volatile("s_waitcnt vmcnt(0)" ::: "memory");
        }
    }
    __syncthreads();
}
constexpr size_t WS_BAR = 64 * 1024;
constexpr int LDS_BAR_OFF = 131072;

constexpr int NPH = 10;
__global__ void __launch_bounds__(NTHR, 2) fwd_kernel(Args a) {
    __shared__ __attribute__((aligned(16))) unsigned char lds_raw[LDS_BYTES];
    LAS unsigned char* lds = (LAS unsigned char*)lds_raw;
    const int G = gridDim.x;
    const int wave_s = __builtin_amdgcn_readfirstlane((int)threadIdx.x >> 6);
    const int lo = a.ph_lo, hi = a.ph_hi;
#define IN(k) (lo <= (k) && (k) < hi)
#if MK_ONE_LAUNCH
    XcdBarrier xbar; xbar.bar = (unsigned*)(a.ws + WS_BAR); xbar.st = (volatile LAS unsigned*)(lds + LDS_BAR_OFF); xbar.x = xb_xcc_id();
    { const int lane0 = pg8::get_lane(); if (wave_s == 0 && lane0 < 2) xbar.st[lane0] = 0u; __syncthreads(); if (wave_s == 0 && lane0 == 0) (void)xb_add(&xbar.bar[XB_XCNT(xbar.x)], 1u); }
#define SEAM(k) do { if (IN(k) && IN((k) + 1)) { if ((k) == 0) cg::this_grid().sync(); else { const bool t0_ = (wave_s == 0) && (pg8::get_lane() == 0); xcd_barrier(xbar, t0_, (unsigned)G); } } } while (0)
#else
#define SEAM(k) do { } while (0)
#endif
    unsigned char* ws = a.ws;
    bf16_t* XN = (bf16_t*)(ws + WS_XN);
    if (IN(0)) { p0_prologue(a, lds, G, wave_s); } SEAM(0);
    if (IN(1)) {
        pg8::Gemm g{XN, (const bf16_t*)(ws + WS_WIN), MP, INTOT, 1024, 1024, 1024}; pg8::StaticOrder S; S.init(MP, INTOT, G, (int)blockIdx.x);
        pg8::EpiZ E{(bf16_t*)(ws + WS_ZC), (bf16_t*)(ws + WS_ZR), (bf16_t*)(ws + WS_ZG)};
        pg8::gemm_phase<pg8::EpiZ, pg8::StaticOrder, true, true>(lds, g, S, E, wave_s);
    } SEAM(1);
    if (IN(2)) { p2_conv(a, lds, G, wave_s); p2_rwkv(a, G, wave_s); } SEAM(2);
    if (IN(3)) {
        pg8::Gemm g{(const bf16_t*)(ws + WS_A2), (const bf16_t*)(ws + WS_WSM), MP, 1536, 256, 256, 256}; pg8::StaticOrder S; S.init(MP, 1536, G, (int)blockIdx.x);
        pg8::EpiSmall E{a.in[10], a.in[12], a.in[16], (float*)(ws + WS_ZC), (bf16_t*)((unsigned char*)a.out + 66 * MiB), (bf16_t*)(ws + WS_ZR), (bf16_t*)(ws + WS_ZR + 33 * MiB), (const bf16_t*)(ws + WS_KK)};
        pg8::gemm_phase<pg8::EpiSmall, pg8::StaticOrder, true, true>(lds, g, S, E, wave_s);
    } SEAM(3);
    if (IN(4)) { p4_scan(a, lds, G, wave_s); } SEAM(4);
    if (IN(5)) {
        bf16_t* Mx = (bf16_t*)(ws + WS_ZR); const bf16_t* Zg = (const bf16_t*)(ws + WS_ZG);
        { pg8::Gemm g{XN, (const bf16_t*)(ws + WS_WCR), M2, 1024, 512, 1024, 1024}; pg8::StaticOrder S; S.init(M2, 1024, G, (int)blockIdx.x);
          pg8::EpiMix<0> E{Mx, Zg}; pg8::gemm_phase<pg8::EpiMix<0>, pg8::StaticOrder, true, true>(lds, g, S, E, wave_s); }
        asm volatile("s_waitcnt vmcnt(0)" ::: "memory"); __syncthreads();
        { pg8::Gemm g{XN + 512, (const bf16_t*)(ws + WS_WCR) + 512, M2, 1024, 512, 1024, 1024}; pg8::StaticOrder S; S.init(M2, 1024, G, (int)blockIdx.x);
          pg8::EpiMix<1> E{Mx, Zg}; pg8::gemm_phase<pg8::EpiMix<1>, pg8::StaticOrder, true, true>(lds, g, S, E, wave_s); }
    } SEAM(5);
    if (IN(6)) {
        pg8::Gemm g{(const bf16_t*)(ws + WS_ZR), (const bf16_t*)(ws + WS_WO), M2, 1024, 1024, 1024, 1024}; pg8::StaticOrder S; S.init(M2, 1024, G, (int)blockIdx.x);
        pg8::EpiH1 E{a.in[0], a.out, (bf16_t*)(ws + WS_ZC), (float*)(ws + WS_SSQ)};
        pg8::gemm_phase<pg8::EpiH1, pg8::StaticOrder, true, true>(lds, g, S, E, wave_s);
    } SEAM(6);
    if (IN(7)) {
        pg8::Gemm g{(const bf16_t*)(ws + WS_ZC), (const bf16_t*)(ws + WS_WQ), M2, 2048, 1024, 1024, 1024}; pg8::StaticOrder S; S.init(M2, 2048, G, (int)blockIdx.x);
        pg8::EpiQ E{(bf16_t*)(ws + WS_ZG), (const float*)(ws + WS_SSQ)};
        pg8::gemm_phase<pg8::EpiQ, pg8::StaticOrder, true, true>(lds, g, S, E, wave_s);
    } SEAM(7);
    if (IN(8)) { p9_topk(a, lds, G, wave_s); } SEAM(8);
    if (IN(9)) { p10_peer(a, G, wave_s); }
#undef IN
#undef SEAM
}

extern "C" void kernel_launch(void* const* d_in, const int* in_sizes, int n_in, void* d_out, int out_size, void* d_ws, size_t ws_size, hipStream_t stream) {
    static int grid = 0;
    if (grid == 0) {
        if (n_in != 28 || out_size != M2 * D || ws_size < WS_END) { fprintf(stderr, "kernel_launch: unexpected shapes (n_in %d out %d ws %zu)\n", n_in, out_size, ws_size); grid = -1; return; }
        int dev = 0, cus = 0, per_cu = 0;
        if (hipGetDevice(&dev) != hipSuccess || hipDeviceGetAttribute(&cus, hipDeviceAttributeMultiprocessorCount, dev) != hipSuccess) { grid = -1; return; }
        if (hipOccupancyMaxActiveBlocksPerMultiprocessor(&per_cu, (const void*)fwd_kernel, NTHR, 0) != hipSuccess || per_cu < 1) { fprintf(stderr, "kernel_launch: occupancy query says %d blocks per CU\n", per_cu); (void)hipGetLastError(); grid = -1; return; }
        grid = cus;
    }
    if (grid < 0) return;
    (void)hipMemsetAsync((char*)d_ws + WS_CTL, 0, CTL_ZERO_BYTES, stream);
    Args a{};
    for (int i = 0; i < 28; ++i) a.in[i] = (const float*)d_in[i];
    a.out = (float*)d_out; a.ws = (unsigned char*)d_ws;
#if MK_ONE_LAUNCH
    a.ph_lo = 0; a.ph_hi = NPH;
    void* args[] = {&a};
    hipError_t e = hipLaunchCooperativeKernel((const void*)fwd_kernel, dim3(grid), dim3(NTHR), args, 0, stream);
    if (e != hipSuccess) fprintf(stderr, "kernel_launch: cooperative launch failed: %s (grid %d)\n", hipGetErrorString(e), grid);
#else
#ifndef MK_PH_HI
#define MK_PH_HI NPH
#endif
#ifndef MK_PH_LO
#define MK_PH_LO 0
#endif
    for (int ph = MK_PH_LO; ph < MK_PH_HI; ++ph) { a.ph_lo = ph; a.ph_hi = ph + 1; hipLaunchKernelGGL(fwd_kernel, dim3(grid), dim3(NTHR), 0, stream, a); }
#endif
}
```

```cpp
#include <hip/hip_runtime.h>
#include <hip/hip_cooperative_groups.h>
#include <cstdio>
#include <cstdint>
namespace cg = cooperative_groups;

#ifndef MK_ONE_LAUNCH
#define MK_ONE_LAUNCH 1
#endif

#define LAS __attribute__((address_space(3)))
#define LDS_WAIT() asm volatile("s_waitcnt lgkmcnt(0)" ::: "memory")

namespace pg8 {
#define PG8_LAS __attribute__((address_space(3)))
typedef unsigned short bf16_t;
typedef short bf16x8 __attribute__((ext_vector_type(8)));
typedef float f32x4 __attribute__((ext_vector_type(4)));
typedef unsigned u32x4 __attribute__((ext_vector_type(4)));
constexpr int BM = 256, BK = 64, HALF = 128, HTB = HALF * BK * 2  , STAGE_BYTES = 8 * HTB, NXCD = 8, WGM = 8;

__host__ __device__ __forceinline__ int lds_byte(int r, int c) { const int st = (r >> 4) * 2 + (c >> 5), rr = r & 15, cc = c & 31, ob = rr * 64 + cc * 2; return st * 1024 + (ob ^ (((ob >> 9) & 1) << 5)); }
__host__ __device__ __forceinline__ void stage_rc(int b, int& R, int& C) { const int st = b / 1024, sb = b % 1024, swz = sb ^ (((sb >> 9) & 1) << 5); R = (st >> 1) * 16 + swz / 64; C = (st & 1) * 32 + (swz % 64) / 2; }
__host__ __device__ __forceinline__ int perm32(int rho) { const int n = rho >> 4, i = rho & 15; return 8 * (i >> 2) + 4 * n + (i & 3); }

struct Unit { int pm, pn; };
struct Gemm { const bf16_t* A; const bf16_t* Bt; int M, N, K, lda, ldb; const bf16_t* A2 = nullptr; };

struct StaticOrder {
    int nM, nN, nwg, G, c;
    __host__ __device__ void init(int M, int N, int G_, int c_) { nM = M / BM; nN = N / BM; nwg = nM * nN; G = G_; c = c_; }
    __host__ __device__ bool next(int i, Unit& u) const {
        const long L = (long)i * G + c; if (L >= nwg) return false;
        int wgid = (int)L; { const int q = nwg / NXCD, r = nwg % NXCD, xcd = wgid % NXCD, off = wgid / NXCD; wgid = (xcd < r ? xcd * (q + 1) : r * (q + 1) + (xcd - r) * q) + off; }
        const int nig = WGM * nN, gid = wgid / nig, fm = gid * WGM, gsz = (nM - fm) < WGM ? (nM - fm) : WGM;
        u.pm = fm + ((wgid % nig) % gsz); u.pn = (wgid % nig) / gsz; return true;
    }
    __device__ __forceinline__ void a_ready(const Unit&) const {}
    __device__ __forceinline__ void done(const Unit&) const {}
};

typedef float f32x2_cv __attribute__((ext_vector_type(2)));
typedef __bf16 bf16x2_cv __attribute__((ext_vector_type(2)));
__device__ __forceinline__ unsigned cvt_pk_bf16(float lo, float hi) { const f32x2_cv v = {lo, hi}; const bf16x2_cv b = __builtin_convertvector(v, bf16x2_cv); return __builtin_bit_cast(unsigned, b); }
__device__ __forceinline__ void store8(bf16_t* p, const f32x4 v0, const f32x4 v1) {
    u32x4 w; w.x = cvt_pk_bf16(v0[0], v0[1]); w.y = cvt_pk_bf16(v0[2], v0[3]); w.z = cvt_pk_bf16(v1[0], v1[1]); w.w = cvt_pk_bf16(v1[2], v1[3]);
    *(u32x4*)p = w;
}
__device__ __forceinline__ float bflo(unsigned w) { return __builtin_bit_cast(float, w << 16); }
__device__ __forceinline__ float bfhi(unsigned w) { return __builtin_bit_cast(float, w & 0xffff0000u); }
__device__ __forceinline__ void load8(const bf16_t* p, f32x4& v0, f32x4& v1) {
    const u32x4 w = *(const u32x4*)p;
    v0 = (f32x4){bflo(w.x), bfhi(w.x), bflo(w.y), bfhi(w.y)}; v1 = (f32x4){bflo(w.z), bfhi(w.z), bflo(w.w), bfhi(w.w)};
}
__device__ __forceinline__ float sigm(float x) { return __builtin_amdgcn_rcpf(1.f + __expf(-x)); }
__device__ __forceinline__ int get_lane() { unsigned m = 0xffffffffu; asm volatile("" : "+s"(m)); return (int)__builtin_amdgcn_mbcnt_hi(m, __builtin_amdgcn_mbcnt_lo(m, 0u)); }
__device__ __forceinline__ void lane_ids(int& fr, int& fq) { const int lane = get_lane(); fr = lane & 15; fq = lane >> 4; }


struct EpiZ {
    static constexpr bool PERM = true, AFTER_DRAIN = false, HAS_MID = false;
    bf16_t *Zc, *Zr, *Zg; int pn_off;
    __device__ __forceinline__ void operator()(const f32x4 (&acc)[2][2][4][2], const Unit& u, int wr, int wc, int, int) const {
        int fr, fq; lane_ids(fr, fq);
        const int pn = u.pn + pn_off;
        if (pn < 4) {
            const int row0 = u.pm * BM + wr * 64 + fr, col0 = pn * 128 + wc * 32 + 8 * fq;
#pragma unroll
            for (int ai = 0; ai < 2; ++ai)
#pragma unroll
                for (int m = 0; m < 4; ++m) { f32x4 u0, u1;
#pragma unroll
                    for (int j = 0; j < 4; ++j) { u0[j] = acc[ai][0][m][0][j] * sigm(acc[ai][1][m][0][j]); u1[j] = acc[ai][0][m][1][j] * sigm(acc[ai][1][m][1][j]); }
                    store8(Zc + (size_t)(row0 + ai * HALF + m * 16) * 512 + col0, u0, u1); }
        } else if (pn < 11) {
            bf16_t* base = Zr; const int ldc = 1792, colt = (pn - 4) * 256;
            const int row0 = u.pm * BM + wr * 64 + fr, col0 = colt + wc * 32 + 8 * fq;
#pragma unroll
            for (int ai = 0; ai < 2; ++ai)
#pragma unroll
                for (int m = 0; m < 4; ++m) { bf16_t* rowp = base + (size_t)(row0 + ai * HALF + m * 16) * ldc + col0;
#pragma unroll
                    for (int bj = 0; bj < 2; ++bj) store8(rowp + bj * HALF, acc[ai][bj][m][0], acc[ai][bj][m][1]); }
        } else {
            const int row0 = u.pm * BM + wr * 64 + fr, col0 = (pn - 11) * 128 + wc * 32 + 8 * fq;
#pragma unroll
            for (int ai = 0; ai < 2; ++ai)
#pragma unroll
                for (int m = 0; m < 4; ++m) { bf16_t* rowp = Zg + (size_t)(row0 + ai * HALF + m * 16) * 2048 + col0;
                    f32x4 r0, r1, b0, b1;
#pragma unroll
                    for (int j = 0; j < 4; ++j) { const float ea0 = __expf(fminf(-acc[ai][0][m][0][j], 60.f)), ea1 = __expf(fminf(-acc[ai][0][m][1][j], 60.f)), eb0 = __expf(fminf(-acc[ai][1][m][0][j], 60.f)), eb1 = __expf(fminf(-acc[ai][1][m][1][j], 60.f));
                        r0[j] = (1.f + eb0) * __builtin_amdgcn_rcpf(1.f + ea0); r1[j] = (1.f + eb1) * __builtin_amdgcn_rcpf(1.f + ea1);
                        b0[j] = __builtin_amdgcn_rcpf(1.f + eb0); b1[j] = __builtin_amdgcn_rcpf(1.f + eb1); }
                    store8(rowp, r0, r1); store8(rowp + 1024, b0, b1); }
        }
    }
};

template <bool DRY = false> struct EpiSmallT {
    static constexpr bool PERM = true, AFTER_DRAIN = false, HAS_MID = false;
    const float *w0, *a0, *k_a; float* E; bf16_t *Kb, *Bb, *Gb; const bf16_t* KKb;
    __device__ __forceinline__ void operator()(const f32x4 (&acc)[2][2][4][2], const Unit& u, int wr, int wc, int, int) const {
        int fr, fq; lane_ids(fr, fq);
        const int pn = u.pn, kind = pn >> 1;
        const int row0 = u.pm * BM + wr * 64 + fr, col0 = (pn & 1) * 256 + wc * 32 + 8 * fq;
        if (kind == 0) {
            f32x4 p[2][2];
#pragma unroll
            for (int bj = 0; bj < 2; ++bj) { p[bj][0] = *(const f32x4*)(w0 + col0 + bj * HALF); p[bj][1] = *(const f32x4*)(w0 + col0 + bj * HALF + 4); }
#pragma unroll
            for (int ai = 0; ai < 2; ++ai)
#pragma unroll
                for (int m = 0; m < 4; ++m) { const size_t rowoff = (size_t)(row0 + ai * HALF + m * 16) * 512;
#pragma unroll
                    for (int bj = 0; bj < 2; ++bj) { const int c = col0 + bj * HALF; f32x4 v0 = acc[ai][bj][m][0], v1 = acc[ai][bj][m][1];
#pragma unroll
                        for (int j = 0; j < 4; ++j) { v0[j] = 0.60653065971f * sigm(p[bj][0][j] + v0[j]); v1[j] = 0.60653065971f * sigm(p[bj][1][j] + v1[j]); }
                        *(f32x4*)(E + rowoff + c) = v0; *(f32x4*)(E + rowoff + c + 4) = v1; } }
        } else if (kind == 1) {
            f32x4 p[2][2], q[2][2];
#pragma unroll
            for (int bj = 0; bj < 2; ++bj) { const int c = col0 + bj * HALF; p[bj][0] = *(const f32x4*)(a0 + c); p[bj][1] = *(const f32x4*)(a0 + c + 4); q[bj][0] = *(const f32x4*)(k_a + c); q[bj][1] = *(const f32x4*)(k_a + c + 4); }
#pragma unroll
            for (int am = 0; am < 4; ++am) { const int ai = am >> 1;
                u32x4 kw[4][2], kkw[4][2];
#pragma unroll
                for (int m = 2 * (am & 1); m < 2 * (am & 1) + 2; ++m) { const size_t rowoff = (size_t)(row0 + ai * HALF + m * 16) * 512;
#pragma unroll
                    for (int bj = 0; bj < 2; ++bj) { const int c = col0 + bj * HALF; kw[m][bj] = *(const u32x4*)(Kb + rowoff + c); kkw[m][bj] = *(const u32x4*)(KKb + rowoff + c); } }
#pragma unroll
                for (int m = 2 * (am & 1); m < 2 * (am & 1) + 2; ++m) { const size_t rowoff = (size_t)(row0 + ai * HALF + m * 16) * 512;
#pragma unroll
                    for (int bj = 0; bj < 2; ++bj) { const int c = col0 + bj * HALF; const f32x4 v0 = acc[ai][bj][m][0], v1 = acc[ai][bj][m][1];
                        const u32x4 kx = kw[m][bj], kkx = kkw[m][bj];
                        const f32x4 k0 = {bflo(kx.x), bfhi(kx.x), bflo(kx.y), bfhi(kx.y)}, k1 = {bflo(kx.z), bfhi(kx.z), bflo(kx.w), bfhi(kx.w)};
                        const f32x4 kk0 = {bflo(kkx.x), bfhi(kkx.x), bflo(kkx.y), bfhi(kkx.y)}, kk1 = {bflo(kkx.z), bfhi(kkx.z), bflo(kkx.w), bfhi(kkx.w)};
                        f32x4 km0, km1, b0, b1;
#pragma unroll
                        for (int j = 0; j < 4; ++j) { const float a_0 = sigm(p[bj][0][j] + v0[j]), a_1 = sigm(p[bj][1][j] + v1[j]);
                            km0[j] = k0[j] * (1.f + (a_0 - 1.f) * q[bj][0][j]); km1[j] = k1[j] * (1.f + (a_1 - 1.f) * q[bj][1][j]); b0[j] = kk0[j] * a_0; b1[j] = kk1[j] * a_1; }
                        if (!DRY) store8(Kb + rowoff + c, km0, km1); store8(Bb + rowoff + c, b0, b1); } }
            }
        } else {
#pragma unroll
            for (int ai = 0; ai < 2; ++ai)
#pragma unroll
                for (int m = 0; m < 4; ++m) { const size_t rowoff = (size_t)(row0 + ai * HALF + m * 16) * 512;
#pragma unroll
                    for (int bj = 0; bj < 2; ++bj) store8(Gb + rowoff + col0 + bj * HALF, acc[ai][bj][m][0], acc[ai][bj][m][1]); }
        }
    }
};
typedef EpiSmallT<false> EpiSmall;

struct EpiG {
    static constexpr bool PERM = true, AFTER_DRAIN = false, HAS_MID = false;
    bf16_t* Gb;
    __device__ __forceinline__ void operator()(const f32x4 (&acc)[2][2][4][2], const Unit& u, int wr, int wc, int, int) const {
        int fr, fq; lane_ids(fr, fq);
        const int row0 = u.pm * BM + wr * 64 + fr, col0 = u.pn * BM + wc * 32 + 8 * fq;
#pragma unroll
        for (int ai = 0; ai < 2; ++ai)
#pragma unroll
            for (int m = 0; m < 4; ++m) { bf16_t* op = Gb + (size_t)(row0 + ai * HALF + m * 16) * 512 + col0;
#pragma unroll
                for (int bj = 0; bj < 2; ++bj) store8(op + bj * HALF, acc[ai][bj][m][0], acc[ai][bj][m][1]); }
    }
};

__device__ __forceinline__ int mfull_of(int m2) { return m2 + 16 * ((m2 >> 12) + 1); }

template <int MODE> struct EpiMix {
    static constexpr bool PERM = true, AFTER_DRAIN = false, HAS_MID = false;
    bf16_t* Mx; const bf16_t* Zg;
    __device__ __forceinline__ void operator()(const f32x4 (&acc)[2][2][4][2], const Unit& u, int wr, int wc, int, int) const {
        int fr, fq; lane_ids(fr, fq);
        const int row0 = u.pm * BM + wr * 64 + fr, col0 = u.pn * BM + wc * 32 + 8 * fq;
#pragma unroll
        for (int ai = 0; ai < 2; ++ai)
#pragma unroll
            for (int m = 0; m < 4; ++m) { const int row = row0 + ai * HALF + m * 16; const bf16_t* gp = Zg + (size_t)mfull_of(row) * 2048 + MODE * 1024 + col0; bf16_t* op = Mx + (size_t)row * 1024 + col0;
#pragma unroll
                for (int bj = 0; bj < 2; ++bj) { f32x4 g0, g1; load8(gp + bj * HALF, g0, g1); f32x4 v0 = acc[ai][bj][m][0] * g0, v1 = acc[ai][bj][m][1] * g1;
                    if (MODE == 1) { f32x4 o0, o1; load8(op + bj * HALF, o0, o1); v0 += o0; v1 += o1; }
                    store8(op + bj * HALF, v0, v1); } }
    }
};

struct EpiMixF {
    static constexpr bool PERM = true, AFTER_DRAIN = false, HAS_MID = true;
    bf16_t* Mx; const bf16_t* Zg;
    __device__ __forceinline__ void mid(f32x4 (&acc)[2][2][4][2], const Unit& u, int wr, int wc) const {
        int fr, fq; lane_ids(fr, fq);
        const int row0 = u.pm * BM + wr * 64 + fr, col0 = u.pn * BM + wc * 32 + 8 * fq;
        u32x4 rw[2][4][2];
#pragma unroll
        for (int ai = 0; ai < 2; ++ai)
#pragma unroll
            for (int m = 0; m < 4; ++m) { const bf16_t* gp = Zg + (size_t)mfull_of(row0 + ai * HALF + m * 16) * 2048 + col0;
#pragma unroll
                for (int bj = 0; bj < 2; ++bj) rw[ai][m][bj] = *(const u32x4*)(gp + bj * HALF); }
#pragma unroll
        for (int ai = 0; ai < 2; ++ai)
#pragma unroll
            for (int m = 0; m < 4; ++m)
#pragma unroll
                for (int bj = 0; bj < 2; ++bj) { const u32x4 w = rw[ai][m][bj];
                    acc[ai][bj][m][0] *= (f32x4){bflo(w.x), bfhi(w.x), bflo(w.y), bfhi(w.y)}; acc[ai][bj][m][1] *= (f32x4){bflo(w.z), bfhi(w.z), bflo(w.w), bfhi(w.w)}; }
    }
    __device__ __forceinline__ void operator()(const f32x4 (&acc)[2][2][4][2], const Unit& u, int wr, int wc, int, int) const {
        int fr, fq; lane_ids(fr, fq);
        const int row0 = u.pm * BM + wr * 64 + fr, col0 = u.pn * BM + wc * 32 + 8 * fq;
        u32x4 gw[2][4][2];
#pragma unroll
        for (int ai = 0; ai < 2; ++ai)
#pragma unroll
            for (int m = 0; m < 4; ++m) { const int row = row0 + ai * HALF + m * 16; const bf16_t* gp = Zg + (size_t)mfull_of(row) * 2048 + 1024 + col0;
#pragma unroll
                for (int bj = 0; bj < 2; ++bj) gw[ai][m][bj] = *(const u32x4*)(gp + bj * HALF); }
#pragma unroll
        for (int ai = 0; ai < 2; ++ai)
#pragma unroll
            for (int m = 0; m < 4; ++m) { const int row = row0 + ai * HALF + m * 16; bf16_t* op = Mx + (size_t)row * 1024 + col0;
#pragma unroll
                for (int bj = 0; bj < 2; ++bj) { const u32x4 w = gw[ai][m][bj]; const f32x4 g0 = {bflo(w.x), bfhi(w.x), bflo(w.y), bfhi(w.y)}, g1 = {bflo(w.z), bfhi(w.z), bflo(w.w), bfhi(w.w)};
                    store8(op + bj * HALF, acc[ai][bj][m][0] * g0, acc[ai][bj][m][1] * g1); } }
    }
};

struct EpiH1 {
    static constexpr bool PERM = true, AFTER_DRAIN = false, HAS_MID = false;
    const float* X; float* H1; bf16_t* H1b; float* ssq;
    __device__ __forceinline__ void operator()(const f32x4 (&acc)[2][2][4][2], const Unit& u, int wr, int wc, int, int) const {
        int fr, fq; lane_ids(fr, fq);
        const int row0 = u.pm * BM + wr * 64 + fr, col0 = u.pn * BM + wc * 32 + 8 * fq;
#pragma unroll
        for (int ai = 0; ai < 2; ++ai)
        {   f32x4 xv[4][2][2];
#pragma unroll
            for (int m = 0; m < 4; ++m) { const size_t off = (size_t)(row0 + ai * HALF + m * 16) * 1024 + col0;
#pragma unroll
                for (int bj = 0; bj < 2; ++bj) { xv[m][bj][0] = *(const f32x4*)(X + off + bj * HALF); xv[m][bj][1] = *(const f32x4*)(X + off + bj * HALF + 4); } }
#pragma unroll
            for (int m = 0; m < 4; ++m) { const int row = row0 + ai * HALF + m * 16; const size_t off = (size_t)row * 1024 + col0; float s = 0.f;
#pragma unroll
                for (int bj = 0; bj < 2; ++bj) {
                    const f32x4 v0 = acc[ai][bj][m][0] + xv[m][bj][0], v1 = acc[ai][bj][m][1] + xv[m][bj][1];
                    store8(H1b + off + bj * HALF, v0, v1);
                    s += (v0[0] * v0[0] + v0[1] * v0[1]) + (v0[2] * v0[2] + v0[3] * v0[3]) + (v1[0] * v1[0] + v1[1] * v1[1]) + (v1[2] * v1[2] + v1[3] * v1[3]); }
                s += __shfl_xor(s, 16); s += __shfl_xor(s, 32);
                if (fq == 0) atomicAdd(ssq + row, s); }
        }
    }
};

struct EpiQ {
    static constexpr bool PERM = true, AFTER_DRAIN = false, HAS_MID = false;
    bf16_t* Q; const float* ssq;
    __device__ __forceinline__ void operator()(const f32x4 (&acc)[2][2][4][2], const Unit& u, int wr, int wc, int, int) const {
        int fr, fq; lane_ids(fr, fq);
        const int row0 = u.pm * BM + wr * 64 + fr, col0 = u.pn * BM + wc * 32 + 8 * fq;
#pragma unroll
        for (int ai = 0; ai < 2; ++ai)
#pragma unroll
            for (int m = 0; m < 4; ++m) { bf16_t* op = Q + (size_t)(row0 + ai * HALF + m * 16) * 2048 + col0;
#pragma unroll
                for (int bj = 0; bj < 2; ++bj) store8(op + bj * HALF, acc[ai][bj][m][0], acc[ai][bj][m][1]); }
    }
};

template <class Epi, class Sched, bool ALIGN_EPI = false, bool SP2 = false>
__device__ __forceinline__ void gemm_phase(PG8_LAS unsigned char* lds, const Gemm g, const Sched& S, const Epi& E, const int wave_s) {
    const int wid = wave_s, lane = get_lane(), tid = wid * 64 + lane, wr = wid >> 2, wc = wid & 3, fr = lane & 15, fq = lane >> 4;
    const int K = g.K, nt = K / BK;
    unsigned voffA[2], voffB[2];
#pragma unroll
    for (int i = 0; i < 2; ++i) { int R, C; stage_rc(tid * 16 + i * 8192, R, C); const int Rb = Epi::PERM ? ((R & ~31) + perm32(R & 31)) : R;
        voffA[i] = (unsigned)(R * g.lda + C) * 2u; voffB[i] = (unsigned)(Rb * g.ldb + C) * 2u; }
    const size_t kstep = (size_t)(BK * 2);
    const size_t hstepA = (size_t)HALF * g.lda * 2, hstepB = (size_t)HALF * g.ldb * 2;
    const size_t tstepA = 2 * hstepA, tstepB = 2 * hstepB;
    const unsigned ldsw = (unsigned)wid * 1024u;
    const int aoff = lds_byte(wr * 64 + fr, fq * 8), boff = lds_byte(wc * 32 + fr, fq * 8);
#define PG8_SA(b, h) (((b) * 2 + (h)) * HTB)
#define PG8_SB(b, h) ((4 + (b) * 2 + (h)) * HTB)
#define PG8_STAGE(bufoff, gbase, voff) do { _Pragma("unroll") for (int _i = 0; _i < 2; ++_i) \
        __builtin_amdgcn_global_load_lds((const unsigned*)((const char*)(gbase) + (voff)[_i]), (PG8_LAS unsigned*)(lds + (bufoff) + ldsw + _i * 8192), 16, 0, 0); } while (0)
#define PG8_LDA(dst, b, h) do { unsigned _ab = (unsigned)(PG8_SA(b, h) + aoff); asm volatile("" : "+v"(_ab)); _Pragma("unroll") for (int m = 0; m < 4; ++m) _Pragma("unroll") for (int k = 0; k < 2; ++k) dst[m][k] = *(const PG8_LAS bf16x8*)(lds + _ab + m * 2048 + k * 1024); } while (0)
#define PG8_LDB(dst, b, h) do { unsigned _bb = (unsigned)(PG8_SB(b, h) + boff); asm volatile("" : "+v"(_bb)); _Pragma("unroll") for (int n = 0; n < 2; ++n) _Pragma("unroll") for (int k = 0; k < 2; ++k) dst[n][k] = *(const PG8_LAS bf16x8*)(lds + _bb + n * 2048 + k * 1024); } while (0)
#define PG8_MMA(ai, bj, At, Bt) do { __builtin_amdgcn_s_setprio(1); _Pragma("unroll") for (int m = 0; m < 4; ++m) _Pragma("unroll") for (int n = 0; n < 2; ++n) _Pragma("unroll") for (int k = 0; k < 2; ++k) \
        acc[ai][bj][m][n] = __builtin_amdgcn_mfma_f32_16x16x32_bf16(Bt[n][k], At[m][k], acc[ai][bj][m][n], 0, 0, 0); __builtin_amdgcn_s_setprio(0); } while (0)
#define PG8_WAIT_V(n) asm volatile("s_waitcnt vmcnt(" #n ")" ::: "memory")
#define PG8_WAIT_L(n) asm volatile("s_waitcnt lgkmcnt(" #n ")" ::: "memory")
#define PG8_BAR __builtin_amdgcn_s_barrier()
#define PG8_SCHED __builtin_amdgcn_sched_barrier(0)
    Unit cur, nxt; int ui = 0;
    if (!S.next(0, cur)) return;
    f32x4 acc[2][2][4][2];
#pragma unroll
    for (int a = 0; a < 2; ++a)
#pragma unroll
        for (int b = 0; b < 2; ++b)
#pragma unroll
            for (int m = 0; m < 4; ++m)
#pragma unroll
                for (int n = 0; n < 2; ++n) acc[a][b][m][n] = (f32x4){0.f, 0.f, 0.f, 0.f};
    bf16x8 At[4][2], B0[2][2], B1[2][2];
    const char* cA = (const char*)g.A + (size_t)cur.pm * tstepA; const char* cB = (const char*)g.Bt + (size_t)cur.pn * tstepB;
    S.a_ready(cur);
    if constexpr (SP2) {
        PG8_STAGE(PG8_SB(0, 0), cB, voffB); PG8_STAGE(PG8_SB(0, 1), cB + hstepB, voffB); PG8_STAGE(PG8_SA(0, 0), cA, voffA); PG8_STAGE(PG8_SA(0, 1), cA + hstepA, voffA);
        if (wr == 1) PG8_BAR;
        PG8_WAIT_V(2); PG8_BAR;
        PG8_STAGE(PG8_SB(1, 0), cB + kstep, voffB); PG8_STAGE(PG8_SA(1, 0), cA + kstep, voffA); PG8_STAGE(PG8_SB(1, 1), cB + hstepB + kstep, voffB);
        PG8_WAIT_V(6); PG8_BAR;
    } else {
        PG8_STAGE(PG8_SB(0, 0), cB, voffB); PG8_STAGE(PG8_SA(0, 0), cA, voffA); PG8_STAGE(PG8_SB(0, 1), cB + hstepB, voffB); PG8_STAGE(PG8_SA(0, 1), cA + hstepA, voffA);
        if (wr == 1) PG8_BAR;
        PG8_WAIT_V(4); PG8_BAR;
        PG8_STAGE(PG8_SB(1, 0), cB + kstep, voffB); PG8_STAGE(PG8_SA(1, 0), cA + kstep, voffA); PG8_STAGE(PG8_SB(1, 1), cB + hstepB + kstep, voffB);
        PG8_WAIT_V(6); PG8_BAR;
    }
    for (;;) {
        const bool has_next = S.next(ui + 1, nxt);
        const char* nA = has_next ? (const char*)g.A + (size_t)nxt.pm * tstepA : cA; const char* nB = has_next ? (const char*)g.Bt + (size_t)nxt.pn * tstepB : cB;
        for (int t = 0; t < nt; t += 2) {
            const bool last = (t == nt - 2);
            const char* cA2 = g.A2 ? (const char*)g.A2 + (cA - (const char*)g.A) - (size_t)(nt / 2) * kstep : cA;
            const int nh = g.A2 ? nt / 2 : nt;
            const char* a1 = ((t + 1 < nh) ? cA : cA2) + (size_t)(t + 1) * kstep;
            const char* a2 = last ? nA : ((t + 2 < nh) ? cA : cA2) + (size_t)(t + 2) * kstep; const char* b2 = last ? nB : cB + (size_t)(t + 2) * kstep;
            const char* a3 = a2 + kstep; const char* b3 = b2 + kstep;
            if (last && has_next) S.a_ready(nxt);
            if constexpr (Epi::HAS_MID) { if (t == nt / 2) E.mid(acc, cur, wr, wc); }
            if constexpr (SP2) {
            PG8_LDB(B0, 0, 0); PG8_LDB(B1, 0, 1); PG8_SCHED; PG8_LDA(At, 0, 0); PG8_STAGE(PG8_SA(1, 1), a1 + hstepA, voffA);
            PG8_WAIT_V(8); PG8_WAIT_L(0); PG8_BAR; PG8_MMA(0, 0, At, B0); PG8_MMA(0, 1, At, B1); PG8_BAR; PG8_SCHED;
            PG8_LDA(At, 0, 1); PG8_STAGE(PG8_SB(0, 0), b2, voffB); PG8_STAGE(PG8_SB(0, 1), b2 + hstepB, voffB); PG8_STAGE(PG8_SA(0, 0), a2, voffA);
            PG8_WAIT_V(8); PG8_WAIT_L(0); PG8_BAR; PG8_MMA(1, 0, At, B0); PG8_MMA(1, 1, At, B1); PG8_BAR; PG8_SCHED;
            PG8_LDB(B0, 1, 0); PG8_LDB(B1, 1, 1); PG8_SCHED; PG8_LDA(At, 1, 0); PG8_STAGE(PG8_SA(0, 1), a2 + hstepA, voffA);
            PG8_WAIT_V(8); PG8_WAIT_L(0); PG8_BAR; PG8_MMA(0, 0, At, B0); PG8_MMA(0, 1, At, B1); PG8_BAR; PG8_SCHED;
            PG8_LDA(At, 1, 1); PG8_STAGE(PG8_SB(1, 0), b3, voffB); PG8_STAGE(PG8_SB(1, 1), b3 + hstepB, voffB); PG8_STAGE(PG8_SA(1, 0), a3, voffA);
            PG8_WAIT_V(8); PG8_WAIT_L(0); PG8_BAR; PG8_MMA(1, 0, At, B0); PG8_MMA(1, 1, At, B1); PG8_BAR; PG8_SCHED;
            } else {
            PG8_LDB(B0, 0, 0); PG8_SCHED; PG8_LDA(At, 0, 0); PG8_STAGE(PG8_SA(1, 1), a1 + hstepA, voffA);
            PG8_WAIT_L(8); PG8_BAR; PG8_WAIT_L(0); PG8_MMA(0, 0, At, B0); PG8_BAR; PG8_SCHED;
            PG8_LDB(B1, 0, 1); PG8_STAGE(PG8_SB(0, 0), b2, voffB);
            PG8_BAR; PG8_WAIT_L(0); PG8_MMA(0, 1, At, B1); PG8_BAR;
            PG8_LDA(At, 0, 1); PG8_STAGE(PG8_SA(0, 0), a2, voffA);
            PG8_BAR; PG8_WAIT_L(0); PG8_MMA(1, 0, At, B0); PG8_BAR; PG8_SCHED;
            PG8_STAGE(PG8_SB(0, 1), b2 + hstepB, voffB);
            PG8_WAIT_V(6); PG8_BAR; PG8_MMA(1, 1, At, B1); PG8_BAR;
            PG8_LDB(B0, 1, 0); PG8_SCHED; PG8_LDA(At, 1, 0); PG8_STAGE(PG8_SA(0, 1), a2 + hstepA, voffA);
            PG8_WAIT_L(8); PG8_BAR; PG8_WAIT_L(0); PG8_MMA(0, 0, At, B0); PG8_BAR; PG8_SCHED;
            PG8_LDB(B1, 1, 1); PG8_STAGE(PG8_SB(1, 0), b3, voffB);
            PG8_BAR; PG8_WAIT_L(0); PG8_MMA(0, 1, At, B1); PG8_BAR;
            PG8_LDA(At, 1, 1); PG8_STAGE(PG8_SA(1, 0), a3, voffA);
            PG8_BAR; PG8_WAIT_L(0); PG8_MMA(1, 0, At, B0); PG8_BAR; PG8_SCHED;
            PG8_STAGE(PG8_SB(1, 1), b3 + hstepB, voffB);
            PG8_WAIT_V(6); PG8_BAR; PG8_MMA(1, 1, At, B1); PG8_BAR;
            }
        }
        if constexpr (ALIGN_EPI) { if (wr == 0) PG8_BAR; }
        if constexpr (!Epi::AFTER_DRAIN) { E(acc, cur, wr, wc, fr, fq); S.done(cur); }
        if (!has_next) break;
#pragma unroll
        for (int a = 0; a < 2; ++a)
#pragma unroll
            for (int b = 0; b < 2; ++b)
#pragma unroll
                for (int m = 0; m < 4; ++m)
#pragma unroll
                    for (int n = 0; n < 2; ++n) acc[a][b][m][n] = (f32x4){0.f, 0.f, 0.f, 0.f};
        cur = nxt; cA = nA; cB = nB; ++ui;
        if constexpr (ALIGN_EPI) { if (wr == 1) PG8_BAR; }
    }
    PG8_WAIT_V(0);
    if constexpr (!ALIGN_EPI) { if (wr == 0) PG8_BAR; }
    PG8_BAR;
    if constexpr (Epi::AFTER_DRAIN) { E.fused(acc, cur, wr, wc, fr, fq, lds, wid, lane); S.done(cur); }
#undef PG8_SA
#undef PG8_SB
#undef PG8_STAGE
#undef PG8_LDA
#undef PG8_LDB
#undef PG8_MMA
#undef PG8_WAIT_V
#undef PG8_WAIT_L
#undef PG8_BAR
#undef PG8_SCHED
}
}

typedef pg8::bf16_t bf16_t;
typedef pg8::f32x4 f32x4;
typedef pg8::u32x4 u32x4;
typedef pg8::bf16x8 bf16x8;
typedef unsigned u32x2 __attribute__((ext_vector_type(2)));
using pg8::bflo; using pg8::bfhi; using pg8::cvt_pk_bf16; using pg8::sigm; using pg8::load8; using pg8::store8;

constexpr int D = 1024, NB = 8, SEQ = 4096, NMETA = 16, T = SEQ + NMETA  , MT = NB * T  , MP = 33024  , M2 = NB * SEQ  ;
constexpr int INTOT = 4864, CCH = 512, RWW = 512, RWIN = 1792, NHEAD = 8;
constexpr int PH = 8, PK = 128, PDH = 128, PTOPK = 16, NEXP = 16384;
constexpr int NWAVES = 8, NTHR = 512;
constexpr int LDS_BYTES = 147456;

constexpr size_t MiB = 1u << 20;
constexpr size_t WS_CTL = 0, CTL_ZERO_BYTES = 1 * MiB;
constexpr size_t WS_SSQ = 256 * 1024;
constexpr size_t WS_SSQ2 = 512 * 1024;
constexpr size_t WS_WIN = 1 * MiB;
constexpr size_t WS_WCR = 11 * MiB;
constexpr size_t WS_WO = 13 * MiB;
constexpr size_t WS_WQ = 15 * MiB;
constexpr size_t WS_SK = 19 * MiB;
constexpr size_t WS_WSM = 19 * MiB + 512 * 1024;
constexpr size_t WS_EU = 20 * MiB + 256 * 1024, WS_EV = WS_EU + 16 * MiB + 256 * 1024;
constexpr size_t WS_ACL = 53 * MiB;
constexpr size_t WS_EU_OLD_ = 0, WS_EV_OLD_ = 0;
constexpr size_t WS_XN = 85 * MiB;
constexpr size_t WS_ZG = 150 * MiB;
constexpr size_t WS_ZR = 279 * MiB;
constexpr size_t WS_ZC = 392 * MiB;
constexpr size_t WS_KK = 457 * MiB;
constexpr size_t WS_A2 = 490 * MiB;
constexpr size_t WS_RK = 507 * MiB + 256 * 1024;
constexpr size_t WS_EM = WS_ZC + 32 * MiB + 512 * 1024;
constexpr size_t WS_WC = WS_A2 + 13 * MiB + 64 * 1024;
constexpr size_t WS_ORAW = 345 * MiB;
constexpr size_t WS_END = 509 * MiB;

struct Args { const float* in[28]; float* out; unsigned char* ws; int ph_lo, ph_hi; };

__device__ __forceinline__ float dpp_f(float x, const int ctrl_sel) { return x; }
#define DPP_ADD(x, ctrl) ((x) + __builtin_bit_cast(float, __builtin_amdgcn_update_dpp(0, __builtin_bit_cast(int, (x)), (ctrl), 0xf, 0xf, true)))
__device__ __forceinline__ float red8(float x) {
    x = DPP_ADD(x, 0xB1); x = DPP_ADD(x, 0x4E); x = DPP_ADD(x, 0x141); return x;
}
__device__ __forceinline__ float red16(float x) { x = red8(x); x = DPP_ADD(x, 0x140); return x; }
__device__ __forceinline__ float wave_sum(float x) {
    x = red16(x);
    const int xi = __builtin_bit_cast(int, x);
    const float a = __builtin_bit_cast(float, __builtin_amdgcn_readlane(xi, 0)), b = __builtin_bit_cast(float, __builtin_amdgcn_readlane(xi, 16)), c = __builtin_bit_cast(float, __builtin_amdgcn_readlane(xi, 32)), d = __builtin_bit_cast(float, __builtin_amdgcn_readlane(xi, 48));
    return (a + b) + (c + d);
}

template <bool GATEP = false>
__device__ __forceinline__ void p0_transpose_item(const float* W, int ldw, bf16_t* WT, int ldt, int koff, const float* kscale, int nblk, LAS float* scr, int item, int lane) {
    const int kb = item / nblk, nb = item % nblk, k0 = 64 * kb, n0 = 32 * nb;
    int no0 = n0; if (GATEP && n0 < 1024) { const int jb = n0 >= 512 ? 1 : 0, jc = n0 - 512 * jb; no0 = 256 * (jc >> 7) + 128 * jb + (jc & 127); }
    if (GATEP && n0 >= 2816) { const int j = n0 - 2816, jb = j >= 1024 ? 1 : 0, jc = j - 1024 * jb; no0 = 2816 + 256 * (jc >> 7) + 128 * jb + (jc & 127); }
#pragma unroll 8
    for (int i = 0; i < 32; ++i) { const int kk = 2 * i + (lane >> 5); float w = W[(size_t)(k0 + kk) * ldw + n0 + (lane & 31)]; if (kscale) w *= kscale[k0 + kk]; scr[kk * 33 + (lane & 31)] = w; }
    LDS_WAIT(); asm volatile("" ::: "memory");
    const int c = lane & 7;
#pragma unroll
    for (int j = 0; j < 4; ++j) { const int n = (lane >> 3) + 8 * j; const LAS float* s = scr + (8 * c) * 33 + n;
        u32x4 o; o.x = cvt_pk_bf16(s[0 * 33], s[1 * 33]); o.y = cvt_pk_bf16(s[2 * 33], s[3 * 33]); o.z = cvt_pk_bf16(s[4 * 33], s[5 * 33]); o.w = cvt_pk_bf16(s[6 * 33], s[7 * 33]);
        *(u32x4*)(WT + (size_t)(no0 + n) * ldt + koff + k0 + 8 * c) = o; }
    LDS_WAIT(); asm volatile("" ::: "memory");
}

template <int PART> __device__ __forceinline__ void p0_prologue(const Args& a, LAS unsigned char* lds, const int vb, const int VG, const int wave) {
    const int lane = pg8::get_lane(), tid = wave * 64 + lane;
    unsigned char* ws = a.ws;
    LAS float* scr = (LAS float*)(lds + wave * 16384);
    const int gw = vb * NWAVES + wave, NGW = VG * NWAVES;
    const int gt = vb * NTHR + tid, NGT = VG * NTHR;
    constexpr int I_IN = (1024 / 64) * (INTOT / 32), I_C = (512 / 64) * (1024 / 32), I_O = (1024 / 64) * (1024 / 32), I_Q = (1024 / 64) * (2048 / 32);
    constexpr int NITEMS = I_IN + 2 * I_C + I_O + I_Q;
    for (int it = gw; it < NITEMS; it += NGW) {
        int r = it;
        if ((r < I_IN) != (PART != 1) && PART != 2) continue;
        if (r < I_IN) { p0_transpose_item<true>(a.in[3], INTOT, (bf16_t*)(ws + WS_WIN), 1024, 0, nullptr, INTOT / 32, scr, r, lane); continue; } r -= I_IN;
        if (r < I_C) { p0_transpose_item(a.in[8], 1024, (bf16_t*)(ws + WS_WCR), 1024, 0, nullptr, 32, scr, r, lane); continue; } r -= I_C;
        if (r < I_C) { p0_transpose_item(a.in[20], 1024, (bf16_t*)(ws + WS_WCR), 1024, 512, nullptr, 32, scr, r, lane); continue; } r -= I_C;
        if (r < I_O) { p0_transpose_item(a.in[21], 1024, (bf16_t*)(ws + WS_WO), 1024, 0, nullptr, 32, scr, r, lane); continue; } r -= I_O;
        p0_transpose_item(a.in[23], 2048, (bf16_t*)(ws + WS_WQ), 1024, 0, a.in[22], 64, scr, r, lane);
    }
    if (PART != 0) { const float* sk = a.in[24]; bf16_t* o = (bf16_t*)(ws + WS_SK);
      for (int i = gt; i < 16 * 128 * 128 / 8; i += NGT) { const f32x4 x0 = *(const f32x4*)(sk + (size_t)i * 8), x1 = *(const f32x4*)(sk + (size_t)i * 8 + 4); store8(o + (size_t)i * 8, x0, x1); } }
    if (PART != 1) { const float* w_up = a.in[11]; const float* a_up = a.in[13]; const float* g_up = a.in[14]; bf16_t* o = (bf16_t*)(ws + WS_WSM);
      for (int i = gt; i < 1536 * 32; i += NGT) { const int n = i >> 5, k8 = (i & 31) * 8; float v[8];
#pragma unroll
          for (int j = 0; j < 8; ++j) { const int k = k8 + j; float x = 0.f;
              if (n < 512) { if (k < 64) x = w_up[k * 512 + n]; }
              else if (n < 1024) { if (k >= 64 && k < 128) x = a_up[(k - 64) * 512 + (n - 512)]; }
              else { if (k >= 128) x = g_up[(k - 128) * 512 + (n - 1024)]; }
              v[j] = x; }
          store8(o + (size_t)n * 256 + k8, (f32x4){v[0], v[1], v[2], v[3]}, (f32x4){v[4], v[5], v[6], v[7]}); } }
    if (PART != 0) { const float* gf = a.in[22]; unsigned char* t8[2] = {ws + WS_EU, ws + WS_EV};
      for (int it = gw; it < 2 * NEXP; it += NGW) {
          const int tb = it >= NEXP ? 1 : 0, e = it - tb * NEXP;
          const float* src = (tb ? a.in[26] : a.in[25]) + (size_t)e * 1024 + 16 * lane;
          f32x4 v[4]; float mx = 0.f;
#pragma unroll
          for (int j = 0; j < 4; ++j) { v[j] = *(const f32x4*)(src + 4 * j); if (!tb) v[j] = v[j] * *(const f32x4*)(gf + 16 * lane + 4 * j);
              mx = fmaxf(mx, fmaxf(fmaxf(fabsf(v[j][0]), fabsf(v[j][1])), fmaxf(fabsf(v[j][2]), fabsf(v[j][3])))); }
#pragma unroll
          for (int o = 1; o < 64; o <<= 1) mx = fmaxf(mx, __shfl_xor(mx, o));
          mx = fmaxf(mx, 1e-30f);
          const float sc = 384.f / mx;
          u32x4 w; int p;
          p = 0; p = __builtin_amdgcn_cvt_pk_fp8_f32(v[0][0] * sc, v[0][1] * sc, p, false); p = __builtin_amdgcn_cvt_pk_fp8_f32(v[0][2] * sc, v[0][3] * sc, p, true); w.x = (unsigned)p;
          p = 0; p = __builtin_amdgcn_cvt_pk_fp8_f32(v[1][0] * sc, v[1][1] * sc, p, false); p = __builtin_amdgcn_cvt_pk_fp8_f32(v[1][2] * sc, v[1][3] * sc, p, true); w.y = (unsigned)p;
          p = 0; p = __builtin_amdgcn_cvt_pk_fp8_f32(v[2][0] * sc, v[2][1] * sc, p, false); p = __builtin_amdgcn_cvt_pk_fp8_f32(v[2][2] * sc, v[2][3] * sc, p, true); w.z = (unsigned)p;
          p = 0; p = __builtin_amdgcn_cvt_pk_fp8_f32(v[3][0] * sc, v[3][1] * sc, p, false); p = __builtin_amdgcn_cvt_pk_fp8_f32(v[3][2] * sc, v[3][3] * sc, p, true); w.w = (unsigned)p;
          unsigned char* tab = tb ? (ws + WS_EV) : (ws + WS_EU);
          *(u32x4*)(tab + (size_t)e * 1024 + 16 * lane) = w;
          if (lane == 0) ((float*)(tab + 16 * MiB))[e] = mx * (1.f / 384.f);
      } }
    if (PART != 1) { const float* x = a.in[0]; const float* meta = a.in[1]; const float* gm = a.in[2]; bf16_t* XN = (bf16_t*)(ws + WS_XN);
      f32x4 nv[4];
#define XN_LOAD(mm) do { if ((mm) < MT) { const int b_ = (mm) / T, t_ = (mm) - b_ * T; const float* src_ = (t_ < NMETA) ? meta + (size_t)t_ * 1024 : x + ((size_t)b_ * SEQ + (t_ - NMETA)) * 1024; \
          _Pragma("unroll") for (int j = 0; j < 4; ++j) nv[j] = ((const f32x4*)src_)[lane + 64 * j]; } } while (0)
      if (gw < MP) XN_LOAD(gw);
      for (int m = gw; m < MP; m += NGW) {
          bf16_t* o = XN + (size_t)m * 1024;
          f32x4 v[4];
#pragma unroll
          for (int j = 0; j < 4; ++j) v[j] = nv[j];
          if (m + NGW < MP) XN_LOAD(m + NGW);
          if (m >= MT) { const u32x4 z = {0u, 0u, 0u, 0u}; ((u32x4*)o)[lane] = z; ((u32x4*)o)[lane + 64] = z; continue; }
          float s = 0.f;
#pragma unroll
          for (int j = 0; j < 4; ++j) s += (v[j][0] * v[j][0] + v[j][1] * v[j][1]) + (v[j][2] * v[j][2] + v[j][3] * v[j][3]);
          const float rs = 1.f / sqrtf(wave_sum(s) * (1.f / 1024.f) + 1e-6f);
#pragma unroll
          for (int j = 0; j < 4; ++j) { const f32x4 g = ((const f32x4*)gm)[lane + 64 * j]; const f32x4 y = v[j] * rs * g;
              u32x2 w; w.x = cvt_pk_bf16(y[0], y[1]); w.y = cvt_pk_bf16(y[2], y[3]); ((u32x2*)o)[lane + 64 * j] = w; }
      }
#undef XN_LOAD
    }
}

typedef float f32x2v __attribute__((ext_vector_type(2)));
__device__ __forceinline__ void p2_conv(const Args& a, LAS unsigned char* lds, int G, const int wave, const bool split) {
    const int lane = pg8::get_lane(), tid = wave * 64 + lane;
    const bf16_t* Zc = (const bf16_t*)(a.ws + WS_ZC); bf16_t* ACL = (bf16_t*)(a.ws + WS_ACL);
    const float* conv_w = a.in[4]; const float* conv_b = a.in[5]; const float* ln_g = a.in[6]; const float* ln_b = a.in[7];
    constexpr int CT = 66, HT = 33, NR = CT + 30, TPB = (T + CT - 1) / CT;
    LAS unsigned char* ul = lds;
    LAS unsigned* yl = (LAS unsigned*)lds;
    const int cp = tid & 255, tg = tid >> 8;
    f32x2v w[31];
#pragma unroll
    for (int j = 0; j < 31; ++j) w[j] = *(const f32x2v*)(conv_w + j * 512 + 2 * cp);
    const f32x2v bias = *(const f32x2v*)(conv_b + 2 * cp);
    const bool tailwg = split && (int)blockIdx.x >= G - NB;
    const int it_first = split ? (tailwg ? 0 : (int)blockIdx.x) : (int)blockIdx.x, it_step = split ? (G - NB) : G, it_end = split ? (tailwg ? 1 : NB * (TPB - 1)) : NB * TPB;
    for (int it = it_first; it < it_end; it += it_step) {
        const int b = split ? (tailwg ? (int)blockIdx.x - (G - NB) : it / (TPB - 1)) : it / TPB;
        const int t0 = (split ? (tailwg ? TPB - 1 : it - b * (TPB - 1)) : it - b * TPB) * CT;
        u32x4 vv[12];
#pragma unroll
        for (int k = 0; k < 12; ++k) { const int r = (tid >> 6) + 8 * k, ti = t0 - 30 + r; vv[k] = (u32x4){0u, 0u, 0u, 0u};
            if (ti >= 0 && ti < T) vv[k] = *(const u32x4*)(Zc + (size_t)(b * T + ti) * 512 + 8 * lane); }
#pragma unroll
        for (int k = 0; k < 12; ++k) { const int r = (tid >> 6) + 8 * k; *(LAS u32x4*)(ul + r * 1024 + lane * 16) = vv[k]; }
        __syncthreads();
        f32x2v u[HT + 30];
#pragma unroll
        for (int s = 0; s < HT + 30; ++s) { const unsigned uw = *(const LAS unsigned*)(ul + (tg * HT + s) * 1024 + cp * 4); u[s] = (f32x2v){bflo(uw), bfhi(uw)}; }
        unsigned yv[HT];
#pragma unroll
        for (int o = 0; o < HT; ++o) {
            f32x2v acc = bias;
#pragma unroll
            for (int j = 0; j < 31; ++j) acc = w[j] * u[o + j] + acc;
            yv[o] = cvt_pk_bf16(acc.x, acc.y);
        }
        __syncthreads();
#pragma unroll
        for (int o = 0; o < HT; ++o) yl[(tg * HT + o) * 256 + cp] = yv[o];
        __syncthreads();
        for (int o = wave; o < CT; o += NWAVES) {
            const int t = t0 + o;
            if (t >= NMETA && t < T) {
                const u32x4 yw = *(const LAS u32x4*)(yl + o * 256 + 4 * lane);
                const f32x4 y0 = {bflo(yw.x), bfhi(yw.x), bflo(yw.y), bfhi(yw.y)}, y1 = {bflo(yw.z), bfhi(yw.z), bflo(yw.w), bfhi(yw.w)};
                const float mean = wave_sum((y0[0] + y0[1]) + (y0[2] + y0[3]) + (y1[0] + y1[1]) + (y1[2] + y1[3])) * (1.f / 512.f);
                const f32x4 d0 = y0 - mean, d1 = y1 - mean;
                const float var = wave_sum((d0[0] * d0[0] + d0[1] * d0[1]) + (d0[2] * d0[2] + d0[3] * d0[3]) + (d1[0] * d1[0] + d1[1] * d1[1]) + (d1[2] * d1[2] + d1[3] * d1[3])) * (1.f / 512.f);
                const float rstd = __builtin_amdgcn_rsqf(var + 1e-5f);
                const f32x4 g0 = *(const f32x4*)(ln_g + 8 * lane), g1 = *(const f32x4*)(ln_g + 8 * lane + 4), b0 = *(const f32x4*)(ln_b + 8 * lane), b1 = *(const f32x4*)(ln_b + 8 * lane + 4);
                f32x4 z0 = d0 * rstd * g0 + b0, z1 = d1 * rstd * g1 + b1;
#pragma unroll
                for (int j = 0; j < 4; ++j) { z0[j] = z0[j] * sigm(z0[j]); z1[j] = z1[j] * sigm(z1[j]); }
                store8(ACL + ((size_t)b * SEQ + (t - NMETA)) * 512 + 8 * lane, z0, z1);
            }
        }
        __syncthreads();
    }
}

__device__ __forceinline__ void p2_lorag(const Args& a, int G, const int wave) {
    const int lane = pg8::get_lane();
    const bf16_t* Zr = (const bf16_t*)(a.ws + WS_ZR); bf16_t* A2g = (bf16_t*)(a.ws + WS_A2);
    const float mu0 = a.in[9][1664 + 2 * lane], mu1 = a.in[9][1664 + 2 * lane + 1];
    const int gw = blockIdx.x * NWAVES + wave, NGW = G * NWAVES;
    for (int run = gw; run < MT / 16; run += NGW) {
        const int m0 = run * 16, t0 = m0 % T;
        unsigned rw[17];
        rw[0] = 0u; if (t0 > 0) rw[0] = *(const unsigned*)(Zr + (size_t)(m0 - 1) * RWIN + 1664 + 2 * lane);
#pragma unroll
        for (int i = 0; i < 16; ++i) rw[i + 1] = *(const unsigned*)(Zr + (size_t)(m0 + i) * RWIN + 1664 + 2 * lane);
#pragma unroll
        for (int i = 0; i < 16; ++i) { const float c0 = bflo(rw[i + 1]), c1 = bfhi(rw[i + 1]);
            *(unsigned*)(A2g + (size_t)(m0 + i) * 128 + 2 * lane) = cvt_pk_bf16(sigm(c0 + (bflo(rw[i]) - c0) * mu0), sigm(c1 + (bfhi(rw[i]) - c1) * mu1)); }
    }
}

typedef short s16x4 __attribute__((ext_vector_type(4)));
__device__ __forceinline__ f32x4 mfma16(const s16x4 x, const s16x4 y, const f32x4 c) { return __builtin_amdgcn_mfma_f32_16x16x16bf16_1k(x, y, c, 0, 0, 0); }
__device__ __forceinline__ unsigned short f2bf_bits(float f) { return (unsigned short)(cvt_pk_bf16(f, 0.f) & 0xffffu); }
__device__ __forceinline__ s16x4 pack4(const f32x4 v) { u32x2 w; w.x = cvt_pk_bf16(v[0], v[1]); w.y = cvt_pk_bf16(v[2], v[3]); return __builtin_bit_cast(s16x4, w); }
__device__ __forceinline__ float bf2f(unsigned short b) { return __builtin_bit_cast(float, (unsigned)b << 16); }
constexpr int NCHK = T / 16;

__device__ __forceinline__ bf16_t* bb_base(const Args& a, int b) {
    return (b < 7) ? (bf16_t*)((unsigned char*)a.out + 99 * MiB) : (bf16_t*)(a.ws + WS_A2 + 9 * MiB) - (size_t)7 * T * 512;
}
__device__ __forceinline__ float tanh_fast(float x) { return 1.f - 2.f * __builtin_amdgcn_rcpf(1.f + __expf(2.f * x)); }
constexpr int P4_WSTRIDE = 13568, P4_WL = 8 * P4_WSTRIDE  , P4_MU = P4_WL + 2 * 9216  ;

template <bool TAIL> __device__ __forceinline__ void p4a_fused(const Args& a, LAS unsigned char* lds, int G, const int wave, const int tail_b) {
    const int lane_o = pg8::get_lane();
    const bf16_t* Zr = (const bf16_t*)(a.ws + WS_ZR);
    bf16_t* Rb = (bf16_t*)a.out; bf16_t* Vb = (bf16_t*)((unsigned char*)a.out + 33 * MiB); bf16_t* Kb = (bf16_t*)((unsigned char*)a.out + 66 * MiB);
    bf16_t* KKb = (bf16_t*)(a.ws + WS_KK); bf16_t* Em = (bf16_t*)(a.ws + WS_EM); float* WCa = (float*)(a.ws + WS_WC);
    float* RKs = (float*)(a.ws + WS_RK);
    LAS unsigned char* wl = lds + wave * P4_WSTRIDE;
    LAS unsigned char* mt = wl + 4352;
    LAS float* Al = (LAS float*)(wl + 2048);
    LAS float* ST = (LAS float*)wl;
    constexpr int NVB = 8 * 32, NITEM = TAIL ? 1 : NB * 256;
    const bf16_t* WsmG = (const bf16_t*)(a.ws + WS_WSM);
    for (int vb = TAIL ? 0 : (int)blockIdx.x; vb < (TAIL ? 1 : NVB); vb += G) {
    const int h = TAIL ? wave : (vb & 7), q8 = TAIL ? -wave : (vb >> 3) * 8;
    if (!TAIL) {   const bf16_t* Wsm = (const bf16_t*)(a.ws + WS_WSM); const int tid = wave * 64 + lane_o;
#pragma unroll
        for (int i = 0; i < 2; ++i) { const int q = tid + NTHR * i, kind = q >> 9, ch = (q >> 3) & 63, pc = q & 7;
            *(LAS u32x4*)(lds + P4_WL + kind * 9216 + ch * 144 + pc * 16) = *(const u32x4*)(Wsm + (size_t)(kind * 512 + h * 64 + ch) * 256 + kind * 64 + pc * 8); }
        if (tid < 128) *(LAS float*)(lds + P4_MU + tid * 4) = a.in[9][1536 + tid];
        __syncthreads(); }
    const int chn_o = h * 64 + lane_o;
    const float mu_r = a.in[9][chn_o], mu_k = a.in[9][512 + chn_o], mu_v = a.in[9][1024 + chn_o], w0c = a.in[10][chn_o], a0c = a.in[12][chn_o], kkc = a.in[15][chn_o], kac = a.in[16][chn_o], rkc2 = a.in[17][chn_o];
    u32x4 n_r0, n_r1, n_k0, n_k1, n_v0, n_v1, n_lw0, n_lw1, n_la0, n_la1, n_pw0, n_pw1, n_pa0, n_pa1; unsigned short n_pr, n_pk, n_pv;
#define F_LOAD(bcx) do { const int b_ = TAIL ? tail_b : ((bcx) >> 8), c_ = TAIL ? NCHK - 1 : ((bcx) & 255); const size_t m0_ = (size_t)b_ * T + (size_t)c_ * 16; \
        const bf16_t* zp_ = Zr + (m0_ + prow) * RWIN + h * 64 + pp * 8; \
        n_r0 = *(const u32x4*)zp_; n_r1 = *(const u32x4*)(zp_ + 8 * RWIN); n_k0 = *(const u32x4*)(zp_ + 512); n_k1 = *(const u32x4*)(zp_ + 8 * RWIN + 512); \
        n_v0 = *(const u32x4*)(zp_ + 1024); n_v1 = *(const u32x4*)(zp_ + 8 * RWIN + 1024); \
        const bf16_t* zl_ = Zr + (m0_ + x) * RWIN + 1536 + 8 * g; \
        n_lw0 = *(const u32x4*)zl_; n_lw1 = *(const u32x4*)(zl_ + 32); n_la0 = *(const u32x4*)(zl_ + 64); n_la1 = *(const u32x4*)(zl_ + 96); \
        n_pw0 = (u32x4){0u, 0u, 0u, 0u}; n_pw1 = n_pw0; n_pa0 = n_pw0; n_pa1 = n_pw0; n_pr = 0; n_pk = 0; n_pv = 0; \
        if (c_ > 0) { const bf16_t* zq_ = Zr + (m0_ - 1) * RWIN; \
            n_pr = *(const unsigned short*)(zq_ + chn); n_pk = *(const unsigned short*)(zq_ + 512 + chn); n_pv = *(const unsigned short*)(zq_ + 1024 + chn); \
            n_pw0 = *(const u32x4*)(zq_ + 1536 + 8 * g); n_pw1 = *(const u32x4*)(zq_ + 1568 + 8 * g); n_pa0 = *(const u32x4*)(zq_ + 1600 + 8 * g); n_pa1 = *(const u32x4*)(zq_ + 1632 + 8 * g); } } while (0)
    if (q8 + wave < NITEM) { const int lane = lane_o, x = lane & 15, g = lane >> 4, prow = lane >> 3, pp = lane & 7, chn = h * 64 + lane; F_LOAD(q8 + wave); }
    for (int bc = q8 + wave; bc < NITEM; bc += NVB) {
        int lx_ = lane_o; asm volatile("" : "+v"(lx_)); const int lane = lx_, x = lane & 15, g = lane >> 4, prow = lane >> 3, pp = lane & 7, chn = h * 64 + lane;
        const int b = TAIL ? tail_b : (bc >> 8), c = TAIL ? NCHK - 1 : (bc & 255);
        const size_t m0 = (size_t)b * T + (size_t)c * 16;
        const size_t e0 = m0 * 512 + h * 64;
        const size_t pb = e0 + (size_t)prow * 512 + pp * 8;
        bf16_t* Bb = bb_base(a, b);
        bf16x8 Aw0, Aw1, Aa0, Aa1;
#define LORA_FRAG(DST, CUR, PRV, MUOFF, TANH) do { f32x4 ma_, mb_; if (TAIL) { ma_ = *(const f32x4*)(a.in[9] + 1536 + (MUOFF) + 8 * g); mb_ = *(const f32x4*)(a.in[9] + 1536 + (MUOFF) + 8 * g + 4); } \
            else { ma_ = *(const LAS f32x4*)(lds + P4_MU + ((MUOFF) + 8 * g) * 4); mb_ = *(const LAS f32x4*)(lds + P4_MU + ((MUOFF) + 8 * g) * 4 + 16); } \
            const float mm_[8] = {ma_[0], ma_[1], ma_[2], ma_[3], mb_[0], mb_[1], mb_[2], mb_[3]}; u32x4 o_; \
            _Pragma("unroll") for (int i = 0; i < 4; ++i) { const unsigned cw_ = CUR[i]; const unsigned pw_ = (unsigned)__builtin_amdgcn_update_dpp((int)PRV[i], (int)cw_, 0x111, 0xf, 0xf, false); \
                float zl_ = bflo(cw_), zh_ = bfhi(cw_); zl_ += (bflo(pw_) - zl_) * mm_[2 * i]; zh_ += (bfhi(pw_) - zh_) * mm_[2 * i + 1]; \
                if (TANH) { zl_ = tanh_fast(zl_); zh_ = tanh_fast(zh_); } o_[i] = cvt_pk_bf16(zl_, zh_); } \
            DST = __builtin_bit_cast(bf16x8, o_); } while (0)
        LORA_FRAG(Aw0, n_lw0, n_pw0, 0, true); LORA_FRAG(Aw1, n_lw1, n_pw1, 32, true); LORA_FRAG(Aa0, n_la0, n_pa0, 64, false); LORA_FRAG(Aa1, n_la1, n_pa1, 96, false);
#undef LORA_FRAG
        *(LAS u32x4*)(mt + prow * 128 + pp * 16) = n_k0; *(LAS u32x4*)(mt + (prow + 8) * 128 + pp * 16) = n_k1;
        *(LAS u32x4*)(mt + 2048 + prow * 128 + pp * 16) = n_v0; *(LAS u32x4*)(mt + 2048 + (prow + 8) * 128 + pp * 16) = n_v1;
        *(LAS u32x4*)(mt + 4096 + prow * 128 + pp * 16) = n_r0; *(LAS u32x4*)(mt + 4096 + (prow + 8) * 128 + pp * 16) = n_r1;
        const float p_r = bf2f(n_pr), p_k = bf2f(n_pk), p_v = bf2f(n_pv);
        LDS_WAIT(); asm volatile("" ::: "memory");
        { const int bcn = (bc + NVB < NITEM) ? bc + NVB : bc; F_LOAD(bcn); }
        float ev[16], av[16];
        {   f32x4 accW[4], accA[4]; const f32x4 z4 = {0.f, 0.f, 0.f, 0.f};
#pragma unroll
            for (int n = 0; n < 4; ++n) { bf16x8 bw0, bw1, ba0, ba1;
                if (TAIL) { const bf16_t* gw_ = WsmG + (size_t)(h * 64 + 16 * n + x) * 256 + 8 * g; const bf16_t* ga_ = gw_ + (size_t)512 * 256 + 64;
                    bw0 = *(const bf16x8*)gw_; bw1 = *(const bf16x8*)(gw_ + 32); ba0 = *(const bf16x8*)ga_; ba1 = *(const bf16x8*)(ga_ + 32); }
                else { const LAS unsigned char* wp = lds + P4_WL + (16 * n + x) * 144 + g * 16;
                    bw0 = *(const LAS bf16x8*)wp; bw1 = *(const LAS bf16x8*)(wp + 64); ba0 = *(const LAS bf16x8*)(wp + 9216); ba1 = *(const LAS bf16x8*)(wp + 9216 + 64); }
                accW[n] = __builtin_amdgcn_mfma_f32_16x16x32_bf16(Aw0, bw0, z4, 0, 0, 0); accW[n] = __builtin_amdgcn_mfma_f32_16x16x32_bf16(Aw1, bw1, accW[n], 0, 0, 0);
                accA[n] = __builtin_amdgcn_mfma_f32_16x16x32_bf16(Aa0, ba0, z4, 0, 0, 0); accA[n] = __builtin_amdgcn_mfma_f32_16x16x32_bf16(Aa1, ba1, accA[n], 0, 0, 0); }
#pragma unroll
            for (int n = 0; n < 4; ++n)
#pragma unroll
                for (int r = 0; r < 4; ++r) ST[(4 * g + r) * 68 + 16 * n + x] = accW[n][r];
            LDS_WAIT(); asm volatile("" ::: "memory");
#pragma unroll
            for (int t = 0; t < 16; ++t) ev[t] = 0.60653065971f * sigm(w0c + ST[t * 68 + lane]);
            LDS_WAIT(); asm volatile("" ::: "memory");
#pragma unroll
            for (int n = 0; n < 4; ++n)
#pragma unroll
                for (int r = 0; r < 4; ++r) ST[(4 * g + r) * 68 + 16 * n + x] = accA[n][r];
            LDS_WAIT(); asm volatile("" ::: "memory");
#pragma unroll
            for (int t = 0; t < 16; ++t) av[t] = sigm(a0c + ST[t * 68 + lane]);
            LDS_WAIT(); asm volatile("" ::: "memory");
        }
        float kkv[16], bv[16], kv[16], rv[16]; unsigned short vbits[16];
#define UNSTAGE_SHIFT(dst, OFF, PREV, MU) do { float pv_ = (PREV); _Pragma("unroll") for (int t = 0; t < 16; ++t) { const float c_ = bf2f(*(const LAS unsigned short*)(mt + (OFF) + t * 128 + lane * 2)); dst[t] = c_ + (pv_ - c_) * (MU); pv_ = c_; } } while (0)
        UNSTAGE_SHIFT(rv, 4096, p_r, mu_r); UNSTAGE_SHIFT(kv, 0, p_k, mu_k); UNSTAGE_SHIFT(bv, 2048, p_v, mu_v);
        LDS_WAIT(); asm volatile("" ::: "memory");
#pragma unroll
        for (int t = 0; t < 16; ++t) vbits[t] = f2bf_bits(bv[t]);
#undef UNSTAGE_SHIFT
        {
#pragma unroll
          for (int t = 0; t < 16; ++t) { kkv[t] = kv[t] * kkc; ST[t * 65 + lane] = kkv[t] * kkv[t]; }
          LDS_WAIT(); asm volatile("" ::: "memory");
          float s = 0.f;
#pragma unroll
          for (int j = 0; j < 16; ++j) s += ST[x * 65 + 16 * g + j];
          s += __shfl_xor(s, 16); s += __shfl_xor(s, 32);
          const int rnb = __builtin_bit_cast(int, __builtin_amdgcn_rsqf(fmaxf(s, 1e-24f)));
          LDS_WAIT(); asm volatile("" ::: "memory");
#pragma unroll
          for (int t = 0; t < 16; ++t) { const float rn = __builtin_bit_cast(float, __builtin_amdgcn_readlane(rnb, t));
              kkv[t] *= rn; bv[t] = kkv[t] * av[t]; kv[t] = kv[t] * (1.f + (av[t] - 1.f) * kac); } }
        {
#pragma unroll
          for (int t = 0; t < 16; ++t) *(LAS float*)(wl + (t * 65 + lane) * 4) = rv[t] * kv[t] * rkc2;
          LDS_WAIT(); asm volatile("" ::: "memory");
          float s = 0.f;
#pragma unroll
          for (int j = 0; j < 16; ++j) s += *(const LAS float*)(wl + (x * 65 + 16 * g + j) * 4);
          s += __shfl_xor(s, 16); s += __shfl_xor(s, 32);
          if (lane < 16) RKs[(m0 + lane) * 8 + h] = s;
          LDS_WAIT(); asm volatile("" ::: "memory"); }
        float lw = 0.f, wprev = 1.f; float bts[16], kts[16];
#pragma unroll
        for (int t = 0; t < 16; ++t) {
            lw -= ev[t]; const float wt = __expf(lw), iw = __expf(-lw);
            bts[t] = bv[t] * iw; kts[t] = kv[t] * iw;
            *(LAS unsigned short*)(mt + 0 * 2304 + t * 144 + lane * 2) = f2bf_bits(-kkv[t] * wprev); *(LAS unsigned short*)(mt + 1 * 2304 + t * 144 + lane * 2) = f2bf_bits(rv[t] * wt);
            *(LAS unsigned short*)(mt + 2 * 2304 + t * 144 + lane * 2) = f2bf_bits(bts[t]); *(LAS unsigned short*)(mt + 3 * 2304 + t * 144 + lane * 2) = f2bf_bits(kts[t]);
            wprev = wt;
        }
        const float wc = wprev;
        {
            const size_t o = e0 + (size_t)(lane >> 2) * 512 + (lane & 3) * 16;
            u32x4 w0, w1;
            w0.x = cvt_pk_bf16(bts[0] * wc, bts[1] * wc); w0.y = cvt_pk_bf16(bts[2] * wc, bts[3] * wc); w0.z = cvt_pk_bf16(bts[4] * wc, bts[5] * wc); w0.w = cvt_pk_bf16(bts[6] * wc, bts[7] * wc);
            w1.x = cvt_pk_bf16(bts[8] * wc, bts[9] * wc); w1.y = cvt_pk_bf16(bts[10] * wc, bts[11] * wc); w1.z = cvt_pk_bf16(bts[12] * wc, bts[13] * wc); w1.w = cvt_pk_bf16(bts[14] * wc, bts[15] * wc);
            *(u32x4*)(Bb + o) = w0; *(u32x4*)(Bb + o + 8) = w1;
            w0.x = cvt_pk_bf16(kts[0] * wc, kts[1] * wc); w0.y = cvt_pk_bf16(kts[2] * wc, kts[3] * wc); w0.z = cvt_pk_bf16(kts[4] * wc, kts[5] * wc); w0.w = cvt_pk_bf16(kts[6] * wc, kts[7] * wc);
            w1.x = cvt_pk_bf16(kts[8] * wc, kts[9] * wc); w1.y = cvt_pk_bf16(kts[10] * wc, kts[11] * wc); w1.z = cvt_pk_bf16(kts[12] * wc, kts[13] * wc); w1.w = cvt_pk_bf16(kts[14] * wc, kts[15] * wc);
            *(u32x4*)(Kb + o) = w0; *(u32x4*)(Kb + o + 8) = w1;
            w0.x = vbits[0] | ((unsigned)vbits[1] << 16); w0.y = vbits[2] | ((unsigned)vbits[3] << 16); w0.z = vbits[4] | ((unsigned)vbits[5] << 16); w0.w = vbits[6] | ((unsigned)vbits[7] << 16);
            w1.x = vbits[8] | ((unsigned)vbits[9] << 16); w1.y = vbits[10] | ((unsigned)vbits[11] << 16); w1.z = vbits[12] | ((unsigned)vbits[13] << 16); w1.w = vbits[14] | ((unsigned)vbits[15] << 16);
            *(u32x4*)(Vb + o) = w0; *(u32x4*)(Vb + o + 8) = w1;
        }
        LDS_WAIT(); asm volatile("" ::: "memory");
        { const u32x4 a0 = *(const LAS u32x4*)(mt + 0 * 2304 + prow * 144 + pp * 16), a1 = *(const LAS u32x4*)(mt + 0 * 2304 + (prow + 8) * 144 + pp * 16);
          const u32x4 r0 = *(const LAS u32x4*)(mt + 1 * 2304 + prow * 144 + pp * 16), r1 = *(const LAS u32x4*)(mt + 1 * 2304 + (prow + 8) * 144 + pp * 16);
          *(u32x4*)(KKb + pb) = a0; *(u32x4*)(KKb + pb + 8 * 512) = a1; *(u32x4*)(Rb + pb) = r0; *(u32x4*)(Rb + pb + 8 * 512) = r1; }
        { int ly_ = lane_o; asm volatile("" : "+v"(ly_)); const int lane = ly_, x = lane & 15, g = lane >> 4, prow = lane >> 3, pp = lane & 7;
        f32x4 Aab = {0.f, 0.f, 0.f, 0.f}, Aak = Aab, Arb = Aab, Ark = Aab;
#pragma unroll
        for (int s = 0; s < 4; ++s) {
            const int fo = x * 144 + (16 * s + 4 * g) * 2;
            const s16x4 aF = *(const LAS s16x4*)(mt + 0 * 2304 + fo), rF = *(const LAS s16x4*)(mt + 1 * 2304 + fo), bF = *(const LAS s16x4*)(mt + 2 * 2304 + fo), kF = *(const LAS s16x4*)(mt + 3 * 2304 + fo);
            Aab = mfma16(aF, bF, Aab); Aak = mfma16(aF, kF, Aak); Arb = mfma16(rF, bF, Arb); Ark = mfma16(rF, kF, Ark);
        }
#pragma unroll
        for (int r = 0; r < 4; ++r) { const int t = 4 * g + r; if (!(x < t)) { Aab[r] = 0.f; Aak[r] = 0.f; } if (!(x <= t)) { Arb[r] = 0.f; Ark[r] = 0.f; }
            Al[t * 16 + x] = Aab[r];
            *(LAS unsigned short*)(wl + t * 128 + 32 + 2 * x) = f2bf_bits(Arb[r]); *(LAS unsigned short*)(wl + t * 128 + 64 + 2 * x) = f2bf_bits(Aak[r]); *(LAS unsigned short*)(wl + t * 128 + 96 + 2 * x) = f2bf_bits(Ark[r]); }
        LDS_WAIT(); asm volatile("" ::: "memory");
        float Trow[16];
#pragma unroll
        for (int t = 0; t < 16; ++t) {
            const f32x4 a0 = *(const LAS f32x4*)(Al + t * 16), a1 = *(const LAS f32x4*)(Al + t * 16 + 4), a2 = *(const LAS f32x4*)(Al + t * 16 + 8), a3 = *(const LAS f32x4*)(Al + t * 16 + 12);
            const float ar[16] = {a0[0], a0[1], a0[2], a0[3], a1[0], a1[1], a1[2], a1[3], a2[0], a2[1], a2[2], a2[3], a3[0], a3[1], a3[2], a3[3]};
            float acc = (x == t) ? 1.f : 0.f;
#pragma unroll
            for (int j = 0; j < 16; ++j) if (j < t) acc = fmaf(ar[j], Trow[j], acc);
            Trow[t] = acc;
        }
        if (g == 0) {
#pragma unroll
            for (int t = 0; t < 16; ++t) *(LAS unsigned short*)(wl + t * 128 + 2 * x) = f2bf_bits(Trow[t]);
        }
        LDS_WAIT(); asm volatile("" ::: "memory");
        { const u32x4 m0v = *(const LAS u32x4*)(wl + prow * 128 + pp * 16), m1v = *(const LAS u32x4*)(wl + (prow + 8) * 128 + pp * 16);
          *(u32x4*)(Em + pb) = m0v; *(u32x4*)(Em + pb + 8 * 512) = m1v;
          WCa[((size_t)(b * NHEAD + h) * NCHK + c) * 64 + lane] = wc; }
        LDS_WAIT(); asm volatile("" ::: "memory");
        }
    }
    __syncthreads();
    }
#undef F_LOAD
}

struct ScanOps { s16x4 Af[4], Rf[4], Mf[4], BTf[4], KTf[4], VTf; f32x4 WCf[4]; };
constexpr int RS_STRIDE = 13824, RS_NSLOT = 3, RS_OBUF = RS_NSLOT * RS_STRIDE;
constexpr int SCAN_NIT = 264;
__device__ __forceinline__ int rs_mk(int low3) { return low3 | (((low3 >> 2) & 1) << 3); }
__device__ __forceinline__ int rs_mig(int i, int g) { return rs_mk(2 * i + (g >> 1)); }
__device__ __forceinline__ int rs_mgh(int g, int h) { return rs_mk(2 * ((g >> 1) * 2 + h)); }
__device__ __forceinline__ s16x4 lo64(const u32x4 v) { const u32x2 w = {v.x, v.y}; return __builtin_bit_cast(s16x4, w); }
__device__ __forceinline__ s16x4 hi64(const u32x4 v) { const u32x2 w = {v.z, v.w}; return __builtin_bit_cast(s16x4, w); }
__device__ __forceinline__ void scan_frag_read(ScanOps& o, LAS unsigned char* slot, const int (&oar)[4], const int (&om)[2], const int ov, const int g) {
#pragma unroll
    for (int i = 0; i < 4; ++i) {
        const u32x4 ar = *(const LAS u32x4*)(slot + oar[i]), bk = *(const LAS u32x4*)(slot + 4096 + oar[i]);
        o.Af[i] = lo64(ar); o.Rf[i] = hi64(ar); o.BTf[i] = lo64(bk); o.KTf[i] = hi64(bk);
        o.WCf[i] = *(const LAS f32x4*)(slot + 12800 + (4 * i + g) * 16); }
    const u32x4 m0 = *(const LAS u32x4*)(slot + 8192 + om[0]), m1 = *(const LAS u32x4*)(slot + 8192 + om[1]);
    o.Mf[0] = lo64(m0); o.Mf[1] = hi64(m0); o.Mf[2] = lo64(m1); o.Mf[3] = hi64(m1);
    o.VTf = *(const LAS s16x4*)(slot + 10240 + ov);
}
__device__ __forceinline__ void scan_step(const ScanOps& o, f32x4 (&Sacc)[4], s16x4 (&Sb)[4], LAS float* ob, int x, int g, int w) {
    const f32x4 z = {0.f, 0.f, 0.f, 0.f};
    f32x4 X = mfma16(o.Mf[2], o.VTf, z);
#pragma unroll
    for (int i = 0; i < 4; ++i) X = mfma16(o.Af[i], Sb[i], X);
    const s16x4 Xb = pack4(X);
    const f32x4 U = mfma16(o.Mf[0], Xb, z); const s16x4 Ub = pack4(U);
    f32x4 Oc = mfma16(o.Mf[3], o.VTf, z);
#pragma unroll
    for (int i = 0; i < 4; ++i) Oc = mfma16(o.Rf[i], Sb[i], Oc);
    Oc = mfma16(o.Mf[1], Ub, Oc);
#pragma unroll
    for (int i = 0; i < 4; ++i) { f32x4 s = Sacc[i] * o.WCf[i]; s = mfma16(o.KTf[i], o.VTf, s); s = mfma16(o.BTf[i], Ub, s); Sacc[i] = s; Sb[i] = pack4(s); }
#pragma unroll
    for (int r = 0; r < 4; ++r) ob[(4 * g + r) * 64 + 16 * w + x] = Oc[r];
}

__device__ __forceinline__ void p4b_chain(const Args& a, LAS unsigned char* lds, int G, const int wave) {
    const int lane = pg8::get_lane(), x = lane & 15, g = lane >> 4;
    const bf16_t* Rb = (const bf16_t*)a.out; const bf16_t* Vb = (const bf16_t*)((unsigned char*)a.out + 33 * MiB); const bf16_t* Kb = (const bf16_t*)((unsigned char*)a.out + 66 * MiB);
    const bf16_t* KKb = (const bf16_t*)(a.ws + WS_KK);
    const bf16_t* Em = (const bf16_t*)(a.ws + WS_EM); const float* WCa = (const float*)(a.ws + WS_WC); bf16_t* ORAW = (bf16_t*)(a.ws + WS_ORAW);
    LAS float* obuf = (LAS float*)(lds + RS_OBUF);
#define SCAN_BAR() do { asm volatile("s_waitcnt lgkmcnt(0)" ::: "memory"); __builtin_amdgcn_s_barrier(); asm volatile("" ::: "memory"); } while (0)
    for (int it = blockIdx.x; it < NB * NHEAD; it += G) {
        const int b = it >> 3, h = it & 7;
        const bf16_t* Bb = bb_base(a, b);
        const size_t ebase = (size_t)b * T * 512 + h * 64;
        const int sb0 = (int)(ebase * 2);
        if (wave < 4) {
            f32x4 Sacc[4]; s16x4 Sb[4];
#pragma unroll
            for (int i = 0; i < 4; ++i) { Sacc[i] = (f32x4){0.f, 0.f, 0.f, 0.f}; Sb[i] = (s16x4){0, 0, 0, 0}; }
            int oar[4], om[2];
#pragma unroll
            for (int i = 0; i < 4; ++i) oar[i] = (4 * i + g) * 256 + ((x ^ rs_mig(i, g)) * 16);
            om[0] = (2 * g) * 256 + ((x ^ rs_mgh(g, 0)) * 16); om[1] = (2 * g + 1) * 256 + ((x ^ rs_mgh(g, 1)) * 16);
            const int ov = g * 640 + (16 * wave + x) * 8;
            SCAN_BAR();
            ScanOps opA, opB;
            scan_frag_read(opA, lds, oar, om, ov, g);
#define CONS_ITER(cc, CUR, NXT) do { { const int sn_ = ((cc) + 1) % 3; scan_frag_read(NXT, lds + sn_ * RS_STRIDE, oar, om, ov, g); } \
                if ((cc) < NCHK) scan_step(CUR, Sacc, Sb, obuf + ((cc) & 1) * 1024, x, g, wave); SCAN_BAR(); } while (0)
            for (int cc = 0; cc < SCAN_NIT; cc += 2) { CONS_ITER(cc, opA, opB); CONS_ITER(cc + 1, opB, opA); }
#undef CONS_ITER
        } else {
            const int lw = wave - 4, hf = lw & 1, prow = 8 * hf + (lane >> 3), pp = lane & 7;
            const __amdgpu_buffer_rsrc_t rs0 = __builtin_amdgcn_make_buffer_rsrc((void*)(lw < 2 ? KKb : Rb), 0, 0x7fffffff, 0x00020000);
            const __amdgpu_buffer_rsrc_t rs1 = __builtin_amdgcn_make_buffer_rsrc((void*)(lw < 2 ? Bb : Kb), 0, 0x7fffffff, 0x00020000);
            const __amdgpu_buffer_rsrc_t rs2 = __builtin_amdgcn_make_buffer_rsrc((void*)(lw < 2 ? (const void*)Vb : (const void*)Em), 0, 0x7fffffff, 0x00020000);
            const __amdgpu_buffer_rsrc_t rsE = __builtin_amdgcn_make_buffer_rsrc((void*)WCa, 0, 0x7fffffff, 0x00020000), rsO = __builtin_amdgcn_make_buffer_rsrc((void*)ORAW, 0, 0x7fffffff, 0x00020000);
            const int vo01 = prow * 1024 + pp * 16;
            const int voW = (lane & 15) * 16, wcb0 = it * NCHK * 256;
            const int hi8 = (lw < 2) ? 0 : 8;
            int w0a[2], w1a[2], w2a[2];
#pragma unroll
            for (int hl = 0; hl < 2; ++hl) { const int gg = 2 * (pp & 1) + hl, ii = pp >> 1;
                w0a[hl] = (4 * ii + gg) * 256 + ((prow ^ rs_mig(ii, gg)) * 16) + hi8;
                const int kr = 4 * prow + (pp >> 1), ki = kr >> 4, kx = kr & 15;
                w1a[hl] = 4096 + (4 * ki + gg) * 256 + ((kx ^ rs_mig(ki, gg)) * 16) + hi8;
                w2a[hl] = (lw < 2) ? (10240 + gg * 640 + kr * 8) : (8192 + (2 * gg + (ii >> 1)) * 256 + ((prow ^ rs_mgh(gg, ii >> 1)) * 16) + 8 * (ii & 1)); }
            const int ldW = 12800 + (lane & 15) * 16;
            struct RSet { u32x4 r0, r1, r2, rw; };
            RSet s0, s1, s2, s3, s4, s5, s6, s7;
#define RING_LOAD(S, chunk) do { const int cn_ = ((chunk) < NCHK) ? (chunk) : NCHK - 1; const int so_ = sb0 + cn_ * 16 * 1024; \
                S.r0 = __builtin_amdgcn_raw_buffer_load_b128(rs0, vo01, so_, 0); S.r1 = __builtin_amdgcn_raw_buffer_load_b128(rs1, vo01, so_, 0); \
                S.r2 = __builtin_amdgcn_raw_buffer_load_b128(rs2, vo01, so_, 0); S.rw = __builtin_amdgcn_raw_buffer_load_b128(rsE, voW, wcb0 + cn_ * 256, 0); } while (0)
#define RING_WRITE(S, slotp) do { LAS unsigned char* sp_ = (slotp); \
                *(LAS u32x2*)(sp_ + w0a[0]) = (u32x2){S.r0.x, S.r0.y}; *(LAS u32x2*)(sp_ + w0a[1]) = (u32x2){S.r0.z, S.r0.w}; \
                *(LAS u32x2*)(sp_ + w1a[0]) = (u32x2){S.r1.x, S.r1.y}; *(LAS u32x2*)(sp_ + w1a[1]) = (u32x2){S.r1.z, S.r1.w}; \
                *(LAS u32x2*)(sp_ + w2a[0]) = (u32x2){S.r2.x, S.r2.y}; *(LAS u32x2*)(sp_ + w2a[1]) = (u32x2){S.r2.z, S.r2.w}; \
                if (lw == 0 && lane < 16) *(LAS u32x4*)(sp_ + ldW) = S.rw; } while (0)
            RING_LOAD(s0, 0); RING_LOAD(s1, 1); RING_LOAD(s2, 2); RING_LOAD(s3, 3); RING_LOAD(s4, 4); RING_LOAD(s5, 5); RING_LOAD(s6, 6); RING_LOAD(s7, 7);
            RING_WRITE(s0, lds); RING_LOAD(s0, 8); RING_WRITE(s1, lds + RS_STRIDE);
            SCAN_BAR();
#define LOADER_ITER(cc, WS, LS) do { \
                RING_WRITE(WS, lds + (((cc) + 2) % 3) * RS_STRIDE); RING_LOAD(LS, (cc) + 9); \
                if ((cc) >= 1 && (cc) <= NCHK) { const int pc = (cc) - 1; const LAS float* ob = obuf + (pc & 1) * 1024; \
                    _Pragma("unroll") for (int q = 0; q < 4; ++q) { const int ts = 4 * lw + q; \
                        __builtin_amdgcn_raw_buffer_store_b16(f2bf_bits(ob[ts * 64 + lane]), rsO, 2 * lane, sb0 + (pc * 16 + ts) * 1024, 0); } } \
                SCAN_BAR(); } while (0)
            static_assert(SCAN_NIT % 8 == 0 && SCAN_NIT > NCHK, "loader iterations come in eights");
            for (int cc = 0; cc < SCAN_NIT; cc += 8) { LOADER_ITER(cc, s2, s1); LOADER_ITER(cc + 1, s3, s2); LOADER_ITER(cc + 2, s4, s3); LOADER_ITER(cc + 3, s5, s4);
                                                      LOADER_ITER(cc + 4, s6, s5); LOADER_ITER(cc + 5, s7, s6); LOADER_ITER(cc + 6, s0, s7); LOADER_ITER(cc + 7, s1, s0); }
#undef LOADER_ITER
#undef RING_WRITE
#undef RING_LOAD
        }
        __syncthreads();
    }
#undef SCAN_BAR
}

__device__ __forceinline__ void p4c_post(const Args& a, int G, const int wave) {
    const int lane = pg8::get_lane();
    const bf16_t* ORAW = (const bf16_t*)(a.ws + WS_ORAW); const bf16_t* Vb = (const bf16_t*)((unsigned char*)a.out + 33 * MiB); const bf16_t* Gb = (const bf16_t*)(a.ws + WS_ZR + 33 * MiB);
    const float* RKs = (const float*)(a.ws + WS_RK); bf16_t* ACR = (bf16_t*)(a.ws + WS_XN);
    const float* gn_g = a.in[18]; const float* gn_b = a.in[19];
    const int gw = blockIdx.x * NWAVES + wave, NGW = G * NWAVES;
    for (int m2 = gw; m2 < M2; m2 += NGW) {
        const int b = m2 >> 12, t = (m2 & 4095) + NMETA; const size_t m = (size_t)b * T + t;
        const int c = t >> 4, ts = t & 15;
        const float rkv = (lane < 8) ? RKs[m * 8 + lane] : 0.f;
#pragma unroll
        for (int h = 0; h < NHEAD; ++h) {
            const float o = bf2f(ORAW[m * 512 + h * 64 + lane]);
            const float vv = bf2f(Vb[((size_t)b * T + c * 16 + (lane >> 2)) * 512 + h * 64 + (lane & 3) * 16 + ts]);
            const float gg = bf2f(Gb[m * 512 + h * 64 + lane]);
            const float s1 = wave_sum(o), s2 = wave_sum(o * o);
            const float mean = s1 * (1.f / 64.f), var = fmaxf(s2 * (1.f / 64.f) - mean * mean, 0.f);
            const float rk = __builtin_bit_cast(float, __builtin_amdgcn_readlane(__builtin_bit_cast(int, rkv), h));
            const float res = ((o - mean) * (1.f / sqrtf(var + 64e-5f)) * gn_g[h * 64 + lane] + gn_b[h * 64 + lane] + rk * vv) * gg;
            ACR[(size_t)m2 * 512 + h * 64 + lane] = f2bf_bits(res);
        }
    }
}

#define CE_DESC(x, y) do { const float _hi = fmaxf((x), (y)), _lo = fminf((x), (y)); (x) = _hi; (y) = _lo; } while (0)
__device__ __forceinline__ void sort16_desc(float (&v)[16]) {
#pragma unroll
    for (int k = 2; k <= 16; k <<= 1) {
#pragma unroll
        for (int j = k >> 1; j > 0; j >>= 1) {
#pragma unroll
            for (int i = 0; i < 16; ++i) { const int l = i ^ j; if (l > i) { if ((i & k) == 0) CE_DESC(v[i], v[l]); else CE_DESC(v[l], v[i]); } }
        }
    }
}
__device__ __forceinline__ void merge16(float (&x)[16], const float (&y)[16]) {
#pragma unroll
    for (int i = 0; i < 16; ++i) x[i] = fmaxf(x[i], y[15 - i]);
#pragma unroll
    for (int j = 8; j > 0; j >>= 1) {
#pragma unroll
        for (int i = 0; i < 16; ++i) { const int l = i ^ j; if (l > i) CE_DESC(x[i], x[l]); }
    }
}
__device__ __forceinline__ void xmerge16(float (&x)[16], int mask) {
    float y[16];
#pragma unroll
    for (int i = 0; i < 16; ++i) y[i] = __shfl_xor(x[i], mask);
    merge16(x, y);
}
__device__ __forceinline__ float pk_low(float x, unsigned code, unsigned keep_mask) { return __builtin_bit_cast(float, (__builtin_bit_cast(unsigned, x) & keep_mask) | code); }

__device__ __forceinline__ void p9_topk(const Args& a, LAS unsigned char* lds, int G, const int wave) {
    const int lane = pg8::get_lane(), tid = wave * 64 + lane;
    const bf16_t* Q = (const bf16_t*)(a.ws + WS_ZG); const bf16_t* SK = (const bf16_t*)(a.ws + WS_SK);
    int* TKid = (int*)(a.ws + WS_KK); float* TKg = (float*)(a.ws + WS_KK + 16 * MiB);
    LAS unsigned char* wl = lds + 65536 + wave * 512;
    const int fr = lane & 15, fq = lane >> 4;
    const bool aligned = (G % 8 == 0);
    const int nhb = aligned ? G / 8 : G, rank = aligned ? (int)(blockIdx.x >> 3) : (int)blockIdx.x;
    constexpr int NGRP = M2 / 16;
    for (int h = aligned ? (int)(blockIdx.x & 7) : 0; h < PH; h += aligned ? 8 : 1) {
        __syncthreads();
#pragma unroll
        for (int k = 0; k < 8; ++k) { const int pi = wave * 64 + lane + 512 * k, c = pi >> 11, row = (pi >> 4) & 127, pp = pi & 15;
            const u32x4 v = *(const u32x4*)(SK + ((size_t)(h * 2 + c) * 128 + row) * 128 + pp * 8);
            *(LAS u32x4*)(lds + c * 32768 + row * 256 + ((pp ^ (row & 15)) * 16)) = v; }
        __syncthreads();
    for (int grp = rank * NWAVES + wave; grp < NGRP; grp += nhb * NWAVES) {
        const int tok0 = grp * 16;
        float top[2][16];
#pragma unroll
        for (int c = 0; c < 2; ++c) {
            f32x4 acc[8];
#pragma unroll
            for (int nt = 0; nt < 8; ++nt) acc[nt] = (f32x4){0.f, 0.f, 0.f, 0.f};
            const bf16_t* qrow = Q + (size_t)(tok0 + fr) * 2048 + h * 256 + c * 128 + fq * 8;
            bf16x8 qf[4];
#pragma unroll
            for (int ks = 0; ks < 4; ++ks) qf[ks] = *(const bf16x8*)(qrow + ks * 32);
            const LAS unsigned char* skl = lds + c * 32768 + fr * 256;
#pragma unroll
            for (int nt = 0; nt < 8; ++nt)
#pragma unroll
                for (int ks = 0; ks < 4; ++ks) { const bf16x8 kf = *(const LAS bf16x8*)(skl + nt * 4096 + (((4 * ks + fq) ^ fr) * 16));
                    acc[nt] = __builtin_amdgcn_mfma_f32_16x16x32_bf16(kf, qf[ks], acc[nt], 0, 0, 0); }
            float lo[16], hi[16];
#pragma unroll
            for (int nt = 0; nt < 4; ++nt)
#pragma unroll
                for (int r = 0; r < 4; ++r) { lo[nt * 4 + r] = pk_low(acc[nt][r], (unsigned)(16 * nt + 4 * fq + r), 0xffffff80u); hi[nt * 4 + r] = pk_low(acc[nt + 4][r], (unsigned)(16 * (nt + 4) + 4 * fq + r), 0xffffff80u); }
            sort16_desc(lo); sort16_desc(hi); merge16(lo, hi); xmerge16(lo, 16); xmerge16(lo, 32);
#pragma unroll
            for (int i = 0; i < 16; ++i) top[c][i] = lo[i];
        }
        float cand[16];
        const float PAD = -3.0e38f;
#pragma unroll
        for (int s = 0; s < 16; ++s) {
            const int i1 = (s < 8) ? 1 : (s < 13) ? 2 : 4, j1 = (s < 8) ? s : (s < 13) ? s - 8 : s - 13;
            const int i2 = (s < 4) ? 3 : (s < 6) ? 5 : (s < 8) ? 6 : 7, j2 = (s < 4) ? s : (s < 6) ? s - 4 : (s < 8) ? s - 6 : s - 8;
            const float c0 = pk_low(top[0][0] + top[1][s], (unsigned)s, 0xffffff00u);
            const float c1 = pk_low(top[0][i1] + top[1][j1], (unsigned)(i1 * 16 + j1), 0xffffff00u);
            const float c2 = (s < 10) ? pk_low(top[0][i2] + top[1][j2], (unsigned)(i2 * 16 + j2), 0xffffff00u) : PAD;
            const float c3 = (s < 8) ? pk_low(top[0][8 + s] + top[1][0], (unsigned)((8 + s) * 16), 0xffffff00u) : PAD;
            cand[s] = (fq == 0) ? c0 : (fq == 1) ? c1 : (fq == 2) ? c2 : c3;
        }
        sort16_desc(cand); xmerge16(cand, 16); xmerge16(cand, 32);
        if (fq == 0) {
            u32x4 wa, wb; unsigned pa[4], pb[4];
#pragma unroll
            for (int g = 0; g < 4; ++g) { pa[g] = 0u; pb[g] = 0u;
#pragma unroll
                for (int j = 0; j < 4; ++j) { pa[g] |= (__builtin_bit_cast(unsigned, top[0][4 * g + j]) & 0x7fu) << (8 * j); pb[g] |= (__builtin_bit_cast(unsigned, top[1][4 * g + j]) & 0x7fu) << (8 * j); } }
            wa.x = pa[0]; wa.y = pa[1]; wa.z = pa[2]; wa.w = pa[3]; wb.x = pb[0]; wb.y = pb[1]; wb.z = pb[2]; wb.w = pb[3];
            *(LAS u32x4*)(wl + fr * 32) = wa; *(LAS u32x4*)(wl + fr * 32 + 16) = wb;
            LDS_WAIT();
            float p[16], sum = 0.f; int eid[16];
            const float mx = cand[0], rsq = __builtin_amdgcn_rsqf(((const float*)(a.ws + WS_SSQ))[tok0 + fr] * (1.f / 1024.f) + 1e-6f);
#pragma unroll
            for (int i = 0; i < 16; ++i) { p[i] = __expf((cand[i] - mx) * rsq); sum += p[i];
                const unsigned code = __builtin_bit_cast(unsigned, cand[i]) & 0xffu;
                const int i1 = wl[fr * 32 + (code >> 4)], i2 = wl[fr * 32 + 16 + (code & 15u)];
                eid[i] = i1 * PK + i2; }
            const float inv = 1.f / sum;
            int* ip = TKid + (size_t)(tok0 + fr) * 128 + h * 16; float* gp = TKg + (size_t)(tok0 + fr) * 128 + h * 16;
#pragma unroll
            for (int g = 0; g < 4; ++g) { *(int4*)(ip + 4 * g) = make_int4(eid[4 * g], eid[4 * g + 1], eid[4 * g + 2], eid[4 * g + 3]);
                *(f32x4*)(gp + 4 * g) = (f32x4){p[4 * g] * inv, p[4 * g + 1] * inv, p[4 * g + 2] * inv, p[4 * g + 3] * inv}; }
            LDS_WAIT();
        }
    }
    }
}

typedef __bf16 bf16v2 __attribute__((ext_vector_type(2)));
__device__ __forceinline__ float dot2bf(unsigned x, unsigned y, float acc) { return __builtin_amdgcn_fdot2_f32_bf16(__builtin_bit_cast(bf16v2, x), __builtin_bit_cast(bf16v2, y), acc, false); }
__device__ __forceinline__ float gelu_exact(float x) { return 0.5f * x * (1.f + erff(x * 0.70710678118f)); }

typedef float f32x2 __attribute__((ext_vector_type(2)));
struct XcdPart { unsigned nloc, nx, rnk, kx; };
typedef long i64_t;
__device__ __forceinline__ i64_t pack64(unsigned lo, unsigned hi) { const u32x2 w = {lo, hi}; return __builtin_bit_cast(i64_t, w); }
__device__ __forceinline__ void pu_partial(const Args& a, LAS unsigned char* lds, const int wave, const XcdPart xp) {
    const int lane = pg8::get_lane(), j16 = lane & 15, kq = lane >> 4;
    const bf16_t* H1b = (const bf16_t*)(a.ws + WS_ZC); const int* TKid = (const int*)(a.ws + WS_KK); const float* ssq = (const float*)(a.ws + WS_SSQ);
    const unsigned char* EU = a.ws + WS_EU; bf16_t* PART = (bf16_t*)(a.ws + WS_ZG);
    const int t_first = (int)xp.rnk * NWAVES + wave, t_stride = (int)xp.nloc * NWAVES;
    const int nt = (t_first < M2) ? (M2 - t_first + t_stride - 1) / t_stride : 0;
    if (nt == 0) return;
    const __amdgpu_buffer_rsrc_t rP = __builtin_amdgcn_make_buffer_rsrc((void*)PART, 0, 0x7fffffff, 0x00020000);
    LAS unsigned char* wl = lds + wave * 16384; LAS unsigned char* xs = lds + 132096 + wave * 128; LAS unsigned char* la = lds + 133120 + wave * 1664;
    const int pz0 = ((lane & 7) ^ (lane >> 4)) * 16, pz1 = ((lane & 7) ^ (4 + (lane >> 4))) * 16;
    const int mm = (j16 >> 1) & 7, rob = (j16 >> 3) * 1024 + (j16 & 7) * 128;
    const int ro0 = rob + (((2 * kq) ^ mm) * 16), ro1 = rob + (((2 * kq + 1) ^ mm) * 16);
    const f32x4 z4 = {0.f, 0.f, 0.f, 0.f};
    for (int s = (int)xp.kx; s < 8; s += (int)xp.nx) {
        const unsigned char* EUs = EU + 128 * s;
        i64_t xc[4];
#define PU_X(j) do { const int jc_ = ((j) < nt) ? (j) : nt - 1; const int tk_ = t_first + jc_ * t_stride; LAS unsigned char* sl_ = la + ((j) & 1) * 832; \
            __builtin_amdgcn_global_load_lds((const unsigned*)(TKid + (size_t)tk_ * 128 + lane), (LAS unsigned*)sl_, 4, 0, 0); \
            __builtin_amdgcn_global_load_lds((const unsigned*)(TKid + (size_t)tk_ * 128 + 64 + lane), (LAS unsigned*)(sl_ + 256), 4, 0, 0); \
            __builtin_amdgcn_global_load_lds((const unsigned*)(H1b + (size_t)tk_ * 1024 + 128 * s + 2 * lane), (LAS unsigned*)(sl_ + 512), 4, 0, 0); \
            if (lane == 0) __builtin_amdgcn_global_load_lds((const unsigned*)(ssq + tk_), (LAS unsigned*)(sl_ + 768), 4, 0, 0); } while (0)
#define PU_X8(j) do { const LAS unsigned char* sl_ = la + ((j) & 1) * 832; const u32x4 X = *(const LAS u32x4*)(sl_ + 512 + 16 * j16); const float sq_ = *(const LAS float*)(sl_ + 768); \
            const float sc_ = 16.f * __builtin_amdgcn_rsqf(sq_ * (1.f / 1024.f) + 1e-6f); \
            int p0_ = 0, p1_ = 0; \
            p0_ = __builtin_amdgcn_cvt_pk_fp8_f32(bflo(X.x) * sc_, bfhi(X.x) * sc_, p0_, false); p0_ = __builtin_amdgcn_cvt_pk_fp8_f32(bflo(X.y) * sc_, bfhi(X.y) * sc_, p0_, true); \
            p1_ = __builtin_amdgcn_cvt_pk_fp8_f32(bflo(X.z) * sc_, bfhi(X.z) * sc_, p1_, false); p1_ = __builtin_amdgcn_cvt_pk_fp8_f32(bflo(X.w) * sc_, bfhi(X.w) * sc_, p1_, true); \
            *(LAS u32x2*)(xs + 8 * j16) = (u32x2){(unsigned)p0_, (unsigned)p1_}; LDS_WAIT(); asm volatile("" ::: "memory"); \
            const u32x4 xa_ = *(const LAS u32x4*)(xs + 32 * kq), xb_ = *(const LAS u32x4*)(xs + 32 * kq + 16); LDS_WAIT(); asm volatile("" ::: "memory"); \
            xc[0] = pack64(xa_.x, xa_.y); xc[1] = pack64(xa_.z, xa_.w); xc[2] = pack64(xb_.x, xb_.y); xc[3] = pack64(xb_.z, xb_.w); } while (0)
#define PU_Q(j, c) do { const LAS unsigned char* sl_ = la + ((j) & 1) * 832; _Pragma("unroll") for (int w_ = 0; w_ < 4; ++w_) { \
            const unsigned id_ = *(const LAS unsigned*)(sl_ + 4 * (32 * (c) + 8 * w_ + (lane >> 3))); \
            const unsigned char* gp_ = EUs + ((size_t)id_ << 10) + ((w_ & 1) ? pz1 : pz0); \
            __builtin_amdgcn_global_load_lds((const unsigned*)gp_, (LAS unsigned*)(wl + (c) * 4096 + w_ * 1024), 16, 0, 1); } } while (0)
#define PU_G(ACC, P0, P1) do { ACC = __builtin_amdgcn_mfma_f32_16x16x32_fp8_fp8(xc[0], pack64(P0.x, P0.y), z4, 0, 0, 0); ACC = __builtin_amdgcn_mfma_f32_16x16x32_fp8_fp8(xc[1], pack64(P0.z, P0.w), ACC, 0, 0, 0); \
            ACC = __builtin_amdgcn_mfma_f32_16x16x32_fp8_fp8(xc[2], pack64(P1.x, P1.y), ACC, 0, 0, 0); ACC = __builtin_amdgcn_mfma_f32_16x16x32_fp8_fp8(xc[3], pack64(P1.z, P1.w), ACC, 0, 0, 0); } while (0)
#define PU_C(ACC0, ACC1, c) do { asm volatile("s_waitcnt vmcnt(16)" ::: "memory"); \
            const u32x4 a0_ = *(const LAS u32x4*)(wl + (c) * 4096 + ro0), a1_ = *(const LAS u32x4*)(wl + (c) * 4096 + ro1), b0_ = *(const LAS u32x4*)(wl + (c) * 4096 + 2048 + ro0), b1_ = *(const LAS u32x4*)(wl + (c) * 4096 + 2048 + ro1); \
            LDS_WAIT(); asm volatile("" ::: "memory");        \
            PU_G(ACC0, a0_, a1_); PU_G(ACC1, b0_, b1_); } while (0)
        PU_X(0); PU_X(1);
        asm volatile("s_waitcnt vmcnt(0)" ::: "memory");
        PU_X8(0);
        PU_Q(0, 0); PU_Q(0, 1); PU_Q(0, 2); PU_Q(0, 3);
        for (int j = 0; j < nt; ++j) {
            PU_X(j + 2);
            f32x4 c0, c1, c2, c3, c4, c5, c6, c7;
            PU_C(c0, c1, 0); PU_Q(j + 1, 0);
            PU_C(c2, c3, 1); PU_Q(j + 1, 1);
            PU_C(c4, c5, 2); PU_Q(j + 1, 2);
            PU_C(c6, c7, 3); PU_Q(j + 1, 3);
            { const float v0 = (kq == 0) ? c0[0] : (kq == 1) ? c1[0] : (kq == 2) ? c2[0] : c3[0], v1 = (kq == 0) ? c4[0] : (kq == 1) ? c5[0] : (kq == 2) ? c6[0] : c7[0];
              const int so_ = (s * M2 + t_first + j * t_stride) * 256;
              __builtin_amdgcn_raw_buffer_store_b16(f2bf_bits(v0), rP, 2 * lane, so_, 0); __builtin_amdgcn_raw_buffer_store_b16(f2bf_bits(v1), rP, 2 * lane + 128, so_, 0); }
            PU_X8(j + 1);
        }
        asm volatile("s_waitcnt vmcnt(0)" ::: "memory");
#undef PU_C
#undef PU_G
#undef PU_Q
#undef PU_X8
#undef PU_X
    }
}
__device__ __forceinline__ void pc_combine(const Args& a, int G, const int wave) {
    const int lane = pg8::get_lane();
    const int* TKid = (const int*)(a.ws + WS_KK); const float* TKg = (const float*)(a.ws + WS_KK + 16 * MiB); const bf16_t* PART = (const bf16_t*)(a.ws + WS_ZG); bf16_t* CFb = (bf16_t*)(a.ws + WS_A2);
    const float* SU = (const float*)(a.ws + WS_EU + 16 * MiB); const float* SV = (const float*)(a.ws + WS_EV + 16 * MiB);
    const int gt = blockIdx.x * NTHR + wave * 64 + lane, NGT = G * NTHR;
    for (int idx0 = gt; idx0 < M2 * 128; idx0 += 4 * NGT) {
        int id[4]; float gt4[4], sm[4], su[4], sv[4];
#pragma unroll
        for (int u = 0; u < 4; ++u) { const int idx = idx0 + u * NGT; const int ic = (idx < M2 * 128) ? idx : idx0;
            id[u] = TKid[ic]; gt4[u] = TKg[ic];
            unsigned short pr[8];
#pragma unroll
            for (int sl = 0; sl < 8; ++sl) pr[sl] = PART[(size_t)sl * M2 * 128 + ic];
            float s = 0.f;
#pragma unroll
            for (int sl = 0; sl < 8; ++sl) s += bf2f(pr[sl]);
            sm[u] = s; }
#pragma unroll
        for (int u = 0; u < 4; ++u) { su[u] = SU[id[u]]; sv[u] = SV[id[u]]; }
#pragma unroll
        for (int u = 0; u < 4; ++u) { const int idx = idx0 + u * NGT;
            if (idx < M2 * 128) CFb[idx] = f2bf_bits(gt4[u] * gelu_exact(sm[u] * (1.f / 16.f) * su[u]) * sv[u]); }
    }
}
__device__ __forceinline__ float wave_max_nn(float x) {
#define DPP_MAXNN(x, ctrl) fmaxf((x), __builtin_bit_cast(float, __builtin_amdgcn_update_dpp(0, __builtin_bit_cast(int, (x)), (ctrl), 0xf, 0xf, true)))
    x = DPP_MAXNN(x, 0xB1); x = DPP_MAXNN(x, 0x4E); x = DPP_MAXNN(x, 0x141); x = DPP_MAXNN(x, 0x140);
#undef DPP_MAXNN
    const int xi = __builtin_bit_cast(int, x);
    const float a = __builtin_bit_cast(float, __builtin_amdgcn_readlane(xi, 0)), b = __builtin_bit_cast(float, __builtin_amdgcn_readlane(xi, 16)), c = __builtin_bit_cast(float, __builtin_amdgcn_readlane(xi, 32)), d = __builtin_bit_cast(float, __builtin_amdgcn_readlane(xi, 48));
    return fmaxf(fmaxf(a, b), fmaxf(c, d));
}
typedef int v2i_t __attribute__((ext_vector_type(2)));
__device__ __forceinline__ void pv_output(const Args& a, LAS unsigned char* lds, const int wave, const XcdPart xp) {
    const int lane = pg8::get_lane(), kq = lane >> 4;
    const int* TKid = (const int*)(a.ws + WS_KK); const bf16_t* CFb = (const bf16_t*)(a.ws + WS_A2);
    const unsigned char* EV = a.ws + WS_EV; bf16_t* Y = (bf16_t*)(a.ws + WS_ZG);
    const int t_first = (int)xp.rnk * NWAVES + wave, t_stride = (int)xp.nloc * NWAVES;
    const int nt = (t_first < M2) ? (M2 - t_first + t_stride - 1) / t_stride : 0;
    if (nt == 0) return;
    const __amdgpu_buffer_rsrc_t rY = __builtin_amdgcn_make_buffer_rsrc((void*)Y, 0, 0x7fffffff, 0x00020000);
    LAS unsigned char* wl = lds + wave * 16384; LAS unsigned char* cv = lds + 131328 + wave * 128; LAS unsigned char* la = lds + 132352 + wave * 1536;
    const int pz0 = ((lane & 7) ^ (lane >> 4)) * 16, pz1 = ((lane & 7) ^ (4 + (lane >> 4))) * 16;
    const int q = (lane & 15) >> 1, jj = 8 * (kq & 1) + q, mm = (jj >> 1) & 7;
    const int trb = (kq >> 1) * 2048 + (jj >> 3) * 1024 + (jj & 7) * 128 + 8 * (lane & 1);
    for (int s = (int)xp.kx; s < 8; s += (int)xp.nx) {
        const unsigned char* EVs = EV + 128 * s;
        i64_t cf[4]; float yinv;
#define PV_X(j) do { const int jc_ = ((j) < nt) ? (j) : nt - 1; const int tk_ = t_first + jc_ * t_stride; LAS unsigned char* sl_ = la + ((j) & 1) * 768; \
            __builtin_amdgcn_global_load_lds((const unsigned*)(TKid + (size_t)tk_ * 128 + lane), (LAS unsigned*)sl_, 4, 0, 0); \
            __builtin_amdgcn_global_load_lds((const unsigned*)(TKid + (size_t)tk_ * 128 + 64 + lane), (LAS unsigned*)(sl_ + 256), 4, 0, 0); \
            __builtin_amdgcn_global_load_lds((const unsigned*)(CFb + (size_t)tk_ * 128 + 2 * lane), (LAS unsigned*)(sl_ + 512), 4, 0, 0); } while (0)
#define PV_CF(j) do { const LAS unsigned char* sl_ = la + ((j) & 1) * 768; const unsigned w_ = *(const LAS unsigned*)(sl_ + 512 + 4 * lane); const float c0_ = bflo(w_), c1_ = bfhi(w_); \
            const float m_ = fmaxf(wave_max_nn(fmaxf(fabsf(c0_), fabsf(c1_))), 1e-30f); const float sc_ = 256.f * __builtin_amdgcn_rcpf(m_); yinv = m_ * (1.f / 256.f); \
            const int p_ = __builtin_amdgcn_cvt_pk_fp8_f32(c0_ * sc_, c1_ * sc_, 0, false); \
            *(LAS unsigned short*)(cv + 2 * lane) = (unsigned short)(p_ & 0xffff); LDS_WAIT(); asm volatile("" ::: "memory"); \
            _Pragma("unroll") for (int k_ = 0; k_ < 4; ++k_) cf[k_] = *(const LAS i64_t*)(cv + 32 * k_ + 8 * kq); \
            LDS_WAIT(); asm volatile("" ::: "memory"); } while (0)
#define PV_Q(j, c) do { const LAS unsigned char* sl_ = la + ((j) & 1) * 768; _Pragma("unroll") for (int w_ = 0; w_ < 4; ++w_) { \
            const unsigned id_ = *(const LAS unsigned*)(sl_ + 4 * (32 * (c) + 8 * w_ + (lane >> 3))); \
            const unsigned char* gp_ = EVs + ((size_t)id_ << 10) + ((w_ & 1) ? pz1 : pz0); \
            __builtin_amdgcn_global_load_lds((const unsigned*)gp_, (LAS unsigned*)(wl + (c) * 4096 + w_ * 1024), 16, 0, 1); } } while (0)
#define PV_C(c) do { asm volatile("s_waitcnt vmcnt(15)" ::: "memory"); v2i_t b_[8]; \
            _Pragma("unroll") for (int n_ = 0; n_ < 8; ++n_) b_[n_] = __builtin_amdgcn_ds_read_tr8_b64_v2i32((LAS v2i_t*)(wl + (c) * 4096 + trb + ((n_ ^ mm) * 16))); \
            LDS_WAIT(); asm volatile("" ::: "memory");        \
            _Pragma("unroll") for (int n_ = 0; n_ < 8; ++n_) acc[n_] = __builtin_amdgcn_mfma_f32_16x16x32_fp8_fp8(cf[c], __builtin_bit_cast(i64_t, b_[n_]), acc[n_], 0, 0, 0); } while (0)
        PV_X(0); PV_X(1);
        asm volatile("s_waitcnt vmcnt(0)" ::: "memory");
        PV_CF(0);
        PV_Q(0, 0); PV_Q(0, 1); PV_Q(0, 2); PV_Q(0, 3);
        for (int j = 0; j < nt; ++j) {
            PV_X(j + 2);
            f32x4 acc[8];
#pragma unroll
            for (int n_ = 0; n_ < 8; ++n_) acc[n_] = (f32x4){0.f, 0.f, 0.f, 0.f};
            PV_C(0); PV_Q(j + 1, 0);
            PV_C(1); PV_Q(j + 1, 1);
            PV_C(2); PV_Q(j + 1, 2);
            PV_C(3); PV_Q(j + 1, 3);
            { const float v0 = ((kq == 0) ? acc[0][0] : (kq == 1) ? acc[1][0] : (kq == 2) ? acc[2][0] : acc[3][0]) * yinv, v1 = ((kq == 0) ? acc[4][0] : (kq == 1) ? acc[5][0] : (kq == 2) ? acc[6][0] : acc[7][0]) * yinv;
              const int so_ = (t_first + j * t_stride) * 2048 + 256 * s;
              __builtin_amdgcn_raw_buffer_store_b16(f2bf_bits(v0), rY, 2 * lane, so_, 0); __builtin_amdgcn_raw_buffer_store_b16(f2bf_bits(v1), rY, 2 * lane + 128, so_, 0); }
            PV_CF(j + 1);
        }
        asm volatile("s_waitcnt vmcnt(0)" ::: "memory");
#undef PV_C
#undef PV_Q
#undef PV_CF
#undef PV_X
    }
}
__device__ __forceinline__ void pf_final(const Args& a, int G, const int wave) {
    const int lane = pg8::get_lane();
    float* OUT = a.out; const bf16_t* H1b = (const bf16_t*)(a.ws + WS_ZC); const bf16_t* Y = (const bf16_t*)(a.ws + WS_ZG); const float* gfin = a.in[27];
    const int gw = blockIdx.x * NWAVES + wave, NGW = G * NWAVES;
    f32x4 g[4];
#pragma unroll
    for (int q = 0; q < 4; ++q) g[q] = *(const f32x4*)(gfin + 16 * lane + 4 * q);
    u32x4 hn0, hn1, yn0, yn1;
#define PF_LOAD(tok) do { hn0 = *(const u32x4*)(H1b + (size_t)(tok) * 1024 + 16 * lane); hn1 = *(const u32x4*)(H1b + (size_t)(tok) * 1024 + 16 * lane + 8); \
        yn0 = *(const u32x4*)(Y + (size_t)(tok) * 1024 + 16 * lane); yn1 = *(const u32x4*)(Y + (size_t)(tok) * 1024 + 16 * lane + 8); } while (0)
    if (gw < M2) PF_LOAD(gw);
    for (int tok = gw; tok < M2; tok += NGW) {
        const u32x4 h0 = hn0, h1 = hn1, y0 = yn0, y1 = yn1;
        { const int tn = (tok + NGW < M2) ? tok + NGW : tok; PF_LOAD(tn); }
        f32x4 h[4];
        h[0] = (f32x4){bflo(h0.x) + bflo(y0.x), bfhi(h0.x) + bfhi(y0.x), bflo(h0.y) + bflo(y0.y), bfhi(h0.y) + bfhi(y0.y)};
        h[1] = (f32x4){bflo(h0.z) + bflo(y0.z), bfhi(h0.z) + bfhi(y0.z), bflo(h0.w) + bflo(y0.w), bfhi(h0.w) + bfhi(y0.w)};
        h[2] = (f32x4){bflo(h1.x) + bflo(y1.x), bfhi(h1.x) + bfhi(y1.x), bflo(h1.y) + bflo(y1.y), bfhi(h1.y) + bfhi(y1.y)};
        h[3] = (f32x4){bflo(h1.z) + bflo(y1.z), bfhi(h1.z) + bfhi(y1.z), bflo(h1.w) + bflo(y1.w), bfhi(h1.w) + bfhi(y1.w)};
        float s = 0.f;
#pragma unroll
        for (int q = 0; q < 4; ++q) s += (h[q][0] * h[q][0] + h[q][1] * h[q][1]) + (h[q][2] * h[q][2] + h[q][3] * h[q][3]);
        const float rf = __builtin_amdgcn_rsqf(wave_sum(s) * (1.f / 1024.f) + 1e-6f);
        float* op = OUT + (size_t)tok * 1024 + 16 * lane;
#pragma unroll
        for (int q = 0; q < 4; ++q) *(f32x4*)(op + 4 * q) = h[q] * rf * g[q];
    }
#undef PF_LOAD
}

#define XB_TMO      128
#define XB_XCNT(j)  (256  + 64 * (j))
#define XB_XSUB(j)  (1280 + 64 * (j))
#define XB_XGEN(j)  (2304 + 64 * (j))
#define XB_TOP      3328
#define XB_TOPGEN   3392
#define XCD_BAR_WORDS 3456
#define XB_SPIN_CAP (1u << 23)
__device__ __forceinline__ unsigned xb_ld(unsigned* p)              { return __hip_atomic_load(p, __ATOMIC_RELAXED, __HIP_MEMORY_SCOPE_AGENT); }
__device__ __forceinline__ unsigned xb_add(unsigned* p, unsigned v) { return __hip_atomic_fetch_add(p, v, __ATOMIC_RELAXED, __HIP_MEMORY_SCOPE_AGENT); }
__device__ __forceinline__ unsigned xb_xcc_id() { return (unsigned)__builtin_amdgcn_s_getreg((3 << 11) | 20) & 0xFu; }
#define XB_SPIN(cond, bar) do { unsigned _sp = 0; while (cond) { __builtin_amdgcn_s_sleep(1); \
    if ((++_sp & 255u) == 0u) { if (xb_ld(&(bar)[XB_TMO])) break; if (_sp > XB_SPIN_CAP) { atomicAdd(&(bar)[XB_TMO], 1u); break; } } } } while (0)
struct XcdBarrier { unsigned* bar; unsigned x; volatile LAS unsigned* st; };
__device__ __forceinline__ void xcd_barrier_complete(unsigned* bar, unsigned x, unsigned G, unsigned& nloc, unsigned& nx, unsigned& below) {
    unsigned sum, cnt, mine, sp = 0u;
    for (;;) {
        sum = 0u; cnt = 0u; mine = 0u; below = 0u;
#pragma unroll
        for (unsigned j = 0; j < 16; ++j) { const unsigned c = xb_ld(&bar[XB_XCNT(j)]); sum += c; cnt += (c > 0u) ? 1u : 0u; mine = (j == x) ? c : mine; below += (j < x && c > 0u) ? 1u : 0u; }
        if (sum == G) break;
        __builtin_amdgcn_s_sleep(1);
        if ((++sp & 255u) == 0u) { if (xb_ld(&bar[XB_TMO])) break; if (sp > XB_SPIN_CAP) { atomicAdd(&bar[XB_TMO], 1u); break; } }
    }
    nloc = mine > 0u ? mine : 1u; nx = cnt > 0u ? cnt : 1u;
}
__device__ __forceinline__ void xcd_barrier(const XcdBarrier& b, const bool t0, const unsigned G) {
    asm volatile("s_waitcnt vmcnt(0)" ::: "memory");
    __syncthreads();
    if (t0) {
        unsigned* bar = b.bar;
        __builtin_amdgcn_s_waitcnt(0);
        unsigned nloc = b.st[0], nx = b.st[1];
        if (nloc == 0u) { unsigned below; xcd_barrier_complete(bar, b.x, G, nloc, nx, below); b.st[0] = nloc; b.st[1] = nx; b.st[3] = below; }
        const unsigned old = xb_add(&bar[XB_XSUB(b.x)], 1u);
        const unsigned gen = old / nloc;
        if (old + 1u == (gen + 1u) * nloc) {
            __builtin_amdgcn_fence(__ATOMIC_RELEASE, "agent");
            asm volatile("s_waitcnt vmcnt(0)" ::: "memory");
            const unsigned og = xb_add(&bar[XB_TOP], 1u);
            const unsigned tg = og / nx;
            if (og + 1u == (tg + 1u) * nx) xb_add(&bar[XB_TOPGEN], 1u);
            else XB_SPIN(xb_ld(&bar[XB_TOPGEN]) == tg, bar);
            __builtin_amdgcn_fence(__ATOMIC_ACQUIRE, "agent");
            xb_add(&bar[XB_XGEN(b.x)], 1u);
            asm volatile("s_waitcnt vmcnt(0)" ::: "memory");
        } else {
            XB_SPIN(xb_ld(&bar[XB_XGEN(b.x)]) == gen, bar);
            __builtin_amdgcn_fence(__ATOMIC_ACQUIRE, "agent");
            asm volatile("s_waitcnt vmcnt(0)" ::: "memory");
        }
    }
    __syncthreads();
}
constexpr size_t WS_BAR = 64 * 1024;
constexpr int LDS_BAR_OFF = 131072;

#if defined(MK_DUP_PH) && MK_DUP_PH == 5
#define MK_REP5 2
#else
#define MK_REP5 1
#endif
#if defined(MK_DUP_PH) && MK_DUP_PH == 7
#define MK_REP7 2
#else
#define MK_REP7 1
#endif
constexpr int NPH = 13;
__global__ void __launch_bounds__(NTHR, 2) fwd_kernel(Args a) {
    __shared__ __attribute__((aligned(16))) unsigned char lds_raw[LDS_BYTES];
    LAS unsigned char* lds = (LAS unsigned char*)lds_raw;
    const int G = gridDim.x;
    const int wave_s = __builtin_amdgcn_readfirstlane((int)threadIdx.x >> 6);
    const int lo = a.ph_lo, hi = a.ph_hi;
#define IN(k) (lo <= (k) && (k) < hi)
#if MK_ONE_LAUNCH
    XcdBarrier xbar; xbar.bar = (unsigned*)(a.ws + WS_BAR); xbar.st = (volatile LAS unsigned*)(lds + LDS_BAR_OFF); xbar.x = xb_xcc_id();
    { const int lane0 = pg8::get_lane(); if (wave_s == 0 && lane0 < 4) xbar.st[lane0] = 0u; __syncthreads(); if (wave_s == 0 && lane0 == 0) xbar.st[2] = xb_add(&xbar.bar[XB_XCNT(xbar.x)], 1u); }
#define SEAM(k) do { if (IN(k) && IN((k) + 1)) { if ((k) == 0) cg::this_grid().sync(); else { const bool t0_ = (wave_s == 0) && (pg8::get_lane() == 0); xcd_barrier(xbar, t0_, (unsigned)G); } } } while (0)
#else
#define SEAM(k) do { } while (0)
#endif
#if defined(MK_PROBE_PH)
    volatile LAS unsigned long long* stamps = (volatile LAS unsigned long long*)(lds + LDS_BAR_OFF + 64);
#define STAMP(i) do { if (blockIdx.x == 0 && wave_s == 0 && pg8::get_lane() == 0) stamps[(i)] = __builtin_amdgcn_s_memrealtime(); } while (0)
#else
#define STAMP(i) do { } while (0)
#endif
    STAMP(0);
    unsigned char* ws = a.ws;
    bf16_t* XN = (bf16_t*)(ws + WS_XN);
    const bool late_p0 = (G > NB * NHEAD);
    if (IN(0)) { if (late_p0) p0_prologue<0>(a, lds, (int)blockIdx.x, G, wave_s); else p0_prologue<2>(a, lds, (int)blockIdx.x, G, wave_s); } SEAM(0); STAMP(1);
    constexpr int NZ_LATE = 4;
    const int nz_early = late_p0 ? (INTOT / 256 - NZ_LATE) : INTOT / 256;
    if (IN(1)) {
        pg8::Gemm g{XN, (const bf16_t*)(ws + WS_WIN), MP, nz_early * 256, 1024, 1024, 1024}; pg8::StaticOrder S; S.init(MP, nz_early * 256, G, (int)blockIdx.x);
        pg8::EpiZ E{(bf16_t*)(ws + WS_ZC), (bf16_t*)(ws + WS_ZR), (bf16_t*)(ws + WS_ZG), 0};
        pg8::gemm_phase<pg8::EpiZ, pg8::StaticOrder, true, true>(lds, g, S, E, wave_s);
    } SEAM(1); STAMP(2);
#if defined(MK_DUP_PH) && MK_DUP_PH == 2
    if (IN(2)) { p2_conv(a, lds, G, wave_s, false); p2_lorag(a, G, wave_s); __syncthreads(); }
#endif
#if defined(MK_DUP_PH) && MK_DUP_PH == 21
    if (IN(2)) { p2_conv(a, lds, G, wave_s, false); __syncthreads(); }
#endif
    const bool split_tail = (G >= 64) && (G % 8 == 0);
    if (IN(2)) { p2_conv(a, lds, G, wave_s, split_tail);
        if (split_tail && (int)blockIdx.x >= G - NB) { __syncthreads(); p4a_fused<true>(a, lds, G, wave_s, (int)blockIdx.x - (G - NB)); }
        p2_lorag(a, G, wave_s); __syncthreads(); }
#if defined(MK_DUP_PH) && MK_DUP_PH == 43
    if (IN(4)) { p4a_fused<false>(a, lds, G, wave_s, 0); __syncthreads(); }
#endif
    if (IN(4)) { p4a_fused<false>(a, lds, G, wave_s, 0); if (!split_tail) { for (int tb_ = (int)blockIdx.x; tb_ < NB; tb_ += G) { __syncthreads(); p4a_fused<true>(a, lds, G, wave_s, tb_); } } }
#if MK_ONE_LAUNCH
    if (IN(4)) { const bool t0_ = (wave_s == 0) && (pg8::get_lane() == 0); xcd_barrier(xbar, t0_, (unsigned)G); }
#endif
#if defined(MK_DUP_PH) && MK_DUP_PH == 41
    if (IN(4)) { p4b_chain(a, lds, G, wave_s); __syncthreads(); }
#endif
#define G_GEMM(VG, VB) do { pg8::Gemm gg_{(const bf16_t*)(ws + WS_A2), (const bf16_t*)(ws + WS_WSM) + (size_t)1024 * 256 + 128, MP, 512, 128, 128, 256}; pg8::StaticOrder Sg_; Sg_.init(MP, 512, (VG), (VB)); \
        pg8::EpiG Eg_{(bf16_t*)(ws + WS_ZR + 33 * MiB)}; pg8::gemm_phase<pg8::EpiG, pg8::StaticOrder, true, true>(lds, gg_, Sg_, Eg_, wave_s); } while (0)
    if (IN(4)) {
        if (!late_p0) { G_GEMM(G, (int)blockIdx.x); __syncthreads(); }
        if ((int)blockIdx.x < NB * NHEAD || !late_p0) p4b_chain(a, lds, G, wave_s);
        else {
            G_GEMM(G - NB * NHEAD, (int)blockIdx.x - NB * NHEAD); __syncthreads();
            p0_prologue<1>(a, lds, (int)blockIdx.x - NB * NHEAD, G - NB * NHEAD, wave_s);
            __syncthreads();
            pg8::Gemm g{XN, (const bf16_t*)(ws + WS_WIN) + (size_t)nz_early * 256 * 1024, MP, NZ_LATE * 256, 1024, 1024, 1024}; pg8::StaticOrder S; S.init(MP, NZ_LATE * 256, G - NB * NHEAD, (int)blockIdx.x - NB * NHEAD);
            pg8::EpiZ E{(bf16_t*)(ws + WS_ZC), (bf16_t*)(ws + WS_ZR), (bf16_t*)(ws + WS_ZG), nz_early};
            pg8::gemm_phase<pg8::EpiZ, pg8::StaticOrder, true, true>(lds, g, S, E, wave_s);
        }
    }
#if MK_ONE_LAUNCH
    if (IN(4)) { const bool t0_ = (wave_s == 0) && (pg8::get_lane() == 0); xcd_barrier(xbar, t0_, (unsigned)G); }
#endif
#if defined(MK_DUP_PH) && MK_DUP_PH == 42
    if (IN(4)) { p4c_post(a, G, wave_s); __syncthreads(); }
#endif
    if (IN(4)) { p4c_post(a, G, wave_s); } SEAM(4); STAMP(5);
#if defined(MK_DUP_PH) && MK_DUP_PH == 99 && MK_ONE_LAUNCH
    { const bool t0_ = (wave_s == 0) && (pg8::get_lane() == 0); for (int r_ = 0; r_ < 10; ++r_) xcd_barrier(xbar, t0_, (unsigned)G); }
#endif
    for (int rep_ = 0; rep_ < MK_REP5; ++rep_)
    if (IN(5)) {
        bf16_t* Mx = (bf16_t*)(ws + WS_ZR); const bf16_t* Zg = (const bf16_t*)(ws + WS_ZG);
        pg8::Gemm g{(const bf16_t*)(ws + WS_ACL), (const bf16_t*)(ws + WS_WCR), M2, 1024, 1024, 512, 1024, (const bf16_t*)(ws + WS_XN)}; pg8::StaticOrder S; S.init(M2, 1024, G, (int)blockIdx.x);
        pg8::EpiMixF E{Mx, Zg}; pg8::gemm_phase<pg8::EpiMixF, pg8::StaticOrder, true, true>(lds, g, S, E, wave_s);
    } SEAM(5); STAMP(6);
#if defined(MK_DUP_PH) && MK_DUP_PH == 6
    if (IN(6)) {
        pg8::Gemm g{(const bf16_t*)(ws + WS_ZR), (const bf16_t*)(ws + WS_WO), M2, 1024, 1024, 1024, 1024}; pg8::StaticOrder S; S.init(M2, 1024, G, (int)blockIdx.x);
        pg8::EpiH1 E{a.in[0], a.out, (bf16_t*)(ws + WS_ZC), (float*)(ws + WS_CTL + 768 * 1024)};
        pg8::gemm_phase<pg8::EpiH1, pg8::StaticOrder, true, true>(lds, g, S, E, wave_s); __syncthreads();
    }
#endif
    if (IN(6)) {
        pg8::Gemm g{(const bf16_t*)(ws + WS_ZR), (const bf16_t*)(ws + WS_WO), M2, 1024, 1024, 1024, 1024}; pg8::StaticOrder S; S.init(M2, 1024, G, (int)blockIdx.x);
        pg8::EpiH1 E{a.in[0], a.out, (bf16_t*)(ws + WS_ZC), (float*)(ws + WS_SSQ)};
        pg8::gemm_phase<pg8::EpiH1, pg8::StaticOrder, true, true>(lds, g, S, E, wave_s);
    } SEAM(6); STAMP(7);
    for (int rep_ = 0; rep_ < MK_REP7; ++rep_)
    if (IN(7)) {
        pg8::Gemm g{(const bf16_t*)(ws + WS_ZC), (const bf16_t*)(ws + WS_WQ), M2, 2048, 1024, 1024, 1024}; pg8::StaticOrder S; S.init(M2, 2048, G, (int)blockIdx.x);
        pg8::EpiQ E{(bf16_t*)(ws + WS_ZG), (const float*)(ws + WS_SSQ)};
        pg8::gemm_phase<pg8::EpiQ, pg8::StaticOrder, true, true>(lds, g, S, E, wave_s);
    } SEAM(7); STAMP(8);
#if defined(MK_DUP_PH) && MK_DUP_PH == 8
    if (IN(8)) { p9_topk(a, lds, G, wave_s); __syncthreads(); }
#endif
    if (IN(8)) { p9_topk(a, lds, G, wave_s); } SEAM(8); STAMP(9);
    XcdPart xp;
#if MK_ONE_LAUNCH
    xp.nloc = __builtin_amdgcn_readfirstlane(xbar.st[0]); xp.nx = __builtin_amdgcn_readfirstlane(xbar.st[1]); xp.rnk = __builtin_amdgcn_readfirstlane(xbar.st[2]); xp.kx = __builtin_amdgcn_readfirstlane(xbar.st[3]);
    if (xp.nloc == 0u || xp.nx == 0u) { xp.nloc = (unsigned)G; xp.nx = 1u; xp.rnk = blockIdx.x; xp.kx = 0u; }
#else
    xp.nloc = (unsigned)G; xp.nx = 1u; xp.rnk = blockIdx.x; xp.kx = 0u;
#endif
#if defined(MK_DUP_PH) && MK_DUP_PH == 9
    if (IN(9)) { pu_partial(a, lds, wave_s, xp); __syncthreads(); }
#endif
    if (IN(9)) { pu_partial(a, lds, wave_s, xp); } SEAM(9);
    if (IN(10)) { pc_combine(a, G, wave_s); } SEAM(10);
#if defined(MK_DUP_PH) && MK_DUP_PH == 11
    if (IN(11)) { pv_output(a, lds, wave_s, xp); __syncthreads(); }
#endif
    if (IN(11)) { pv_output(a, lds, wave_s, xp); } SEAM(11);
    if (IN(12)) { pf_final(a, G, wave_s); }
#if defined(MK_PROBE_PH)
    STAMP(10);
    if (blockIdx.x == 0 && wave_s == 0 && pg8::get_lane() == 0) { asm volatile("s_waitcnt vmcnt(0) lgkmcnt(0)" ::: "memory"); const float us = (float)(stamps[MK_PROBE_PH + 1] - stamps[MK_PROBE_PH]) * 0.01f; a.out[0] += us; }
#endif
#undef IN
#undef SEAM
}

extern "C" void kernel_launch(void* const* d_in, const int* in_sizes, int n_in, void* d_out, int out_size, void* d_ws, size_t ws_size, hipStream_t stream) {
    static int grid = 0;
    if (grid == 0) {
        if (n_in != 28 || out_size != M2 * D || ws_size < WS_END) { fprintf(stderr, "kernel_launch: unexpected shapes (n_in %d out %d ws %zu)\n", n_in, out_size, ws_size); grid = -1; return; }
        int dev = 0, cus = 0, per_cu = 0;
        if (hipGetDevice(&dev) != hipSuccess || hipDeviceGetAttribute(&cus, hipDeviceAttributeMultiprocessorCount, dev) != hipSuccess) { grid = -1; return; }
        if (hipOccupancyMaxActiveBlocksPerMultiprocessor(&per_cu, (const void*)fwd_kernel, NTHR, 0) != hipSuccess || per_cu < 1) { fprintf(stderr, "kernel_launch: occupancy query says %d blocks per CU\n", per_cu); (void)hipGetLastError(); grid = -1; return; }
        grid = cus;
    }
    if (grid < 0) return;
    (void)hipMemsetAsync((char*)d_ws + WS_CTL, 0, CTL_ZERO_BYTES, stream);
    Args a{};
    for (int i = 0; i < 28; ++i) a.in[i] = (const float*)d_in[i];
    a.out = (float*)d_out; a.ws = (unsigned char*)d_ws;
#if MK_ONE_LAUNCH
    a.ph_lo = 0; a.ph_hi = NPH;
    void* args[] = {&a};
    hipError_t e = hipLaunchCooperativeKernel((const void*)fwd_kernel, dim3(grid), dim3(NTHR), args, 0, stream);
    if (e != hipSuccess) fprintf(stderr, "kernel_launch: cooperative launch failed: %s (grid %d)\n", hipGetErrorString(e), grid);
#else
#ifndef MK_PH_HI
#define MK_PH_HI NPH
#endif
#ifndef MK_PH_LO
#define MK_PH_LO 0
#endif
    for (int ph = MK_PH_LO; ph < MK_PH_HI; ++ph) { a.ph_lo = ph; a.ph_hi = ph + 1; hipLaunchKernelGGL(fwd_kernel, dim3(grid), dim3(NTHR), 0, stream, a); }
#endif
}
```

```cpp
#include <hip/hip_runtime.h>
#include <hip/hip_cooperative_groups.h>
#include <cstdio>
#include <cstdint>
namespace cg = cooperative_groups;

#ifndef MK_ONE_LAUNCH
#define MK_ONE_LAUNCH 1
#endif

#define LAS __attribute__((address_space(3)))
#define LDS_WAIT() asm volatile("s_waitcnt lgkmcnt(0)" ::: "memory")

namespace pg8 {
#define PG8_LAS __attribute__((address_space(3)))
typedef unsigned short bf16_t;
typedef short bf16x8 __attribute__((ext_vector_type(8)));
typedef float f32x4 __attribute__((ext_vector_type(4)));
typedef unsigned u32x4 __attribute__((ext_vector_type(4)));
constexpr int BM = 256, BK = 64, HALF = 128, HTB = HALF * BK * 2  , STAGE_BYTES = 8 * HTB, NXCD = 8, WGM = 8;

__host__ __device__ __forceinline__ int lds_byte(int r, int c) { const int st = (r >> 4) * 2 + (c >> 5), rr = r & 15, cc = c & 31, ob = rr * 64 + cc * 2; return st * 1024 + (ob ^ (((ob >> 9) & 1) << 5)); }
__host__ __device__ __forceinline__ void stage_rc(int b, int& R, int& C) { const int st = b / 1024, sb = b % 1024, swz = sb ^ (((sb >> 9) & 1) << 5); R = (st >> 1) * 16 + swz / 64; C = (st & 1) * 32 + (swz % 64) / 2; }
__host__ __device__ __forceinline__ int perm32(int rho) { const int n = rho >> 4, i = rho & 15; return 8 * (i >> 2) + 4 * n + (i & 3); }

struct Unit { int pm, pn; };
struct Gemm { const bf16_t* A; const bf16_t* Bt; int M, N, K, lda, ldb; const bf16_t* A2 = nullptr; };

struct StaticOrder {
    int nM, nN, nwg, G, c;
    __host__ __device__ void init(int M, int N, int G_, int c_) { nM = M / BM; nN = N / BM; nwg = nM * nN; G = G_; c = c_; }
    __host__ __device__ bool next(int i, Unit& u) const {
        const long L = (long)i * G + c; if (L >= nwg) return false;
        int wgid = (int)L; { const int q = nwg / NXCD, r = nwg % NXCD, xcd = wgid % NXCD, off = wgid / NXCD; wgid = (xcd < r ? xcd * (q + 1) : r * (q + 1) + (xcd - r) * q) + off; }
        const int nig = WGM * nN, gid = wgid / nig, fm = gid * WGM, gsz = (nM - fm) < WGM ? (nM - fm) : WGM;
        u.pm = fm + ((wgid % nig) % gsz); u.pn = (wgid % nig) / gsz; return true;
    }
    __device__ __forceinline__ void a_ready(const Unit&) const {}
    __device__ __forceinline__ void done(const Unit&) const {}
};

typedef float f32x2_cv __attribute__((ext_vector_type(2)));
typedef __bf16 bf16x2_cv __attribute__((ext_vector_type(2)));
__device__ __forceinline__ unsigned cvt_pk_bf16(float lo, float hi) { const f32x2_cv v = {lo, hi}; const bf16x2_cv b = __builtin_convertvector(v, bf16x2_cv); return __builtin_bit_cast(unsigned, b); }
__device__ __forceinline__ void store8(bf16_t* p, const f32x4 v0, const f32x4 v1) {
    u32x4 w; w.x = cvt_pk_bf16(v0[0], v0[1]); w.y = cvt_pk_bf16(v0[2], v0[3]); w.z = cvt_pk_bf16(v1[0], v1[1]); w.w = cvt_pk_bf16(v1[2], v1[3]);
    *(u32x4*)p = w;
}
__device__ __forceinline__ float bflo(unsigned w) { return __builtin_bit_cast(float, w << 16); }
__device__ __forceinline__ float bfhi(unsigned w) { return __builtin_bit_cast(float, w & 0xffff0000u); }
__device__ __forceinline__ void load8(const bf16_t* p, f32x4& v0, f32x4& v1) {
    const u32x4 w = *(const u32x4*)p;
    v0 = (f32x4){bflo(w.x), bfhi(w.x), bflo(w.y), bfhi(w.y)}; v1 = (f32x4){bflo(w.z), bfhi(w.z), bflo(w.w), bfhi(w.w)};
}
__device__ __forceinline__ float sigm(float x) { return __builtin_amdgcn_rcpf(1.f + __expf(-x)); }
__device__ __forceinline__ int get_lane() { unsigned m = 0xffffffffu; asm volatile("" : "+s"(m)); return (int)__builtin_amdgcn_mbcnt_hi(m, __builtin_amdgcn_mbcnt_lo(m, 0u)); }
__device__ __forceinline__ void lane_ids(int& fr, int& fq) { const int lane = get_lane(); fr = lane & 15; fq = lane >> 4; }


struct EpiZ {
    static constexpr bool PERM = true, AFTER_DRAIN = false, HAS_MID = false;
    bf16_t *Zc, *Zr, *Zg; int pn_off;
    __device__ __forceinline__ void operator()(const f32x4 (&acc)[2][2][4][2], const Unit& u, int wr, int wc, int, int) const {
        int fr, fq; lane_ids(fr, fq);
        const int pn = u.pn + pn_off;
        if (pn < 4) {
            const int row0 = u.pm * BM + wr * 64 + fr, col0 = pn * 128 + wc * 32 + 8 * fq;
#pragma unroll
            for (int ai = 0; ai < 2; ++ai)
#pragma unroll
                for (int m = 0; m < 4; ++m) { f32x4 u0, u1;
#pragma unroll
                    for (int j = 0; j < 4; ++j) { u0[j] = acc[ai][0][m][0][j] * sigm(acc[ai][1][m][0][j]); u1[j] = acc[ai][0][m][1][j] * sigm(acc[ai][1][m][1][j]); }
                    store8(Zc + (size_t)(row0 + ai * HALF + m * 16) * 512 + col0, u0, u1); }
        } else if (pn < 11) {
            bf16_t* base = Zr; const int ldc = 1792, colt = (pn - 4) * 256;
            const int row0 = u.pm * BM + wr * 64 + fr, col0 = colt + wc * 32 + 8 * fq;
#pragma unroll
            for (int ai = 0; ai < 2; ++ai)
#pragma unroll
                for (int m = 0; m < 4; ++m) { bf16_t* rowp = base + (size_t)(row0 + ai * HALF + m * 16) * ldc + col0;
#pragma unroll
                    for (int bj = 0; bj < 2; ++bj) store8(rowp + bj * HALF, acc[ai][bj][m][0], acc[ai][bj][m][1]); }
        } else {
            const int row0 = u.pm * BM + wr * 64 + fr, col0 = (pn - 11) * 128 + wc * 32 + 8 * fq;
#pragma unroll
            for (int ai = 0; ai < 2; ++ai)
#pragma unroll
                for (int m = 0; m < 4; ++m) { bf16_t* rowp = Zg + (size_t)(row0 + ai * HALF + m * 16) * 2048 + col0;
                    f32x4 r0, r1, b0, b1;
#pragma unroll
                    for (int j = 0; j < 4; ++j) { const float ea0 = __expf(fminf(-acc[ai][0][m][0][j], 60.f)), ea1 = __expf(fminf(-acc[ai][0][m][1][j], 60.f)), eb0 = __expf(fminf(-acc[ai][1][m][0][j], 60.f)), eb1 = __expf(fminf(-acc[ai][1][m][1][j], 60.f));
                        r0[j] = (1.f + eb0) * __builtin_amdgcn_rcpf(1.f + ea0); r1[j] = (1.f + eb1) * __builtin_amdgcn_rcpf(1.f + ea1);
                        b0[j] = __builtin_amdgcn_rcpf(1.f + eb0); b1[j] = __builtin_amdgcn_rcpf(1.f + eb1); }
                    store8(rowp, r0, r1); store8(rowp + 1024, b0, b1); }
        }
    }
};

template <bool DRY = false> struct EpiSmallT {
    static constexpr bool PERM = true, AFTER_DRAIN = false, HAS_MID = false;
    const float *w0, *a0, *k_a; float* E; bf16_t *Kb, *Bb, *Gb; const bf16_t* KKb;
    __device__ __forceinline__ void operator()(const f32x4 (&acc)[2][2][4][2], const Unit& u, int wr, int wc, int, int) const {
        int fr, fq; lane_ids(fr, fq);
        const int pn = u.pn, kind = pn >> 1;
        const int row0 = u.pm * BM + wr * 64 + fr, col0 = (pn & 1) * 256 + wc * 32 + 8 * fq;
        if (kind == 0) {
            f32x4 p[2][2];
#pragma unroll
            for (int bj = 0; bj < 2; ++bj) { p[bj][0] = *(const f32x4*)(w0 + col0 + bj * HALF); p[bj][1] = *(const f32x4*)(w0 + col0 + bj * HALF + 4); }
#pragma unroll
            for (int ai = 0; ai < 2; ++ai)
#pragma unroll
                for (int m = 0; m < 4; ++m) { const size_t rowoff = (size_t)(row0 + ai * HALF + m * 16) * 512;
#pragma unroll
                    for (int bj = 0; bj < 2; ++bj) { const int c = col0 + bj * HALF; f32x4 v0 = acc[ai][bj][m][0], v1 = acc[ai][bj][m][1];
#pragma unroll
                        for (int j = 0; j < 4; ++j) { v0[j] = 0.60653065971f * sigm(p[bj][0][j] + v0[j]); v1[j] = 0.60653065971f * sigm(p[bj][1][j] + v1[j]); }
                        *(f32x4*)(E + rowoff + c) = v0; *(f32x4*)(E + rowoff + c + 4) = v1; } }
        } else if (kind == 1) {
            f32x4 p[2][2], q[2][2];
#pragma unroll
            for (int bj = 0; bj < 2; ++bj) { const int c = col0 + bj * HALF; p[bj][0] = *(const f32x4*)(a0 + c); p[bj][1] = *(const f32x4*)(a0 + c + 4); q[bj][0] = *(const f32x4*)(k_a + c); q[bj][1] = *(const f32x4*)(k_a + c + 4); }
#pragma unroll
            for (int am = 0; am < 4; ++am) { const int ai = am >> 1;
                u32x4 kw[4][2], kkw[4][2];
#pragma unroll
                for (int m = 2 * (am & 1); m < 2 * (am & 1) + 2; ++m) { const size_t rowoff = (size_t)(row0 + ai * HALF + m * 16) * 512;
#pragma unroll
                    for (int bj = 0; bj < 2; ++bj) { const int c = col0 + bj * HALF; kw[m][bj] = *(const u32x4*)(Kb + rowoff + c); kkw[m][bj] = *(const u32x4*)(KKb + rowoff + c); } }
#pragma unroll
                for (int m = 2 * (am & 1); m < 2 * (am & 1) + 2; ++m) { const size_t rowoff = (size_t)(row0 + ai * HALF + m * 16) * 512;
#pragma unroll
                    for (int bj = 0; bj < 2; ++bj) { const int c = col0 + bj * HALF; const f32x4 v0 = acc[ai][bj][m][0], v1 = acc[ai][bj][m][1];
                        const u32x4 kx = kw[m][bj], kkx = kkw[m][bj];
                        const f32x4 k0 = {bflo(kx.x), bfhi(kx.x), bflo(kx.y), bfhi(kx.y)}, k1 = {bflo(kx.z), bfhi(kx.z), bflo(kx.w), bfhi(kx.w)};
                        const f32x4 kk0 = {bflo(kkx.x), bfhi(kkx.x), bflo(kkx.y), bfhi(kkx.y)}, kk1 = {bflo(kkx.z), bfhi(kkx.z), bflo(kkx.w), bfhi(kkx.w)};
                        f32x4 km0, km1, b0, b1;
#pragma unroll
                        for (int j = 0; j < 4; ++j) { const float a_0 = sigm(p[bj][0][j] + v0[j]), a_1 = sigm(p[bj][1][j] + v1[j]);
                            km0[j] = k0[j] * (1.f + (a_0 - 1.f) * q[bj][0][j]); km1[j] = k1[j] * (1.f + (a_1 - 1.f) * q[bj][1][j]); b0[j] = kk0[j] * a_0; b1[j] = kk1[j] * a_1; }
                        if (!DRY) store8(Kb + rowoff + c, km0, km1); store8(Bb + rowoff + c, b0, b1); } }
            }
        } else {
#pragma unroll
            for (int ai = 0; ai < 2; ++ai)
#pragma unroll
                for (int m = 0; m < 4; ++m) { const size_t rowoff = (size_t)(row0 + ai * HALF + m * 16) * 512;
#pragma unroll
                    for (int bj = 0; bj < 2; ++bj) store8(Gb + rowoff + col0 + bj * HALF, acc[ai][bj][m][0], acc[ai][bj][m][1]); }
        }
    }
};
typedef EpiSmallT<false> EpiSmall;

struct EpiG {
    static constexpr bool PERM = true, AFTER_DRAIN = false, HAS_MID = false;
    bf16_t* Gb;
    __device__ __forceinline__ void operator()(const f32x4 (&acc)[2][2][4][2], const Unit& u, int wr, int wc, int, int) const {
        int fr, fq; lane_ids(fr, fq);
        const int row0 = u.pm * BM + wr * 64 + fr, col0 = u.pn * BM + wc * 32 + 8 * fq;
#pragma unroll
        for (int ai = 0; ai < 2; ++ai)
#pragma unroll
            for (int m = 0; m < 4; ++m) { bf16_t* op = Gb + (size_t)(row0 + ai * HALF + m * 16) * 512 + col0;
#pragma unroll
                for (int bj = 0; bj < 2; ++bj) store8(op + bj * HALF, acc[ai][bj][m][0], acc[ai][bj][m][1]); }
    }
};

__device__ __forceinline__ int mfull_of(int m2) { return m2 + 16 * ((m2 >> 12) + 1); }

template <int MODE> struct EpiMix {
    static constexpr bool PERM = true, AFTER_DRAIN = false, HAS_MID = false;
    bf16_t* Mx; const bf16_t* Zg;
    __device__ __forceinline__ void operator()(const f32x4 (&acc)[2][2][4][2], const Unit& u, int wr, int wc, int, int) const {
        int fr, fq; lane_ids(fr, fq);
        const int row0 = u.pm * BM + wr * 64 + fr, col0 = u.pn * BM + wc * 32 + 8 * fq;
#pragma unroll
        for (int ai = 0; ai < 2; ++ai)
#pragma unroll
            for (int m = 0; m < 4; ++m) { const int row = row0 + ai * HALF + m * 16; const bf16_t* gp = Zg + (size_t)mfull_of(row) * 2048 + MODE * 1024 + col0; bf16_t* op = Mx + (size_t)row * 1024 + col0;
#pragma unroll
                for (int bj = 0; bj < 2; ++bj) { f32x4 g0, g1; load8(gp + bj * HALF, g0, g1); f32x4 v0 = acc[ai][bj][m][0] * g0, v1 = acc[ai][bj][m][1] * g1;
                    if (MODE == 1) { f32x4 o0, o1; load8(op + bj * HALF, o0, o1); v0 += o0; v1 += o1; }
                    store8(op + bj * HALF, v0, v1); } }
    }
};

struct EpiMixF {
    static constexpr bool PERM = true, AFTER_DRAIN = false, HAS_MID = true;
    bf16_t* Mx; const bf16_t* Zg;
    __device__ __forceinline__ void mid(f32x4 (&acc)[2][2][4][2], const Unit& u, int wr, int wc) const {
        int fr, fq; lane_ids(fr, fq);
        const int row0 = u.pm * BM + wr * 64 + fr, col0 = u.pn * BM + wc * 32 + 8 * fq;
        u32x4 rw[2][4][2];
#pragma unroll
        for (int ai = 0; ai < 2; ++ai)
#pragma unroll
            for (int m = 0; m < 4; ++m) { const bf16_t* gp = Zg + (size_t)mfull_of(row0 + ai * HALF + m * 16) * 2048 + col0;
#pragma unroll
                for (int bj = 0; bj < 2; ++bj) rw[ai][m][bj] = *(const u32x4*)(gp + bj * HALF); }
#pragma unroll
        for (int ai = 0; ai < 2; ++ai)
#pragma unroll
            for (int m = 0; m < 4; ++m)
#pragma unroll
                for (int bj = 0; bj < 2; ++bj) { const u32x4 w = rw[ai][m][bj];
                    acc[ai][bj][m][0] *= (f32x4){bflo(w.x), bfhi(w.x), bflo(w.y), bfhi(w.y)}; acc[ai][bj][m][1] *= (f32x4){bflo(w.z), bfhi(w.z), bflo(w.w), bfhi(w.w)}; }
    }
    __device__ __forceinline__ void operator()(const f32x4 (&acc)[2][2][4][2], const Unit& u, int wr, int wc, int, int) const {
        int fr, fq; lane_ids(fr, fq);
        const int row0 = u.pm * BM + wr * 64 + fr, col0 = u.pn * BM + wc * 32 + 8 * fq;
        u32x4 gw[2][4][2];
#pragma unroll
        for (int ai = 0; ai < 2; ++ai)
#pragma unroll
            for (int m = 0; m < 4; ++m) { const int row = row0 + ai * HALF + m * 16; const bf16_t* gp = Zg + (size_t)mfull_of(row) * 2048 + 1024 + col0;
#pragma unroll
                for (int bj = 0; bj < 2; ++bj) gw[ai][m][bj] = *(const u32x4*)(gp + bj * HALF); }
#pragma unroll
        for (int ai = 0; ai < 2; ++ai)
#pragma unroll
            for (int m = 0; m < 4; ++m) { const int row = row0 + ai * HALF + m * 16; bf16_t* op = Mx + (size_t)row * 1024 + col0;
#pragma unroll
                for (int bj = 0; bj < 2; ++bj) { const u32x4 w = gw[ai][m][bj]; const f32x4 g0 = {bflo(w.x), bfhi(w.x), bflo(w.y), bfhi(w.y)}, g1 = {bflo(w.z), bfhi(w.z), bflo(w.w), bfhi(w.w)};
                    store8(op + bj * HALF, acc[ai][bj][m][0] * g0, acc[ai][bj][m][1] * g1); } }
    }
};

struct EpiH1 {
    static constexpr bool PERM = true, AFTER_DRAIN = false, HAS_MID = false;
    const float* X; float* H1; bf16_t* H1b; float* ssq;
    __device__ __forceinline__ void operator()(const f32x4 (&acc)[2][2][4][2], const Unit& u, int wr, int wc, int, int) const {
        int fr, fq; lane_ids(fr, fq);
        const int row0 = u.pm * BM + wr * 64 + fr, col0 = u.pn * BM + wc * 32 + 8 * fq;
#pragma unroll
        for (int ai = 0; ai < 2; ++ai)
        {   f32x4 xv[4][2][2];
#pragma unroll
            for (int m = 0; m < 4; ++m) { const size_t off = (size_t)(row0 + ai * HALF + m * 16) * 1024 + col0;
#pragma unroll
                for (int bj = 0; bj < 2; ++bj) { xv[m][bj][0] = *(const f32x4*)(X + off + bj * HALF); xv[m][bj][1] = *(const f32x4*)(X + off + bj * HALF + 4); } }
#pragma unroll
            for (int m = 0; m < 4; ++m) { const int row = row0 + ai * HALF + m * 16; const size_t off = (size_t)row * 1024 + col0; float s = 0.f;
#pragma unroll
                for (int bj = 0; bj < 2; ++bj) {
                    const f32x4 v0 = acc[ai][bj][m][0] + xv[m][bj][0], v1 = acc[ai][bj][m][1] + xv[m][bj][1];
                    store8(H1b + off + bj * HALF, v0, v1);
                    s += (v0[0] * v0[0] + v0[1] * v0[1]) + (v0[2] * v0[2] + v0[3] * v0[3]) + (v1[0] * v1[0] + v1[1] * v1[1]) + (v1[2] * v1[2] + v1[3] * v1[3]); }
                s += __shfl_xor(s, 16); s += __shfl_xor(s, 32);
                if (fq == 0) atomicAdd(ssq + row, s); }
        }
    }
};

struct EpiQ {
    static constexpr bool PERM = true, AFTER_DRAIN = false, HAS_MID = false;
    bf16_t* Q; const float* ssq;
    __device__ __forceinline__ void operator()(const f32x4 (&acc)[2][2][4][2], const Unit& u, int wr, int wc, int, int) const {
        int fr, fq; lane_ids(fr, fq);
        const int row0 = u.pm * BM + wr * 64 + fr, col0 = u.pn * BM + wc * 32 + 8 * fq;
        float sq[2][4];
#pragma unroll
        for (int ai = 0; ai < 2; ++ai)
#pragma unroll
            for (int m = 0; m < 4; ++m) sq[ai][m] = ssq[row0 + ai * HALF + m * 16];
#pragma unroll
        for (int ai = 0; ai < 2; ++ai)
#pragma unroll
            for (int m = 0; m < 4; ++m) { const int row = row0 + ai * HALF + m * 16; const float rs = __builtin_amdgcn_rsqf(sq[ai][m] * (1.f / 1024.f) + 1e-6f); bf16_t* op = Q + (size_t)row * 2048 + col0;
#pragma unroll
                for (int bj = 0; bj < 2; ++bj) store8(op + bj * HALF, acc[ai][bj][m][0] * rs, acc[ai][bj][m][1] * rs); }
    }
};

template <class Epi, class Sched, bool ALIGN_EPI = false, bool SP2 = false>
__device__ __forceinline__ void gemm_phase(PG8_LAS unsigned char* lds, const Gemm g, const Sched& S, const Epi& E, const int wave_s) {
    const int wid = wave_s, lane = get_lane(), tid = wid * 64 + lane, wr = wid >> 2, wc = wid & 3, fr = lane & 15, fq = lane >> 4;
    const int K = g.K, nt = K / BK;
    unsigned voffA[2], voffB[2];
#pragma unroll
    for (int i = 0; i < 2; ++i) { int R, C; stage_rc(tid * 16 + i * 8192, R, C); const int Rb = Epi::PERM ? ((R & ~31) + perm32(R & 31)) : R;
        voffA[i] = (unsigned)(R * g.lda + C) * 2u; voffB[i] = (unsigned)(Rb * g.ldb + C) * 2u; }
    const size_t kstep = (size_t)(BK * 2);
    const size_t hstepA = (size_t)HALF * g.lda * 2, hstepB = (size_t)HALF * g.ldb * 2;
    const size_t tstepA = 2 * hstepA, tstepB = 2 * hstepB;
    const unsigned ldsw = (unsigned)wid * 1024u;
    const int aoff = lds_byte(wr * 64 + fr, fq * 8), boff = lds_byte(wc * 32 + fr, fq * 8);
#define PG8_SA(b, h) (((b) * 2 + (h)) * HTB)
#define PG8_SB(b, h) ((4 + (b) * 2 + (h)) * HTB)
#define PG8_STAGE(bufoff, gbase, voff) do { _Pragma("unroll") for (int _i = 0; _i < 2; ++_i) \
        __builtin_amdgcn_global_load_lds((const unsigned*)((const char*)(gbase) + (voff)[_i]), (PG8_LAS unsigned*)(lds + (bufoff) + ldsw + _i * 8192), 16, 0, 0); } while (0)
#define PG8_LDA(dst, b, h) do { unsigned _ab = (unsigned)(PG8_SA(b, h) + aoff); asm volatile("" : "+v"(_ab)); _Pragma("unroll") for (int m = 0; m < 4; ++m) _Pragma("unroll") for (int k = 0; k < 2; ++k) dst[m][k] = *(const PG8_LAS bf16x8*)(lds + _ab + m * 2048 + k * 1024); } while (0)
#define PG8_LDB(dst, b, h) do { unsigned _bb = (unsigned)(PG8_SB(b, h) + boff); asm volatile("" : "+v"(_bb)); _Pragma("unroll") for (int n = 0; n < 2; ++n) _Pragma("unroll") for (int k = 0; k < 2; ++k) dst[n][k] = *(const PG8_LAS bf16x8*)(lds + _bb + n * 2048 + k * 1024); } while (0)
#define PG8_MMA(ai, bj, At, Bt) do { __builtin_amdgcn_s_setprio(1); _Pragma("unroll") for (int m = 0; m < 4; ++m) _Pragma("unroll") for (int n = 0; n < 2; ++n) _Pragma("unroll") for (int k = 0; k < 2; ++k) \
        acc[ai][bj][m][n] = __builtin_amdgcn_mfma_f32_16x16x32_bf16(Bt[n][k], At[m][k], acc[ai][bj][m][n], 0, 0, 0); __builtin_amdgcn_s_setprio(0); } while (0)
#define PG8_WAIT_V(n) asm volatile("s_waitcnt vmcnt(" #n ")" ::: "memory")
#define PG8_WAIT_L(n) asm volatile("s_waitcnt lgkmcnt(" #n ")" ::: "memory")
#define PG8_BAR __builtin_amdgcn_s_barrier()
#define PG8_SCHED __builtin_amdgcn_sched_barrier(0)
    Unit cur, nxt; int ui = 0;
    if (!S.next(0, cur)) return;
    f32x4 acc[2][2][4][2];
#pragma unroll
    for (int a = 0; a < 2; ++a)
#pragma unroll
        for (int b = 0; b < 2; ++b)
#pragma unroll
            for (int m = 0; m < 4; ++m)
#pragma unroll
                for (int n = 0; n < 2; ++n) acc[a][b][m][n] = (f32x4){0.f, 0.f, 0.f, 0.f};
    bf16x8 At[4][2], B0[2][2], B1[2][2];
    const char* cA = (const char*)g.A + (size_t)cur.pm * tstepA; const char* cB = (const char*)g.Bt + (size_t)cur.pn * tstepB;
    S.a_ready(cur);
    if constexpr (SP2) {
        PG8_STAGE(PG8_SB(0, 0), cB, voffB); PG8_STAGE(PG8_SB(0, 1), cB + hstepB, voffB); PG8_STAGE(PG8_SA(0, 0), cA, voffA); PG8_STAGE(PG8_SA(0, 1), cA + hstepA, voffA);
        if (wr == 1) PG8_BAR;
        PG8_WAIT_V(2); PG8_BAR;
        PG8_STAGE(PG8_SB(1, 0), cB + kstep, voffB); PG8_STAGE(PG8_SA(1, 0), cA + kstep, voffA); PG8_STAGE(PG8_SB(1, 1), cB + hstepB + kstep, voffB);
        PG8_WAIT_V(6); PG8_BAR;
    } else {
        PG8_STAGE(PG8_SB(0, 0), cB, voffB); PG8_STAGE(PG8_SA(0, 0), cA, voffA); PG8_STAGE(PG8_SB(0, 1), cB + hstepB, voffB); PG8_STAGE(PG8_SA(0, 1), cA + hstepA, voffA);
        if (wr == 1) PG8_BAR;
        PG8_WAIT_V(4); PG8_BAR;
        PG8_STAGE(PG8_SB(1, 0), cB + kstep, voffB); PG8_STAGE(PG8_SA(1, 0), cA + kstep, voffA); PG8_STAGE(PG8_SB(1, 1), cB + hstepB + kstep, voffB);
        PG8_WAIT_V(6); PG8_BAR;
    }
    for (;;) {
        const bool has_next = S.next(ui + 1, nxt);
        const char* nA = has_next ? (const char*)g.A + (size_t)nxt.pm * tstepA : cA; const char* nB = has_next ? (const char*)g.Bt + (size_t)nxt.pn * tstepB : cB;
        for (int t = 0; t < nt; t += 2) {
            const bool last = (t == nt - 2);
            const char* cA2 = g.A2 ? (const char*)g.A2 + (cA - (const char*)g.A) - (size_t)(nt / 2) * kstep : cA;
            const int nh = g.A2 ? nt / 2 : nt;
            const char* a1 = ((t + 1 < nh) ? cA : cA2) + (size_t)(t + 1) * kstep;
            const char* a2 = last ? nA : ((t + 2 < nh) ? cA : cA2) + (size_t)(t + 2) * kstep; const char* b2 = last ? nB : cB + (size_t)(t + 2) * kstep;
            const char* a3 = a2 + kstep; const char* b3 = b2 + kstep;
            if (last && has_next) S.a_ready(nxt);
            if constexpr (Epi::HAS_MID) { if (t == nt / 2) E.mid(acc, cur, wr, wc); }
            if constexpr (SP2) {
            PG8_LDB(B0, 0, 0); PG8_LDB(B1, 0, 1); PG8_SCHED; PG8_LDA(At, 0, 0); PG8_STAGE(PG8_SA(1, 1), a1 + hstepA, voffA);
            PG8_WAIT_V(8); PG8_WAIT_L(0); PG8_BAR; PG8_MMA(0, 0, At, B0); PG8_MMA(0, 1, At, B1); PG8_BAR; PG8_SCHED;
            PG8_LDA(At, 0, 1); PG8_STAGE(PG8_SB(0, 0), b2, voffB); PG8_STAGE(PG8_SB(0, 1), b2 + hstepB, voffB); PG8_STAGE(PG8_SA(0, 0), a2, voffA);
            PG8_WAIT_V(8); PG8_WAIT_L(0); PG8_BAR; PG8_MMA(1, 0, At, B0); PG8_MMA(1, 1, At, B1); PG8_BAR; PG8_SCHED;
            PG8_LDB(B0, 1, 0); PG8_LDB(B1, 1, 1); PG8_SCHED; PG8_LDA(At, 1, 0); PG8_STAGE(PG8_SA(0, 1), a2 + hstepA, voffA);
            PG8_WAIT_V(8); PG8_WAIT_L(0); PG8_BAR; PG8_MMA(0, 0, At, B0); PG8_MMA(0, 1, At, B1); PG8_BAR; PG8_SCHED;
            PG8_LDA(At, 1, 1); PG8_STAGE(PG8_SB(1, 0), b3, voffB); PG8_STAGE(PG8_SB(1, 1), b3 + hstepB, voffB); PG8_STAGE(PG8_SA(1, 0), a3, voffA);
            PG8_WAIT_V(8); PG8_WAIT_L(0); PG8_BAR; PG8_MMA(1, 0, At, B0); PG8_MMA(1, 1, At, B1); PG8_BAR; PG8_SCHED;
            } else {
            PG8_LDB(B0, 0, 0); PG8_SCHED; PG8_LDA(At, 0, 0); PG8_STAGE(PG8_SA(1, 1), a1 + hstepA, voffA);
            PG8_WAIT_L(8); PG8_BAR; PG8_WAIT_L(0); PG8_MMA(0, 0, At, B0); PG8_BAR; PG8_SCHED;
            PG8_LDB(B1, 0, 1); PG8_STAGE(PG8_SB(0, 0), b2, voffB);
            PG8_BAR; PG8_WAIT_L(0); PG8_MMA(0, 1, At, B1); PG8_BAR;
            PG8_LDA(At, 0, 1); PG8_STAGE(PG8_SA(0, 0), a2, voffA);
            PG8_BAR; PG8_WAIT_L(0); PG8_MMA(1, 0, At, B0); PG8_BAR; PG8_SCHED;
            PG8_STAGE(PG8_SB(0, 1), b2 + hstepB, voffB);
            PG8_WAIT_V(6); PG8_BAR; PG8_MMA(1, 1, At, B1); PG8_BAR;
            PG8_LDB(B0, 1, 0); PG8_SCHED; PG8_LDA(At, 1, 0); PG8_STAGE(PG8_SA(0, 1), a2 + hstepA, voffA);
            PG8_WAIT_L(8); PG8_BAR; PG8_WAIT_L(0); PG8_MMA(0, 0, At, B0); PG8_BAR; PG8_SCHED;
            PG8_LDB(B1, 1, 1); PG8_STAGE(PG8_SB(1, 0), b3, voffB);
            PG8_BAR; PG8_WAIT_L(0); PG8_MMA(0, 1, At, B1); PG8_BAR;
            PG8_LDA(At, 1, 1); PG8_STAGE(PG8_SA(1, 0), a3, voffA);
            PG8_BAR; PG8_WAIT_L(0); PG8_MMA(1, 0, At, B0); PG8_BAR; PG8_SCHED;
            PG8_STAGE(PG8_SB(1, 1), b3 + hstepB, voffB);
            PG8_WAIT_V(6); PG8_BAR; PG8_MMA(1, 1, At, B1); PG8_BAR;
            }
        }
        if constexpr (ALIGN_EPI) { if (wr == 0) PG8_BAR; }
        if constexpr (!Epi::AFTER_DRAIN) { E(acc, cur, wr, wc, fr, fq); S.done(cur); }
        if (!has_next) break;
#pragma unroll
        for (int a = 0; a < 2; ++a)
#pragma unroll
            for (int b = 0; b < 2; ++b)
#pragma unroll
                for (int m = 0; m < 4; ++m)
#pragma unroll
                    for (int n = 0; n < 2; ++n) acc[a][b][m][n] = (f32x4){0.f, 0.f, 0.f, 0.f};
        cur = nxt; cA = nA; cB = nB; ++ui;
        if constexpr (ALIGN_EPI) { if (wr == 1) PG8_BAR; }
    }
    PG8_WAIT_V(0);
    if constexpr (!ALIGN_EPI) { if (wr == 0) PG8_BAR; }
    PG8_BAR;
    if constexpr (Epi::AFTER_DRAIN) { E.fused(acc, cur, wr, wc, fr, fq, lds, wid, lane); S.done(cur); }
#undef PG8_SA
#undef PG8_SB
#undef PG8_STAGE
#undef PG8_LDA
#undef PG8_LDB
#undef PG8_MMA
#undef PG8_WAIT_V
#undef PG8_WAIT_L
#undef PG8_BAR
#undef PG8_SCHED
}
}

typedef pg8::bf16_t bf16_t;
typedef pg8::f32x4 f32x4;
typedef pg8::u32x4 u32x4;
typedef pg8::bf16x8 bf16x8;
typedef unsigned u32x2 __attribute__((ext_vector_type(2)));
using pg8::bflo; using pg8::bfhi; using pg8::cvt_pk_bf16; using pg8::sigm; using pg8::load8; using pg8::store8;

constexpr int D = 1024, NB = 8, SEQ = 4096, NMETA = 16, T = SEQ + NMETA  , MT = NB * T  , MP = 33024  , M2 = NB * SEQ  ;
constexpr int INTOT = 4864, CCH = 512, RWW = 512, RWIN = 1792, NHEAD = 8;
constexpr int PH = 8, PK = 128, PDH = 128, PTOPK = 16, NEXP = 16384;
constexpr int NWAVES = 8, NTHR = 512;
constexpr int LDS_BYTES = 147456;

constexpr size_t MiB = 1u << 20;
constexpr size_t WS_CTL = 0, CTL_ZERO_BYTES = 1 * MiB;
constexpr size_t WS_SSQ = 256 * 1024;
constexpr size_t WS_SSQ2 = 512 * 1024;
constexpr size_t WS_WIN = 1 * MiB;
constexpr size_t WS_WCR = 11 * MiB;
constexpr size_t WS_WO = 13 * MiB;
constexpr size_t WS_WQ = 15 * MiB;
constexpr size_t WS_SK = 19 * MiB;
constexpr size_t WS_WSM = 19 * MiB + 512 * 1024;
constexpr size_t WS_EU = 20 * MiB + 256 * 1024, WS_EV = WS_EU + 16 * MiB + 256 * 1024;
constexpr size_t WS_ACL = 53 * MiB;
constexpr size_t WS_EU_OLD_ = 0, WS_EV_OLD_ = 0;
constexpr size_t WS_XN = 85 * MiB;
constexpr size_t WS_ZG = 150 * MiB;
constexpr size_t WS_ZR = 279 * MiB;
constexpr size_t WS_ZC = 392 * MiB;
constexpr size_t WS_KK = 457 * MiB;
constexpr size_t WS_A2 = 490 * MiB;
constexpr size_t WS_RK = 507 * MiB + 256 * 1024;
constexpr size_t WS_EM = WS_ZC + 32 * MiB + 512 * 1024;
constexpr size_t WS_WC = WS_A2 + 13 * MiB + 64 * 1024;
constexpr size_t WS_ORAW = 345 * MiB;
constexpr size_t WS_END = 509 * MiB;

struct Args { const float* in[28]; float* out; unsigned char* ws; int ph_lo, ph_hi; };

__device__ __forceinline__ float dpp_f(float x, const int ctrl_sel) { return x; }
#define DPP_ADD(x, ctrl) ((x) + __builtin_bit_cast(float, __builtin_amdgcn_update_dpp(0, __builtin_bit_cast(int, (x)), (ctrl), 0xf, 0xf, true)))
__device__ __forceinline__ float red8(float x) {
    x = DPP_ADD(x, 0xB1); x = DPP_ADD(x, 0x4E); x = DPP_ADD(x, 0x141); return x;
}
__device__ __forceinline__ float red16(float x) { x = red8(x); x = DPP_ADD(x, 0x140); return x; }
__device__ __forceinline__ float wave_sum(float x) {
    x = red16(x);
    const int xi = __builtin_bit_cast(int, x);
    const float a = __builtin_bit_cast(float, __builtin_amdgcn_readlane(xi, 0)), b = __builtin_bit_cast(float, __builtin_amdgcn_readlane(xi, 16)), c = __builtin_bit_cast(float, __builtin_amdgcn_readlane(xi, 32)), d = __builtin_bit_cast(float, __builtin_amdgcn_readlane(xi, 48));
    return (a + b) + (c + d);
}

template <bool GATEP = false>
__device__ __forceinline__ void p0_transpose_item(const float* W, int ldw, bf16_t* WT, int ldt, int koff, const float* kscale, int nblk, LAS float* scr, int item, int lane) {
    const int kb = item / nblk, nb = item % nblk, k0 = 64 * kb, n0 = 32 * nb;
    int no0 = n0; if (GATEP && n0 < 1024) { const int jb = n0 >= 512 ? 1 : 0, jc = n0 - 512 * jb; no0 = 256 * (jc >> 7) + 128 * jb + (jc & 127); }
    if (GATEP && n0 >= 2816) { const int j = n0 - 2816, jb = j >= 1024 ? 1 : 0, jc = j - 1024 * jb; no0 = 2816 + 256 * (jc >> 7) + 128 * jb + (jc & 127); }
#pragma unroll 8
    for (int i = 0; i < 32; ++i) { const int kk = 2 * i + (lane >> 5); float w = W[(size_t)(k0 + kk) * ldw + n0 + (lane & 31)]; if (kscale) w *= kscale[k0 + kk]; scr[kk * 33 + (lane & 31)] = w; }
    LDS_WAIT(); asm volatile("" ::: "memory");
    const int c = lane & 7;
#pragma unroll
    for (int j = 0; j < 4; ++j) { const int n = (lane >> 3) + 8 * j; const LAS float* s = scr + (8 * c) * 33 + n;
        u32x4 o; o.x = cvt_pk_bf16(s[0 * 33], s[1 * 33]); o.y = cvt_pk_bf16(s[2 * 33], s[3 * 33]); o.z = cvt_pk_bf16(s[4 * 33], s[5 * 33]); o.w = cvt_pk_bf16(s[6 * 33], s[7 * 33]);
        *(u32x4*)(WT + (size_t)(no0 + n) * ldt + koff + k0 + 8 * c) = o; }
    LDS_WAIT(); asm volatile("" ::: "memory");
}

template <int PART> __device__ __forceinline__ void p0_prologue(const Args& a, LAS unsigned char* lds, const int vb, const int VG, const int wave) {
    const int lane = pg8::get_lane(), tid = wave * 64 + lane;
    unsigned char* ws = a.ws;
    LAS float* scr = (LAS float*)(lds + wave * 16384);
    const int gw = vb * NWAVES + wave, NGW = VG * NWAVES;
    const int gt = vb * NTHR + tid, NGT = VG * NTHR;
    constexpr int I_IN = (1024 / 64) * (INTOT / 32), I_C = (512 / 64) * (1024 / 32), I_O = (1024 / 64) * (1024 / 32), I_Q = (1024 / 64) * (2048 / 32);
    constexpr int NITEMS = I_IN + 2 * I_C + I_O + I_Q;
    for (int it = gw; it < NITEMS; it += NGW) {
        int r = it;
        if ((r < I_IN) != (PART != 1) && PART != 2) continue;
        if (r < I_IN) { p0_transpose_item<true>(a.in[3], INTOT, (bf16_t*)(ws + WS_WIN), 1024, 0, nullptr, INTOT / 32, scr, r, lane); continue; } r -= I_IN;
        if (r < I_C) { p0_transpose_item(a.in[8], 1024, (bf16_t*)(ws + WS_WCR), 1024, 0, nullptr, 32, scr, r, lane); continue; } r -= I_C;
        if (r < I_C) { p0_transpose_item(a.in[20], 1024, (bf16_t*)(ws + WS_WCR), 1024, 512, nullptr, 32, scr, r, lane); continue; } r -= I_C;
        if (r < I_O) { p0_transpose_item(a.in[21], 1024, (bf16_t*)(ws + WS_WO), 1024, 0, nullptr, 32, scr, r, lane); continue; } r -= I_O;
        p0_transpose_item(a.in[23], 2048, (bf16_t*)(ws + WS_WQ), 1024, 0, a.in[22], 64, scr, r, lane);
    }
    if (PART != 0) { const float* sk = a.in[24]; bf16_t* o = (bf16_t*)(ws + WS_SK);
      for (int i = gt; i < 16 * 128 * 128 / 8; i += NGT) { const f32x4 x0 = *(const f32x4*)(sk + (size_t)i * 8), x1 = *(const f32x4*)(sk + (size_t)i * 8 + 4); store8(o + (size_t)i * 8, x0, x1); } }
    if (PART != 1) { const float* w_up = a.in[11]; const float* a_up = a.in[13]; const float* g_up = a.in[14]; bf16_t* o = (bf16_t*)(ws + WS_WSM);
      for (int i = gt; i < 1536 * 32; i += NGT) { const int n = i >> 5, k8 = (i & 31) * 8; float v[8];
#pragma unroll
          for (int j = 0; j < 8; ++j) { const int k = k8 + j; float x = 0.f;
              if (n < 512) { if (k < 64) x = w_up[k * 512 + n]; }
              else if (n < 1024) { if (k >= 64 && k < 128) x = a_up[(k - 64) * 512 + (n - 512)]; }
              else { if (k >= 128) x = g_up[(k - 128) * 512 + (n - 1024)]; }
              v[j] = x; }
          store8(o + (size_t)n * 256 + k8, (f32x4){v[0], v[1], v[2], v[3]}, (f32x4){v[4], v[5], v[6], v[7]}); } }
    if (PART != 0) { const float* gf = a.in[22]; unsigned char* t8[2] = {ws + WS_EU, ws + WS_EV};
      for (int it = gw; it < 2 * NEXP; it += NGW) {
          const int tb = it >= NEXP ? 1 : 0, e = it - tb * NEXP;
          const float* src = (tb ? a.in[26] : a.in[25]) + (size_t)e * 1024 + 16 * lane;
          f32x4 v[4]; float mx = 0.f;
#pragma unroll
          for (int j = 0; j < 4; ++j) { v[j] = *(const f32x4*)(src + 4 * j); if (!tb) v[j] = v[j] * *(const f32x4*)(gf + 16 * lane + 4 * j);
              mx = fmaxf(mx, fmaxf(fmaxf(fabsf(v[j][0]), fabsf(v[j][1])), fmaxf(fabsf(v[j][2]), fabsf(v[j][3])))); }
#pragma unroll
          for (int o = 1; o < 64; o <<= 1) mx = fmaxf(mx, __shfl_xor(mx, o));
          mx = fmaxf(mx, 1e-30f);
          const float sc = 384.f / mx;
          u32x4 w; int p;
          p = 0; p = __builtin_amdgcn_cvt_pk_fp8_f32(v[0][0] * sc, v[0][1] * sc, p, false); p = __builtin_amdgcn_cvt_pk_fp8_f32(v[0][2] * sc, v[0][3] * sc, p, true); w.x = (unsigned)p;
          p = 0; p = __builtin_amdgcn_cvt_pk_fp8_f32(v[1][0] * sc, v[1][1] * sc, p, false); p = __builtin_amdgcn_cvt_pk_fp8_f32(v[1][2] * sc, v[1][3] * sc, p, true); w.y = (unsigned)p;
          p = 0; p = __builtin_amdgcn_cvt_pk_fp8_f32(v[2][0] * sc, v[2][1] * sc, p, false); p = __builtin_amdgcn_cvt_pk_fp8_f32(v[2][2] * sc, v[2][3] * sc, p, true); w.z = (unsigned)p;
          p = 0; p = __builtin_amdgcn_cvt_pk_fp8_f32(v[3][0] * sc, v[3][1] * sc, p, false); p = __builtin_amdgcn_cvt_pk_fp8_f32(v[3][2] * sc, v[3][3] * sc, p, true); w.w = (unsigned)p;
          unsigned char* tab = tb ? (ws + WS_EV) : (ws + WS_EU);
          *(u32x4*)(tab + (size_t)e * 1024 + 16 * lane) = w;
          if (lane == 0) ((float*)(tab + 16 * MiB))[e] = mx * (1.f / 384.f);
      } }
    if (PART != 1) { const float* x = a.in[0]; const float* meta = a.in[1]; const float* gm = a.in[2]; bf16_t* XN = (bf16_t*)(ws + WS_XN);
      f32x4 nv[4];
#define XN_LOAD(mm) do { if ((mm) < MT) { const int b_ = (mm) / T, t_ = (mm) - b_ * T; const float* src_ = (t_ < NMETA) ? meta + (size_t)t_ * 1024 : x + ((size_t)b_ * SEQ + (t_ - NMETA)) * 1024; \
          _Pragma("unroll") for (int j = 0; j < 4; ++j) nv[j] = ((const f32x4*)src_)[lane + 64 * j]; } } while (0)
      if (gw < MP) XN_LOAD(gw);
      for (int m = gw; m < MP; m += NGW) {
          bf16_t* o = XN + (size_t)m * 1024;
          f32x4 v[4];
#pragma unroll
          for (int j = 0; j < 4; ++j) v[j] = nv[j];
          if (m + NGW < MP) XN_LOAD(m + NGW);
          if (m >= MT) { const u32x4 z = {0u, 0u, 0u, 0u}; ((u32x4*)o)[lane] = z; ((u32x4*)o)[lane + 64] = z; continue; }
          float s = 0.f;
#pragma unroll
          for (int j = 0; j < 4; ++j) s += (v[j][0] * v[j][0] + v[j][1] * v[j][1]) + (v[j][2] * v[j][2] + v[j][3] * v[j][3]);
          const float rs = 1.f / sqrtf(wave_sum(s) * (1.f / 1024.f) + 1e-6f);
#pragma unroll
          for (int j = 0; j < 4; ++j) { const f32x4 g = ((const f32x4*)gm)[lane + 64 * j]; const f32x4 y = v[j] * rs * g;
              u32x2 w; w.x = cvt_pk_bf16(y[0], y[1]); w.y = cvt_pk_bf16(y[2], y[3]); ((u32x2*)o)[lane + 64 * j] = w; }
      }
#undef XN_LOAD
    }
}

typedef float f32x2v __attribute__((ext_vector_type(2)));
__device__ __forceinline__ void p2_conv(const Args& a, LAS unsigned char* lds, int G, const int wave, const bool split) {
    const int lane = pg8::get_lane(), tid = wave * 64 + lane;
    const bf16_t* Zc = (const bf16_t*)(a.ws + WS_ZC); bf16_t* ACL = (bf16_t*)(a.ws + WS_ACL);
    const float* conv_w = a.in[4]; const float* conv_b = a.in[5]; const float* ln_g = a.in[6]; const float* ln_b = a.in[7];
    constexpr int CT = 66, HT = 33, NR = CT + 30, TPB = (T + CT - 1) / CT;
    LAS unsigned char* ul = lds;
    LAS unsigned* yl = (LAS unsigned*)lds;
    const int cp = tid & 255, tg = tid >> 8;
    f32x2v w[31];
#pragma unroll
    for (int j = 0; j < 31; ++j) w[j] = *(const f32x2v*)(conv_w + j * 512 + 2 * cp);
    const f32x2v bias = *(const f32x2v*)(conv_b + 2 * cp);
    const bool tailwg = split && (int)blockIdx.x >= G - NB;
    const int it_first = split ? (tailwg ? 0 : (int)blockIdx.x) : (int)blockIdx.x, it_step = split ? (G - NB) : G, it_end = split ? (tailwg ? 1 : NB * (TPB - 1)) : NB * TPB;
    for (int it = it_first; it < it_end; it += it_step) {
        const int b = split ? (tailwg ? (int)blockIdx.x - (G - NB) : it / (TPB - 1)) : it / TPB;
        const int t0 = (split ? (tailwg ? TPB - 1 : it - b * (TPB - 1)) : it - b * TPB) * CT;
        u32x4 vv[12];
#pragma unroll
        for (int k = 0; k < 12; ++k) { const int r = (tid >> 6) + 8 * k, ti = t0 - 30 + r; vv[k] = (u32x4){0u, 0u, 0u, 0u};
            if (ti >= 0 && ti < T) vv[k] = *(const u32x4*)(Zc + (size_t)(b * T + ti) * 512 + 8 * lane); }
#pragma unroll
        for (int k = 0; k < 12; ++k) { const int r = (tid >> 6) + 8 * k; *(LAS u32x4*)(ul + r * 1024 + lane * 16) = vv[k]; }
        __syncthreads();
        f32x2v u[HT + 30];
#pragma unroll
        for (int s = 0; s < HT + 30; ++s) { const unsigned uw = *(const LAS unsigned*)(ul + (tg * HT + s) * 1024 + cp * 4); u[s] = (f32x2v){bflo(uw), bfhi(uw)}; }
        unsigned yv[HT];
#pragma unroll
        for (int o = 0; o < HT; ++o) {
            f32x2v acc = bias;
#pragma unroll
            for (int j = 0; j < 31; ++j) acc = w[j] * u[o + j] + acc;
            yv[o] = cvt_pk_bf16(acc.x, acc.y);
        }
        __syncthreads();
#pragma unroll
        for (int o = 0; o < HT; ++o) yl[(tg * HT + o) * 256 + cp] = yv[o];
        __syncthreads();
        for (int o = wave; o < CT; o += NWAVES) {
            const int t = t0 + o;
            if (t >= NMETA && t < T) {
                const u32x4 yw = *(const LAS u32x4*)(yl + o * 256 + 4 * lane);
                const f32x4 y0 = {bflo(yw.x), bfhi(yw.x), bflo(yw.y), bfhi(yw.y)}, y1 = {bflo(yw.z), bfhi(yw.z), bflo(yw.w), bfhi(yw.w)};
                const float mean = wave_sum((y0[0] + y0[1]) + (y0[2] + y0[3]) + (y1[0] + y1[1]) + (y1[2] + y1[3])) * (1.f / 512.f);
                const f32x4 d0 = y0 - mean, d1 = y1 - mean;
                const float var = wave_sum((d0[0] * d0[0] + d0[1] * d0[1]) + (d0[2] * d0[2] + d0[3] * d0[3]) + (d1[0] * d1[0] + d1[1] * d1[1]) + (d1[2] * d1[2] + d1[3] * d1[3])) * (1.f / 512.f);
                const float rstd = __builtin_amdgcn_rsqf(var + 1e-5f);
                const f32x4 g0 = *(const f32x4*)(ln_g + 8 * lane), g1 = *(const f32x4*)(ln_g + 8 * lane + 4), b0 = *(const f32x4*)(ln_b + 8 * lane), b1 = *(const f32x4*)(ln_b + 8 * lane + 4);
                f32x4 z0 = d0 * rstd * g0 + b0, z1 = d1 * rstd * g1 + b1;
#pragma unroll
                for (int j = 0; j < 4; ++j) { z0[j] = z0[j] * sigm(z0[j]); z1[j] = z1[j] * sigm(z1[j]); }
                store8(ACL + ((size_t)b * SEQ + (t - NMETA)) * 512 + 8 * lane, z0, z1);
            }
        }
        __syncthreads();
    }
}

__device__ __forceinline__ void p2_lorag(const Args& a, int G, const int wave) {
    const int lane = pg8::get_lane();
    const bf16_t* Zr = (const bf16_t*)(a.ws + WS_ZR); bf16_t* A2g = (bf16_t*)(a.ws + WS_A2);
    const float mu0 = a.in[9][1664 + 2 * lane], mu1 = a.in[9][1664 + 2 * lane + 1];
    const int gw = blockIdx.x * NWAVES + wave, NGW = G * NWAVES;
    for (int run = gw; run < MT / 16; run += NGW) {
        const int m0 = run * 16, t0 = m0 % T;
        unsigned rw[17];
        rw[0] = 0u; if (t0 > 0) rw[0] = *(const unsigned*)(Zr + (size_t)(m0 - 1) * RWIN + 1664 + 2 * lane);
#pragma unroll
        for (int i = 0; i < 16; ++i) rw[i + 1] = *(const unsigned*)(Zr + (size_t)(m0 + i) * RWIN + 1664 + 2 * lane);
#pragma unroll
        for (int i = 0; i < 16; ++i) { const float c0 = bflo(rw[i + 1]), c1 = bfhi(rw[i + 1]);
            *(unsigned*)(A2g + (size_t)(m0 + i) * 128 + 2 * lane) = cvt_pk_bf16(sigm(c0 + (bflo(rw[i]) - c0) * mu0), sigm(c1 + (bfhi(rw[i]) - c1) * mu1)); }
    }
}

typedef short s16x4 __attribute__((ext_vector_type(4)));
__device__ __forceinline__ f32x4 mfma16(const s16x4 x, const s16x4 y, const f32x4 c) { return __builtin_amdgcn_mfma_f32_16x16x16bf16_1k(x, y, c, 0, 0, 0); }
__device__ __forceinline__ unsigned short f2bf_bits(float f) { return (unsigned short)(cvt_pk_bf16(f, 0.f) & 0xffffu); }
__device__ __forceinline__ s16x4 pack4(const f32x4 v) { u32x2 w; w.x = cvt_pk_bf16(v[0], v[1]); w.y = cvt_pk_bf16(v[2], v[3]); return __builtin_bit_cast(s16x4, w); }
__device__ __forceinline__ float bf2f(unsigned short b) { return __builtin_bit_cast(float, (unsigned)b << 16); }
constexpr int NCHK = T / 16;

__device__ __forceinline__ bf16_t* bb_base(const Args& a, int b) {
    return (b < 7) ? (bf16_t*)((unsigned char*)a.out + 99 * MiB) : (bf16_t*)(a.ws + WS_A2 + 9 * MiB) - (size_t)7 * T * 512;
}
__device__ __forceinline__ float tanh_fast(float x) { return 1.f - 2.f * __builtin_amdgcn_rcpf(1.f + __expf(2.f * x)); }
constexpr int P4_WSTRIDE = 13568, P4_WL = 8 * P4_WSTRIDE  , P4_MU = P4_WL + 2 * 9216  ;

template <bool TAIL> __device__ __forceinline__ void p4a_fused(const Args& a, LAS unsigned char* lds, int G, const int wave, const int tail_b) {
    const int lane_o = pg8::get_lane();
    const bf16_t* Zr = (const bf16_t*)(a.ws + WS_ZR);
    bf16_t* Rb = (bf16_t*)a.out; bf16_t* Vb = (bf16_t*)((unsigned char*)a.out + 33 * MiB); bf16_t* Kb = (bf16_t*)((unsigned char*)a.out + 66 * MiB);
    bf16_t* KKb = (bf16_t*)(a.ws + WS_KK); bf16_t* Em = (bf16_t*)(a.ws + WS_EM); float* WCa = (float*)(a.ws + WS_WC);
    float* RKs = (float*)(a.ws + WS_RK);
    LAS unsigned char* wl = lds + wave * P4_WSTRIDE;
    LAS unsigned char* mt = wl + 4352;
    LAS float* Al = (LAS float*)(wl + 2048);
    LAS float* ST = (LAS float*)wl;
    constexpr int NVB = 8 * 32, NITEM = TAIL ? 1 : NB * 256;
    const bf16_t* WsmG = (const bf16_t*)(a.ws + WS_WSM);
    for (int vb = TAIL ? 0 : (int)blockIdx.x; vb < (TAIL ? 1 : NVB); vb += G) {
    const int h = TAIL ? wave : (vb & 7), q8 = TAIL ? -wave : (vb >> 3) * 8;
    if (!TAIL) {   const bf16_t* Wsm = (const bf16_t*)(a.ws + WS_WSM); const int tid = wave * 64 + lane_o;
#pragma unroll
        for (int i = 0; i < 2; ++i) { const int q = tid + NTHR * i, kind = q >> 9, ch = (q >> 3) & 63, pc = q & 7;
            *(LAS u32x4*)(lds + P4_WL + kind * 9216 + ch * 144 + pc * 16) = *(const u32x4*)(Wsm + (size_t)(kind * 512 + h * 64 + ch) * 256 + kind * 64 + pc * 8); }
        if (tid < 128) *(LAS float*)(lds + P4_MU + tid * 4) = a.in[9][1536 + tid];
        __syncthreads(); }
    const int chn_o = h * 64 + lane_o;
    const float mu_r = a.in[9][chn_o], mu_k = a.in[9][512 + chn_o], mu_v = a.in[9][1024 + chn_o], w0c = a.in[10][chn_o], a0c = a.in[12][chn_o], kkc = a.in[15][chn_o], kac = a.in[16][chn_o], rkc2 = a.in[17][chn_o];
    u32x4 n_r0, n_r1, n_k0, n_k1, n_v0, n_v1, n_lw0, n_lw1, n_la0, n_la1, n_pw0, n_pw1, n_pa0, n_pa1; unsigned short n_pr, n_pk, n_pv;
#define F_LOAD(bcx) do { const int b_ = TAIL ? tail_b : ((bcx) >> 8), c_ = TAIL ? NCHK - 1 : ((bcx) & 255); const size_t m0_ = (size_t)b_ * T + (size_t)c_ * 16; \
        const bf16_t* zp_ = Zr + (m0_ + prow) * RWIN + h * 64 + pp * 8; \
        n_r0 = *(const u32x4*)zp_; n_r1 = *(const u32x4*)(zp_ + 8 * RWIN); n_k0 = *(const u32x4*)(zp_ + 512); n_k1 = *(const u32x4*)(zp_ + 8 * RWIN + 512); \
        n_v0 = *(const u32x4*)(zp_ + 1024); n_v1 = *(const u32x4*)(zp_ + 8 * RWIN + 1024); \
        const bf16_t* zl_ = Zr + (m0_ + x) * RWIN + 1536 + 8 * g; \
        n_lw0 = *(const u32x4*)zl_; n_lw1 = *(const u32x4*)(zl_ + 32); n_la0 = *(const u32x4*)(zl_ + 64); n_la1 = *(const u32x4*)(zl_ + 96); \
        n_pw0 = (u32x4){0u, 0u, 0u, 0u}; n_pw1 = n_pw0; n_pa0 = n_pw0; n_pa1 = n_pw0; n_pr = 0; n_pk = 0; n_pv = 0; \
        if (c_ > 0) { const bf16_t* zq_ = Zr + (m0_ - 1) * RWIN; \
            n_pr = *(const unsigned short*)(zq_ + chn); n_pk = *(const unsigned short*)(zq_ + 512 + chn); n_pv = *(const unsigned short*)(zq_ + 1024 + chn); \
            n_pw0 = *(const u32x4*)(zq_ + 1536 + 8 * g); n_pw1 = *(const u32x4*)(zq_ + 1568 + 8 * g); n_pa0 = *(const u32x4*)(zq_ + 1600 + 8 * g); n_pa1 = *(const u32x4*)(zq_ + 1632 + 8 * g); } } while (0)
    if (q8 + wave < NITEM) { const int lane = lane_o, x = lane & 15, g = lane >> 4, prow = lane >> 3, pp = lane & 7, chn = h * 64 + lane; F_LOAD(q8 + wave); }
    for (int bc = q8 + wave; bc < NITEM; bc += NVB) {
        int lx_ = lane_o; asm volatile("" : "+v"(lx_)); const int lane = lx_, x = lane & 15, g = lane >> 4, prow = lane >> 3, pp = lane & 7, chn = h * 64 + lane;
        const int b = TAIL ? tail_b : (bc >> 8), c = TAIL ? NCHK - 1 : (bc & 255);
        const size_t m0 = (size_t)b * T + (size_t)c * 16;
        const size_t e0 = m0 * 512 + h * 64;
        const size_t pb = e0 + (size_t)prow * 512 + pp * 8;
        bf16_t* Bb = bb_base(a, b);
        bf16x8 Aw0, Aw1, Aa0, Aa1;
#define LORA_FRAG(DST, CUR, PRV, MUOFF, TANH) do { f32x4 ma_, mb_; if (TAIL) { ma_ = *(const f32x4*)(a.in[9] + 1536 + (MUOFF) + 8 * g); mb_ = *(const f32x4*)(a.in[9] + 1536 + (MUOFF) + 8 * g + 4); } \
            else { ma_ = *(const LAS f32x4*)(lds + P4_MU + ((MUOFF) + 8 * g) * 4); mb_ = *(const LAS f32x4*)(lds + P4_MU + ((MUOFF) + 8 * g) * 4 + 16); } \
            const float mm_[8] = {ma_[0], ma_[1], ma_[2], ma_[3], mb_[0], mb_[1], mb_[2], mb_[3]}; u32x4 o_; \
            _Pragma("unroll") for (int i = 0; i < 4; ++i) { const unsigned cw_ = CUR[i]; const unsigned pw_ = (unsigned)__builtin_amdgcn_update_dpp((int)PRV[i], (int)cw_, 0x111, 0xf, 0xf, false); \
                float zl_ = bflo(cw_), zh_ = bfhi(cw_); zl_ += (bflo(pw_) - zl_) * mm_[2 * i]; zh_ += (bfhi(pw_) - zh_) * mm_[2 * i + 1]; \
                if (TANH) { zl_ = tanh_fast(zl_); zh_ = tanh_fast(zh_); } o_[i] = cvt_pk_bf16(zl_, zh_); } \
            DST = __builtin_bit_cast(bf16x8, o_); } while (0)
        LORA_FRAG(Aw0, n_lw0, n_pw0, 0, true); LORA_FRAG(Aw1, n_lw1, n_pw1, 32, true); LORA_FRAG(Aa0, n_la0, n_pa0, 64, false); LORA_FRAG(Aa1, n_la1, n_pa1, 96, false);
#undef LORA_FRAG
        *(LAS u32x4*)(mt + prow * 128 + pp * 16) = n_k0; *(LAS u32x4*)(mt + (prow + 8) * 128 + pp * 16) = n_k1;
        *(LAS u32x4*)(mt + 2048 + prow * 128 + pp * 16) = n_v0; *(LAS u32x4*)(mt + 2048 + (prow + 8) * 128 + pp * 16) = n_v1;
        *(LAS u32x4*)(mt + 4096 + prow * 128 + pp * 16) = n_r0; *(LAS u32x4*)(mt + 4096 + (prow + 8) * 128 + pp * 16) = n_r1;
        const float p_r = bf2f(n_pr), p_k = bf2f(n_pk), p_v = bf2f(n_pv);
        LDS_WAIT(); asm volatile("" ::: "memory");
        { const int bcn = (bc + NVB < NITEM) ? bc + NVB : bc; F_LOAD(bcn); }
        float ev[16], av[16];
        {   f32x4 accW[4], accA[4]; const f32x4 z4 = {0.f, 0.f, 0.f, 0.f};
#pragma unroll
            for (int n = 0; n < 4; ++n) { bf16x8 bw0, bw1, ba0, ba1;
                if (TAIL) { const bf16_t* gw_ = WsmG + (size_t)(h * 64 + 16 * n + x) * 256 + 8 * g; const bf16_t* ga_ = gw_ + (size_t)512 * 256 + 64;
                    bw0 = *(const bf16x8*)gw_; bw1 = *(const bf16x8*)(gw_ + 32); ba0 = *(const bf16x8*)ga_; ba1 = *(const bf16x8*)(ga_ + 32); }
                else { const LAS unsigned char* wp = lds + P4_WL + (16 * n + x) * 144 + g * 16;
                    bw0 = *(const LAS bf16x8*)wp; bw1 = *(const LAS bf16x8*)(wp + 64); ba0 = *(const LAS bf16x8*)(wp + 9216); ba1 = *(const LAS bf16x8*)(wp + 9216 + 64); }
                accW[n] = __builtin_amdgcn_mfma_f32_16x16x32_bf16(Aw0, bw0, z4, 0, 0, 0); accW[n] = __builtin_amdgcn_mfma_f32_16x16x32_bf16(Aw1, bw1, accW[n], 0, 0, 0);
                accA[n] = __builtin_amdgcn_mfma_f32_16x16x32_bf16(Aa0, ba0, z4, 0, 0, 0); accA[n] = __builtin_amdgcn_mfma_f32_16x16x32_bf16(Aa1, ba1, accA[n], 0, 0, 0); }
#pragma unroll
            for (int n = 0; n < 4; ++n)
#pragma unroll
                for (int r = 0; r < 4; ++r) ST[(4 * g + r) * 68 + 16 * n + x] = accW[n][r];
            LDS_WAIT(); asm volatile("" ::: "memory");
#pragma unroll
            for (int t = 0; t < 16; ++t) ev[t] = (0.60653065971f * 1.44269504089f) * sigm(w0c + ST[t * 68 + lane]);
            LDS_WAIT(); asm volatile("" ::: "memory");
#pragma unroll
            for (int n = 0; n < 4; ++n)
#pragma unroll
                for (int r = 0; r < 4; ++r) ST[(4 * g + r) * 68 + 16 * n + x] = accA[n][r];
            LDS_WAIT(); asm volatile("" ::: "memory");
#pragma unroll
            for (int t = 0; t < 16; ++t) av[t] = sigm(a0c + ST[t * 68 + lane]);
            LDS_WAIT(); asm volatile("" ::: "memory");
        }
        float kkv[16], bv[16], kv[16], rv[16]; unsigned short vbits[16];
#define UNSTAGE_SHIFT(dst, OFF, PREV, MU) do { float pv_ = (PREV); _Pragma("unroll") for (int t = 0; t < 16; ++t) { const float c_ = bf2f(*(const LAS unsigned short*)(mt + (OFF) + t * 128 + lane * 2)); dst[t] = c_ + (pv_ - c_) * (MU); pv_ = c_; } } while (0)
        UNSTAGE_SHIFT(rv, 4096, p_r, mu_r); UNSTAGE_SHIFT(kv, 0, p_k, mu_k); UNSTAGE_SHIFT(bv, 2048, p_v, mu_v);
        LDS_WAIT(); asm volatile("" ::: "memory");
#pragma unroll
        for (int t = 0; t < 16; ++t) vbits[t] = f2bf_bits(bv[t]);
#undef UNSTAGE_SHIFT
        {
#pragma unroll
          for (int t = 0; t < 16; ++t) { kkv[t] = kv[t] * kkc; ST[t * 65 + lane] = kkv[t] * kkv[t]; }
          LDS_WAIT(); asm volatile("" ::: "memory");
          float s = 0.f;
#pragma unroll
          for (int j = 0; j < 16; ++j) s += ST[x * 65 + 16 * g + j];
          s += __shfl_xor(s, 16); s += __shfl_xor(s, 32);
          const int rnb = __builtin_bit_cast(int, __builtin_amdgcn_rsqf(fmaxf(s, 1e-24f)));
          LDS_WAIT(); asm volatile("" ::: "memory");
#pragma unroll
          for (int t = 0; t < 16; ++t) { const float rn = __builtin_bit_cast(float, __builtin_amdgcn_readlane(rnb, t));
              kkv[t] *= rn; bv[t] = kkv[t] * av[t]; kv[t] = kv[t] * (1.f + (av[t] - 1.f) * kac); } }
        {
#pragma unroll
          for (int t = 0; t < 16; ++t) *(LAS float*)(wl + (t * 65 + lane) * 4) = rv[t] * kv[t] * rkc2;
          LDS_WAIT(); asm volatile("" ::: "memory");
          float s = 0.f;
#pragma unroll
          for (int j = 0; j < 16; ++j) s += *(const LAS float*)(wl + (x * 65 + 16 * g + j) * 4);
          s += __shfl_xor(s, 16); s += __shfl_xor(s, 32);
          if (lane < 16) RKs[(m0 + lane) * 8 + h] = s;
          LDS_WAIT(); asm volatile("" ::: "memory"); }
        float lw = 0.f, wprev = 1.f; float bts[16], kts[16];
#pragma unroll
        for (int t = 0; t < 16; ++t) {
            lw -= ev[t]; const float wt = __builtin_amdgcn_exp2f(lw), iw = __builtin_amdgcn_exp2f(-lw);
            bts[t] = bv[t] * iw; kts[t] = kv[t] * iw;
            *(LAS unsigned short*)(mt + 0 * 2304 + t * 144 + lane * 2) = f2bf_bits(-kkv[t] * wprev); *(LAS unsigned short*)(mt + 1 * 2304 + t * 144 + lane * 2) = f2bf_bits(rv[t] * wt);
            *(LAS unsigned short*)(mt + 2 * 2304 + t * 144 + lane * 2) = f2bf_bits(bts[t]); *(LAS unsigned short*)(mt + 3 * 2304 + t * 144 + lane * 2) = f2bf_bits(kts[t]);
            wprev = wt;
        }
        const float wc = wprev;
        {
            const size_t o = e0 + (size_t)(lane >> 2) * 512 + (lane & 3) * 16;
            u32x4 w0, w1;
            w0.x = cvt_pk_bf16(bts[0] * wc, bts[1] * wc); w0.y = cvt_pk_bf16(bts[2] * wc, bts[3] * wc); w0.z = cvt_pk_bf16(bts[4] * wc, bts[5] * wc); w0.w = cvt_pk_bf16(bts[6] * wc, bts[7] * wc);
            w1.x = cvt_pk_bf16(bts[8] * wc, bts[9] * wc); w1.y = cvt_pk_bf16(bts[10] * wc, bts[11] * wc); w1.z = cvt_pk_bf16(bts[12] * wc, bts[13] * wc); w1.w = cvt_pk_bf16(bts[14] * wc, bts[15] * wc);
            *(u32x4*)(Bb + o) = w0; *(u32x4*)(Bb + o + 8) = w1;
            w0.x = cvt_pk_bf16(kts[0] * wc, kts[1] * wc); w0.y = cvt_pk_bf16(kts[2] * wc, kts[3] * wc); w0.z = cvt_pk_bf16(kts[4] * wc, kts[5] * wc); w0.w = cvt_pk_bf16(kts[6] * wc, kts[7] * wc);
            w1.x = cvt_pk_bf16(kts[8] * wc, kts[9] * wc); w1.y = cvt_pk_bf16(kts[10] * wc, kts[11] * wc); w1.z = cvt_pk_bf16(kts[12] * wc, kts[13] * wc); w1.w = cvt_pk_bf16(kts[14] * wc, kts[15] * wc);
            *(u32x4*)(Kb + o) = w0; *(u32x4*)(Kb + o + 8) = w1;
            w0.x = vbits[0] | ((unsigned)vbits[1] << 16); w0.y = vbits[2] | ((unsigned)vbits[3] << 16); w0.z = vbits[4] | ((unsigned)vbits[5] << 16); w0.w = vbits[6] | ((unsigned)vbits[7] << 16);
            w1.x = vbits[8] | ((unsigned)vbits[9] << 16); w1.y = vbits[10] | ((unsigned)vbits[11] << 16); w1.z = vbits[12] | ((unsigned)vbits[13] << 16); w1.w = vbits[14] | ((unsigned)vbits[15] << 16);
            *(u32x4*)(Vb + o) = w0; *(u32x4*)(Vb + o + 8) = w1;
        }
        LDS_WAIT(); asm volatile("" ::: "memory");
        { const u32x4 a0 = *(const LAS u32x4*)(mt + 0 * 2304 + prow * 144 + pp * 16), a1 = *(const LAS u32x4*)(mt + 0 * 2304 + (prow + 8) * 144 + pp * 16);
          const u32x4 r0 = *(const LAS u32x4*)(mt + 1 * 2304 + prow * 144 + pp * 16), r1 = *(const LAS u32x4*)(mt + 1 * 2304 + (prow + 8) * 144 + pp * 16);
          *(u32x4*)(KKb + pb) = a0; *(u32x4*)(KKb + pb + 8 * 512) = a1; *(u32x4*)(Rb + pb) = r0; *(u32x4*)(Rb + pb + 8 * 512) = r1; }
        { int ly_ = lane_o; asm volatile("" : "+v"(ly_)); const int lane = ly_, x = lane & 15, g = lane >> 4, prow = lane >> 3, pp = lane & 7;
        f32x4 Aab = {0.f, 0.f, 0.f, 0.f}, Aak = Aab, Arb = Aab, Ark = Aab, AabT = Aab;
#pragma unroll
        for (int s = 0; s < 4; ++s) {
            const int fo = x * 144 + (16 * s + 4 * g) * 2;
            const s16x4 aF = *(const LAS s16x4*)(mt + 0 * 2304 + fo), rF = *(const LAS s16x4*)(mt + 1 * 2304 + fo), bF = *(const LAS s16x4*)(mt + 2 * 2304 + fo), kF = *(const LAS s16x4*)(mt + 3 * 2304 + fo);
            Aab = mfma16(aF, bF, Aab); Aak = mfma16(aF, kF, Aak); Arb = mfma16(rF, bF, Arb); Ark = mfma16(rF, kF, Ark); AabT = mfma16(bF, aF, AabT);
        }
        f32x4 idr;
#pragma unroll
        for (int r = 0; r < 4; ++r) { const int t = 4 * g + r; if (!(x < t)) { Aab[r] = 0.f; Aak[r] = 0.f; } if (!(x <= t)) { Arb[r] = 0.f; Ark[r] = 0.f; } if (!(t < x)) AabT[r] = 0.f; idr[r] = (x == t) ? 1.f : 0.f;
            *(LAS unsigned short*)(wl + t * 128 + 32 + 2 * x) = f2bf_bits(Arb[r]); *(LAS unsigned short*)(wl + t * 128 + 64 + 2 * x) = f2bf_bits(Aak[r]); *(LAS unsigned short*)(wl + t * 128 + 96 + 2 * x) = f2bf_bits(Ark[r]); }
        {   const f32x4 z4 = {0.f, 0.f, 0.f, 0.f};
            const s16x4 pA = pack4(Aab), pAT = pack4(AabT);
            const f32x4 A2 = mfma16(pAT, pA, z4), A2T = mfma16(pA, pAT, z4);
            const s16x4 pA2 = pack4(A2), pA2T = pack4(A2T);
            const f32x4 A4 = mfma16(pA2T, pA2, z4), A4T = mfma16(pA2, pA2T, z4);
            const f32x4 A8 = mfma16(pack4(A4T), pack4(A4), z4);
            const s16x4 pIAT = pack4(AabT + idr), pIA2 = pack4(A2 + idr), pIA4 = pack4(A4 + idr), pIA8 = pack4(A8 + idr);
            const f32x4 T1T = mfma16(pIA2, pIAT, z4);
            const f32x4 T2T = mfma16(pIA4, pack4(T1T), z4);
            const f32x4 T3 = mfma16(pack4(T2T), pIA8, z4);
#pragma unroll
            for (int r = 0; r < 4; ++r) *(LAS unsigned short*)(wl + (4 * g + r) * 128 + 2 * x) = f2bf_bits(T3[r]);
        }
        LDS_WAIT(); asm volatile("" ::: "memory");
        { const u32x4 m0v = *(const LAS u32x4*)(wl + prow * 128 + pp * 16), m1v = *(const LAS u32x4*)(wl + (prow + 8) * 128 + pp * 16);
          *(u32x4*)(Em + pb) = m0v; *(u32x4*)(Em + pb + 8 * 512) = m1v;
          WCa[((size_t)(b * NHEAD + h) * NCHK + c) * 64 + lane] = wc; }
        LDS_WAIT(); asm volatile("" ::: "memory");
        }
    }
    __syncthreads();
    }
#undef F_LOAD
}

struct ScanOps { s16x4 Af[4], Rf[4], Mf[4], BTf[4], KTf[4], VTf; f32x4 WCf[4]; };
constexpr int RS_STRIDE = 13824, RS_NSLOT = 3, RS_OBUF = RS_NSLOT * RS_STRIDE;
constexpr int SCAN_NIT = 264;
__device__ __forceinline__ int rs_mk(int low3) { return low3 | (((low3 >> 2) & 1) << 3); }
__device__ __forceinline__ int rs_mig(int i, int g) { return rs_mk(2 * i + (g >> 1)); }
__device__ __forceinline__ int rs_mgh(int g, int h) { return rs_mk(2 * ((g >> 1) * 2 + h)); }
__device__ __forceinline__ s16x4 lo64(const u32x4 v) { const u32x2 w = {v.x, v.y}; return __builtin_bit_cast(s16x4, w); }
__device__ __forceinline__ s16x4 hi64(const u32x4 v) { const u32x2 w = {v.z, v.w}; return __builtin_bit_cast(s16x4, w); }
__device__ __forceinline__ void scan_frag_read(ScanOps& o, LAS unsigned char* slot, const int (&oar)[4], const int (&om)[2], const int ov, const int g) {
#pragma unroll
    for (int i = 0; i < 4; ++i) {
        const u32x4 ar = *(const LAS u32x4*)(slot + oar[i]), bk = *(const LAS u32x4*)(slot + 4096 + oar[i]);
        o.Af[i] = lo64(ar); o.Rf[i] = hi64(ar); o.BTf[i] = lo64(bk); o.KTf[i] = hi64(bk);
        o.WCf[i] = *(const LAS f32x4*)(slot + 12800 + (4 * i + g) * 16); }
    const u32x4 m0 = *(const LAS u32x4*)(slot + 8192 + om[0]), m1 = *(const LAS u32x4*)(slot + 8192 + om[1]);
    o.Mf[0] = lo64(m0); o.Mf[1] = hi64(m0); o.Mf[2] = lo64(m1); o.Mf[3] = hi64(m1);
    o.VTf = *(const LAS s16x4*)(slot + 10240 + ov);
}
__device__ __forceinline__ void scan_step(const ScanOps& o, f32x4 (&Sacc)[4], s16x4 (&Sb)[4], LAS float* ob, int x, int g, int w) {
    const f32x4 z = {0.f, 0.f, 0.f, 0.f};
    f32x4 X = mfma16(o.Mf[2], o.VTf, z);
#pragma unroll
    for (int i = 0; i < 4; ++i) X = mfma16(o.Af[i], Sb[i], X);
    const s16x4 Xb = pack4(X);
    const f32x4 U = mfma16(o.Mf[0], Xb, z); const s16x4 Ub = pack4(U);
    f32x4 Oc = mfma16(o.Mf[3], o.VTf, z);
#pragma unroll
    for (int i = 0; i < 4; ++i) Oc = mfma16(o.Rf[i], Sb[i], Oc);
    Oc = mfma16(o.Mf[1], Ub, Oc);
#pragma unroll
    for (int i = 0; i < 4; ++i) { f32x4 s = Sacc[i] * o.WCf[i]; s = mfma16(o.KTf[i], o.VTf, s); s = mfma16(o.BTf[i], Ub, s); Sacc[i] = s; Sb[i] = pack4(s); }
#pragma unroll
    for (int r = 0; r < 4; ++r) ob[(4 * g + r) * 64 + 16 * w + x] = Oc[r];
}

__device__ __forceinline__ void p4b_chain(const Args& a, LAS unsigned char* lds, int G, const int wave) {
    const int lane = pg8::get_lane(), x = lane & 15, g = lane >> 4;
    const bf16_t* Rb = (const bf16_t*)a.out; const bf16_t* Vb = (const bf16_t*)((unsigned char*)a.out + 33 * MiB); const bf16_t* Kb = (const bf16_t*)((unsigned char*)a.out + 66 * MiB);
    const bf16_t* KKb = (const bf16_t*)(a.ws + WS_KK);
    const bf16_t* Em = (const bf16_t*)(a.ws + WS_EM); const float* WCa = (const float*)(a.ws + WS_WC); bf16_t* ORAW = (bf16_t*)(a.ws + WS_ORAW);
    LAS float* obuf = (LAS float*)(lds + RS_OBUF);
#define SCAN_BAR() do { asm volatile("s_waitcnt lgkmcnt(0)" ::: "memory"); __builtin_amdgcn_s_barrier(); asm volatile("" ::: "memory"); } while (0)
    for (int it = blockIdx.x; it < NB * NHEAD; it += G) {
        const int b = it >> 3, h = it & 7;
        const bf16_t* Bb = bb_base(a, b);
        const size_t ebase = (size_t)b * T * 512 + h * 64;
        const int sb0 = (int)(ebase * 2);
        if (wave < 4) {
            f32x4 Sacc[4]; s16x4 Sb[4];
#pragma unroll
            for (int i = 0; i < 4; ++i) { Sacc[i] = (f32x4){0.f, 0.f, 0.f, 0.f}; Sb[i] = (s16x4){0, 0, 0, 0}; }
            int oar[4], om[2];
#pragma unroll
            for (int i = 0; i < 4; ++i) oar[i] = (4 * i + g) * 256 + ((x ^ rs_mig(i, g)) * 16);
            om[0] = (2 * g) * 256 + ((x ^ rs_mgh(g, 0)) * 16); om[1] = (2 * g + 1) * 256 + ((x ^ rs_mgh(g, 1)) * 16);
            const int ov = g * 640 + (16 * wave + x) * 8;
            SCAN_BAR();
            ScanOps opA, opB;
            scan_frag_read(opA, lds, oar, om, ov, g);
#define CONS_ITER(cc, CUR, NXT) do { { const int sn_ = ((cc) + 1) % 3; scan_frag_read(NXT, lds + sn_ * RS_STRIDE, oar, om, ov, g); } \
                if ((cc) < NCHK) scan_step(CUR, Sacc, Sb, obuf + ((cc) & 1) * 1024, x, g, wave); SCAN_BAR(); } while (0)
            for (int cc = 0; cc < SCAN_NIT; cc += 2) { CONS_ITER(cc, opA, opB); CONS_ITER(cc + 1, opB, opA); }
#undef CONS_ITER
        } else {
            const int lw = wave - 4, hf = lw & 1, prow = 8 * hf + (lane >> 3), pp = lane & 7;
            const __amdgpu_buffer_rsrc_t rs0 = __builtin_amdgcn_make_buffer_rsrc((void*)(lw < 2 ? KKb : Rb), 0, 0x7fffffff, 0x00020000);
            const __amdgpu_buffer_rsrc_t rs1 = __builtin_amdgcn_make_buffer_rsrc((void*)(lw < 2 ? Bb : Kb), 0, 0x7fffffff, 0x00020000);
            const __amdgpu_buffer_rsrc_t rs2 = __builtin_amdgcn_make_buffer_rsrc((void*)(lw < 2 ? (const void*)Vb : (const void*)Em), 0, 0x7fffffff, 0x00020000);
            const __amdgpu_buffer_rsrc_t rsE = __builtin_amdgcn_make_buffer_rsrc((void*)WCa, 0, 0x7fffffff, 0x00020000), rsO = __builtin_amdgcn_make_buffer_rsrc((void*)ORAW, 0, 0x7fffffff, 0x00020000);
            const int vo01 = prow * 1024 + pp * 16;
            const int voW = (lane & 15) * 16, wcb0 = it * NCHK * 256;
            const int hi8 = (lw < 2) ? 0 : 8;
            int w0a[2], w1a[2], w2a[2];
#pragma unroll
            for (int hl = 0; hl < 2; ++hl) { const int gg = 2 * (pp & 1) + hl, ii = pp >> 1;
                w0a[hl] = (4 * ii + gg) * 256 + ((prow ^ rs_mig(ii, gg)) * 16) + hi8;
                const int kr = 4 * prow + (pp >> 1), ki = kr >> 4, kx = kr & 15;
                w1a[hl] = 4096 + (4 * ki + gg) * 256 + ((kx ^ rs_mig(ki, gg)) * 16) + hi8;
                w2a[hl] = (lw < 2) ? (10240 + gg * 640 + kr * 8) : (8192 + (2 * gg + (ii >> 1)) * 256 + ((prow ^ rs_mgh(gg, ii >> 1)) * 16) + 8 * (ii & 1)); }
            const int ldW = 12800 + (lane & 15) * 16;
            struct RSet { u32x4 r0, r1, r2, rw; };
            RSet s0, s1, s2, s3, s4, s5, s6, s7;
#define RING_LOAD(S, chunk) do { const int cn_ = ((chunk) < NCHK) ? (chunk) : NCHK - 1; const int so_ = sb0 + cn_ * 16 * 1024; \
                S.r0 = __builtin_amdgcn_raw_buffer_load_b128(rs0, vo01, so_, 0); S.r1 = __builtin_amdgcn_raw_buffer_load_b128(rs1, vo01, so_, 0); \
                S.r2 = __builtin_amdgcn_raw_buffer_load_b128(rs2, vo01, so_, 0); S.rw = __builtin_amdgcn_raw_buffer_load_b128(rsE, voW, wcb0 + cn_ * 256, 0); } while (0)
#define RING_WRITE(S, slotp) do { LAS unsigned char* sp_ = (slotp); \
                *(LAS u32x2*)(sp_ + w0a[0]) = (u32x2){S.r0.x, S.r0.y}; *(LAS u32x2*)(sp_ + w0a[1]) = (u32x2){S.r0.z, S.r0.w}; \
                *(LAS u32x2*)(sp_ + w1a[0]) = (u32x2){S.r1.x, S.r1.y}; *(LAS u32x2*)(sp_ + w1a[1]) = (u32x2){S.r1.z, S.r1.w}; \
                *(LAS u32x2*)(sp_ + w2a[0]) = (u32x2){S.r2.x, S.r2.y}; *(LAS u32x2*)(sp_ + w2a[1]) = (u32x2){S.r2.z, S.r2.w}; \
                if (lw == 0 && lane < 16) *(LAS u32x4*)(sp_ + ldW) = S.rw; } while (0)
            RING_LOAD(s0, 0); RING_LOAD(s1, 1); RING_LOAD(s2, 2); RING_LOAD(s3, 3); RING_LOAD(s4, 4); RING_LOAD(s5, 5); RING_LOAD(s6, 6); RING_LOAD(s7, 7);
            RING_WRITE(s0, lds); RING_LOAD(s0, 8); RING_WRITE(s1, lds + RS_STRIDE);
            SCAN_BAR();
#define LOADER_ITER(cc, WS, LS) do { \
                RING_WRITE(WS, lds + (((cc) + 2) % 3) * RS_STRIDE); RING_LOAD(LS, (cc) + 9); \
                if ((cc) >= 1 && (cc) <= NCHK) { const int pc = (cc) - 1; const LAS float* ob = obuf + (pc & 1) * 1024; \
                    _Pragma("unroll") for (int q = 0; q < 4; ++q) { const int ts = 4 * lw + q; \
                        __builtin_amdgcn_raw_buffer_store_b16(f2bf_bits(ob[ts * 64 + lane]), rsO, 2 * lane, sb0 + (pc * 16 + ts) * 1024, 0); } } \
                SCAN_BAR(); } while (0)
            static_assert(SCAN_NIT % 8 == 0 && SCAN_NIT > NCHK, "loader iterations come in eights");
            for (int cc = 0; cc < SCAN_NIT; cc += 8) { LOADER_ITER(cc, s2, s1); LOADER_ITER(cc + 1, s3, s2); LOADER_ITER(cc + 2, s4, s3); LOADER_ITER(cc + 3, s5, s4);
                                                      LOADER_ITER(cc + 4, s6, s5); LOADER_ITER(cc + 5, s7, s6); LOADER_ITER(cc + 6, s0, s7); LOADER_ITER(cc + 7, s1, s0); }
#undef LOADER_ITER
#undef RING_WRITE
#undef RING_LOAD
        }
        __syncthreads();
    }
#undef SCAN_BAR
}

__device__ __forceinline__ void p4c_post(const Args& a, int G, const int wave) {
    const int lane = pg8::get_lane();
    const bf16_t* ORAW = (const bf16_t*)(a.ws + WS_ORAW); const bf16_t* Vb = (const bf16_t*)((unsigned char*)a.out + 33 * MiB); const bf16_t* Gb = (const bf16_t*)(a.ws + WS_ZR + 33 * MiB);
    const float* RKs = (const float*)(a.ws + WS_RK); bf16_t* ACR = (bf16_t*)(a.ws + WS_XN);
    const float* gn_g = a.in[18]; const float* gn_b = a.in[19];
    const int gw = blockIdx.x * NWAVES + wave, NGW = G * NWAVES;
    for (int m2 = gw; m2 < M2; m2 += NGW) {
        const int b = m2 >> 12, t = (m2 & 4095) + NMETA; const size_t m = (size_t)b * T + t;
        const int c = t >> 4, ts = t & 15;
        const float rkv = (lane < 8) ? RKs[m * 8 + lane] : 0.f;
#pragma unroll
        for (int h = 0; h < NHEAD; ++h) {
            const float o = bf2f(ORAW[m * 512 + h * 64 + lane]);
            const float vv = bf2f(Vb[((size_t)b * T + c * 16 + (lane >> 2)) * 512 + h * 64 + (lane & 3) * 16 + ts]);
            const float gg = bf2f(Gb[m * 512 + h * 64 + lane]);
            const float s1 = wave_sum(o), s2 = wave_sum(o * o);
            const float mean = s1 * (1.f / 64.f), var = fmaxf(s2 * (1.f / 64.f) - mean * mean, 0.f);
            const float rk = __builtin_bit_cast(float, __builtin_amdgcn_readlane(__builtin_bit_cast(int, rkv), h));
            const float res = ((o - mean) * (1.f / sqrtf(var + 64e-5f)) * gn_g[h * 64 + lane] + gn_b[h * 64 + lane] + rk * vv) * gg;
            ACR[(size_t)m2 * 512 + h * 64 + lane] = f2bf_bits(res);
        }
    }
}

#define CE_DESC(x, y) do { const float _hi = fmaxf((x), (y)), _lo = fminf((x), (y)); (x) = _hi; (y) = _lo; } while (0)
__device__ __forceinline__ void sort16_desc(float (&v)[16]) {
#pragma unroll
    for (int k = 2; k <= 16; k <<= 1) {
#pragma unroll
        for (int j = k >> 1; j > 0; j >>= 1) {
#pragma unroll
            for (int i = 0; i < 16; ++i) { const int l = i ^ j; if (l > i) { if ((i & k) == 0) CE_DESC(v[i], v[l]); else CE_DESC(v[l], v[i]); } }
        }
    }
}
__device__ __forceinline__ void merge16(float (&x)[16], const float (&y)[16]) {
#pragma unroll
    for (int i = 0; i < 16; ++i) x[i] = fmaxf(x[i], y[15 - i]);
#pragma unroll
    for (int j = 8; j > 0; j >>= 1) {
#pragma unroll
        for (int i = 0; i < 16; ++i) { const int l = i ^ j; if (l > i) CE_DESC(x[i], x[l]); }
    }
}
__device__ __forceinline__ void xmerge16(float (&x)[16], int mask) {
    float y[16];
#pragma unroll
    for (int i = 0; i < 16; ++i) y[i] = __shfl_xor(x[i], mask);
    merge16(x, y);
}
__device__ __forceinline__ float pk_low(float x, unsigned code, unsigned keep_mask) { return __builtin_bit_cast(float, (__builtin_bit_cast(unsigned, x) & keep_mask) | code); }

__device__ __forceinline__ void p9_topk(const Args& a, LAS unsigned char* lds, int G, const int wave) {
    const int lane = pg8::get_lane(), tid = wave * 64 + lane;
    const bf16_t* Q = (const bf16_t*)(a.ws + WS_ZG); const bf16_t* SK = (const bf16_t*)(a.ws + WS_SK);
    int* TKid = (int*)(a.ws + WS_KK); float* TKg = (float*)(a.ws + WS_KK + 16 * MiB);
    LAS unsigned char* wl = lds + 65536 + wave * 512;
    const int fr = lane & 15, fq = lane >> 4;
    const bool aligned = (G % 8 == 0);
    const int nhb = aligned ? G / 8 : G, rank = aligned ? (int)(blockIdx.x >> 3) : (int)blockIdx.x;
    constexpr int NGRP = M2 / 16;
    for (int h = aligned ? (int)(blockIdx.x & 7) : 0; h < PH; h += aligned ? 8 : 1) {
        __syncthreads();
#pragma unroll
        for (int k = 0; k < 8; ++k) { const int pi = wave * 64 + lane + 512 * k, c = pi >> 11, row = (pi >> 4) & 127, pp = pi & 15;
            const u32x4 v = *(const u32x4*)(SK + ((size_t)(h * 2 + c) * 128 + row) * 128 + pp * 8);
            *(LAS u32x4*)(lds + c * 32768 + row * 256 + ((pp ^ (row & 15)) * 16)) = v; }
        __syncthreads();
    for (int grp = rank * NWAVES + wave; grp < NGRP; grp += nhb * NWAVES) {
        const int tok0 = grp * 16;
        float top[2][16];
#pragma unroll
        for (int c = 0; c < 2; ++c) {
            f32x4 acc[8];
#pragma unroll
            for (int nt = 0; nt < 8; ++nt) acc[nt] = (f32x4){0.f, 0.f, 0.f, 0.f};
            const bf16_t* qrow = Q + (size_t)(tok0 + fr) * 2048 + h * 256 + c * 128 + fq * 8;
            bf16x8 qf[4];
#pragma unroll
            for (int ks = 0; ks < 4; ++ks) qf[ks] = *(const bf16x8*)(qrow + ks * 32);
            const LAS unsigned char* skl = lds + c * 32768 + fr * 256;
#pragma unroll
            for (int nt = 0; nt < 8; ++nt)
#pragma unroll
                for (int ks = 0; ks < 4; ++ks) { const bf16x8 kf = *(const LAS bf16x8*)(skl + nt * 4096 + (((4 * ks + fq) ^ fr) * 16));
                    acc[nt] = __builtin_amdgcn_mfma_f32_16x16x32_bf16(kf, qf[ks], acc[nt], 0, 0, 0); }
            float lo[16], hi[16];
#pragma unroll
            for (int nt = 0; nt < 4; ++nt)
#pragma unroll
                for (int r = 0; r < 4; ++r) { lo[nt * 4 + r] = pk_low(acc[nt][r], (unsigned)(16 * nt + 4 * fq + r), 0xffffff80u); hi[nt * 4 + r] = pk_low(acc[nt + 4][r], (unsigned)(16 * (nt + 4) + 4 * fq + r), 0xffffff80u); }
            sort16_desc(lo); sort16_desc(hi); merge16(lo, hi); xmerge16(lo, 16); xmerge16(lo, 32);
#pragma unroll
            for (int i = 0; i < 16; ++i) top[c][i] = lo[i];
        }
        float cand[16];
        const float PAD = -3.0e38f;
#pragma unroll
        for (int s = 0; s < 16; ++s) {
            const int i1 = (s < 8) ? 1 : (s < 13) ? 2 : 4, j1 = (s < 8) ? s : (s < 13) ? s - 8 : s - 13;
            const int i2 = (s < 4) ? 3 : (s < 6) ? 5 : (s < 8) ? 6 : 7, j2 = (s < 4) ? s : (s < 6) ? s - 4 : (s < 8) ? s - 6 : s - 8;
            const float c0 = pk_low(top[0][0] + top[1][s], (unsigned)s, 0xffffff00u);
            const float c1 = pk_low(top[0][i1] + top[1][j1], (unsigned)(i1 * 16 + j1), 0xffffff00u);
            const float c2 = (s < 10) ? pk_low(top[0][i2] + top[1][j2], (unsigned)(i2 * 16 + j2), 0xffffff00u) : PAD;
            const float c3 = (s < 8) ? pk_low(top[0][8 + s] + top[1][0], (unsigned)((8 + s) * 16), 0xffffff00u) : PAD;
            cand[s] = (fq == 0) ? c0 : (fq == 1) ? c1 : (fq == 2) ? c2 : c3;
        }
        sort16_desc(cand); xmerge16(cand, 16); xmerge16(cand, 32);
        if (fq == 0) {
            u32x4 wa, wb; unsigned pa[4], pb[4];
#pragma unroll
            for (int g = 0; g < 4; ++g) { pa[g] = 0u; pb[g] = 0u;
#pragma unroll
                for (int j = 0; j < 4; ++j) { pa[g] |= (__builtin_bit_cast(unsigned, top[0][4 * g + j]) & 0x7fu) << (8 * j); pb[g] |= (__builtin_bit_cast(unsigned, top[1][4 * g + j]) & 0x7fu) << (8 * j); } }
            wa.x = pa[0]; wa.y = pa[1]; wa.z = pa[2]; wa.w = pa[3]; wb.x = pb[0]; wb.y = pb[1]; wb.z = pb[2]; wb.w = pb[3];
            *(LAS u32x4*)(wl + fr * 32) = wa; *(LAS u32x4*)(wl + fr * 32 + 16) = wb;
            LDS_WAIT();
            float p[16], sum = 0.f; int eid[16];
            const float mx = cand[0];
#pragma unroll
            for (int i = 0; i < 16; ++i) { p[i] = __expf(cand[i] - mx); sum += p[i];
                const unsigned code = __builtin_bit_cast(unsigned, cand[i]) & 0xffu;
                const int i1 = wl[fr * 32 + (code >> 4)], i2 = wl[fr * 32 + 16 + (code & 15u)];
                eid[i] = i1 * PK + i2; }
            const float inv = 1.f / sum;
            int* ip = TKid + (size_t)(tok0 + fr) * 128 + h * 16; float* gp = TKg + (size_t)(tok0 + fr) * 128 + h * 16;
#pragma unroll
            for (int g = 0; g < 4; ++g) { *(int4*)(ip + 4 * g) = make_int4(eid[4 * g], eid[4 * g + 1], eid[4 * g + 2], eid[4 * g + 3]);
                *(f32x4*)(gp + 4 * g) = (f32x4){p[4 * g] * inv, p[4 * g + 1] * inv, p[4 * g + 2] * inv, p[4 * g + 3] * inv}; }
            LDS_WAIT();
        }
    }
    }
}

typedef __bf16 bf16v2 __attribute__((ext_vector_type(2)));
__device__ __forceinline__ float dot2bf(unsigned x, unsigned y, float acc) { return __builtin_amdgcn_fdot2_f32_bf16(__builtin_bit_cast(bf16v2, x), __builtin_bit_cast(bf16v2, y), acc, false); }
__device__ __forceinline__ float gelu_exact(float x) { return 0.5f * x * (1.f + erff(x * 0.70710678118f)); }

typedef float f32x2 __attribute__((ext_vector_type(2)));
struct XcdPart { unsigned nloc, nx, rnk, kx; };
typedef long i64_t;
__device__ __forceinline__ i64_t pack64(unsigned lo, unsigned hi) { const u32x2 w = {lo, hi}; return __builtin_bit_cast(i64_t, w); }
__device__ __forceinline__ void pu_partial(const Args& a, LAS unsigned char* lds, const int wave, const XcdPart xp) {
    const int lane = pg8::get_lane(), j16 = lane & 15, kq = lane >> 4;
    const bf16_t* H1b = (const bf16_t*)(a.ws + WS_ZC); const int* TKid = (const int*)(a.ws + WS_KK); const float* ssq = (const float*)(a.ws + WS_SSQ);
    const unsigned char* EU = a.ws + WS_EU; bf16_t* PART = (bf16_t*)(a.ws + WS_ZG);
    const int t_first = (int)xp.rnk * NWAVES + wave, t_stride = (int)xp.nloc * NWAVES;
    const int nt = (t_first < M2) ? (M2 - t_first + t_stride - 1) / t_stride : 0;
    if (nt == 0) return;
    const __amdgpu_buffer_rsrc_t rP = __builtin_amdgcn_make_buffer_rsrc((void*)PART, 0, 0x7fffffff, 0x00020000);
    LAS unsigned char* wl = lds + wave * 16384; LAS unsigned char* xs = lds + 132096 + wave * 128; LAS unsigned char* la = lds + 133120 + wave * 1664;
    const int pz0 = ((lane & 7) ^ (lane >> 4)) * 16, pz1 = ((lane & 7) ^ (4 + (lane >> 4))) * 16;
    const int mm = (j16 >> 1) & 7, rob = (j16 >> 3) * 1024 + (j16 & 7) * 128;
    const int ro0 = rob + (((2 * kq) ^ mm) * 16), ro1 = rob + (((2 * kq + 1) ^ mm) * 16);
    const f32x4 z4 = {0.f, 0.f, 0.f, 0.f};
    for (int s = (int)xp.kx; s < 8; s += (int)xp.nx) {
        const unsigned char* EUs = EU + 128 * s;
        i64_t xc[4];
#define PU_X(j) do { const int jc_ = ((j) < nt) ? (j) : nt - 1; const int tk_ = t_first + jc_ * t_stride; LAS unsigned char* sl_ = la + ((j) & 1) * 832; \
            __builtin_amdgcn_global_load_lds((const unsigned*)(TKid + (size_t)tk_ * 128 + lane), (LAS unsigned*)sl_, 4, 0, 0); \
            __builtin_amdgcn_global_load_lds((const unsigned*)(TKid + (size_t)tk_ * 128 + 64 + lane), (LAS unsigned*)(sl_ + 256), 4, 0, 0); \
            __builtin_amdgcn_global_load_lds((const unsigned*)(H1b + (size_t)tk_ * 1024 + 128 * s + 2 * lane), (LAS unsigned*)(sl_ + 512), 4, 0, 0); \
            if (lane == 0) __builtin_amdgcn_global_load_lds((const unsigned*)(ssq + tk_), (LAS unsigned*)(sl_ + 768), 4, 0, 0); } while (0)
#define PU_X8(j) do { const LAS unsigned char* sl_ = la + ((j) & 1) * 832; const u32x4 X = *(const LAS u32x4*)(sl_ + 512 + 16 * j16); const float sq_ = *(const LAS float*)(sl_ + 768); \
            const float sc_ = 16.f * __builtin_amdgcn_rsqf(sq_ * (1.f / 1024.f) + 1e-6f); \
            int p0_ = 0, p1_ = 0; \
            p0_ = __builtin_amdgcn_cvt_pk_fp8_f32(bflo(X.x) * sc_, bfhi(X.x) * sc_, p0_, false); p0_ = __builtin_amdgcn_cvt_pk_fp8_f32(bflo(X.y) * sc_, bfhi(X.y) * sc_, p0_, true); \
            p1_ = __builtin_amdgcn_cvt_pk_fp8_f32(bflo(X.z) * sc_, bfhi(X.z) * sc_, p1_, false); p1_ = __builtin_amdgcn_cvt_pk_fp8_f32(bflo(X.w) * sc_, bfhi(X.w) * sc_, p1_, true); \
            *(LAS u32x2*)(xs + 8 * j16) = (u32x2){(unsigned)p0_, (unsigned)p1_}; LDS_WAIT(); asm volatile("" ::: "memory"); \
            const u32x4 xa_ = *(const LAS u32x4*)(xs + 32 * kq), xb_ = *(const LAS u32x4*)(xs + 32 * kq + 16); LDS_WAIT(); asm volatile("" ::: "memory"); \
            xc[0] = pack64(xa_.x, xa_.y); xc[1] = pack64(xa_.z, xa_.w); xc[2] = pack64(xb_.x, xb_.y); xc[3] = pack64(xb_.z, xb_.w); } while (0)
#define PU_Q(j, c) do { const LAS unsigned char* sl_ = la + ((j) & 1) * 832; _Pragma("unroll") for (int w_ = 0; w_ < 4; ++w_) { \
            const unsigned id_ = *(const LAS unsigned*)(sl_ + 4 * (32 * (c) + 8 * w_ + (lane >> 3))); \
            const unsigned char* gp_ = EUs + ((size_t)id_ << 10) + ((w_ & 1) ? pz1 : pz0); \
            __builtin_amdgcn_global_load_lds((const unsigned*)gp_, (LAS unsigned*)(wl + (c) * 4096 + w_ * 1024), 16, 0, 1); } } while (0)
#define PU_G(ACC, P0, P1) do { ACC = __builtin_amdgcn_mfma_f32_16x16x32_fp8_fp8(xc[0], pack64(P0.x, P0.y), z4, 0, 0, 0); ACC = __builtin_amdgcn_mfma_f32_16x16x32_fp8_fp8(xc[1], pack64(P0.z, P0.w), ACC, 0, 0, 0); \
            ACC = __builtin_amdgcn_mfma_f32_16x16x32_fp8_fp8(xc[2], pack64(P1.x, P1.y), ACC, 0, 0, 0); ACC = __builtin_amdgcn_mfma_f32_16x16x32_fp8_fp8(xc[3], pack64(P1.z, P1.w), ACC, 0, 0, 0); } while (0)
#define PU_C(ACC0, ACC1, c) do { asm volatile("s_waitcnt vmcnt(16)" ::: "memory"); \
            const u32x4 a0_ = *(const LAS u32x4*)(wl + (c) * 4096 + ro0), a1_ = *(const LAS u32x4*)(wl + (c) * 4096 + ro1), b0_ = *(const LAS u32x4*)(wl + (c) * 4096 + 2048 + ro0), b1_ = *(const LAS u32x4*)(wl + (c) * 4096 + 2048 + ro1); \
            LDS_WAIT(); asm volatile("" ::: "memory");        \
            PU_G(ACC0, a0_, a1_); PU_G(ACC1, b0_, b1_); } while (0)
        PU_X(0); PU_X(1);
        asm volatile("s_waitcnt vmcnt(0)" ::: "memory");
        PU_X8(0);
        PU_Q(0, 0); PU_Q(0, 1); PU_Q(0, 2); PU_Q(0, 3);
        for (int j = 0; j < nt; ++j) {
            PU_X(j + 2);
            f32x4 c0, c1, c2, c3, c4, c5, c6, c7;
            PU_C(c0, c1, 0); PU_Q(j + 1, 0);
            PU_C(c2, c3, 1); PU_Q(j + 1, 1);
            PU_C(c4, c5, 2); PU_Q(j + 1, 2);
            PU_C(c6, c7, 3); PU_Q(j + 1, 3);
            { const float v0 = (kq == 0) ? c0[0] : (kq == 1) ? c1[0] : (kq == 2) ? c2[0] : c3[0], v1 = (kq == 0) ? c4[0] : (kq == 1) ? c5[0] : (kq == 2) ? c6[0] : c7[0];
              const int so_ = (s * M2 + t_first + j * t_stride) * 256;
              __builtin_amdgcn_raw_buffer_store_b16(f2bf_bits(v0), rP, 2 * lane, so_, 0); __builtin_amdgcn_raw_buffer_store_b16(f2bf_bits(v1), rP, 2 * lane + 128, so_, 0); }
            PU_X8(j + 1);
        }
        asm volatile("s_waitcnt vmcnt(0)" ::: "memory");
#undef PU_C
#undef PU_G
#undef PU_Q
#undef PU_X8
#undef PU_X
    }
}
__device__ __forceinline__ void pc_combine(const Args& a, int G, const int wave) {
    const int lane = pg8::get_lane();
    const int* TKid = (const int*)(a.ws + WS_KK); const float* TKg = (const float*)(a.ws + WS_KK + 16 * MiB); const bf16_t* PART = (const bf16_t*)(a.ws + WS_ZG); bf16_t* CFb = (bf16_t*)(a.ws + WS_A2);
    const float* SU = (const float*)(a.ws + WS_EU + 16 * MiB); const float* SV = (const float*)(a.ws + WS_EV + 16 * MiB);
    const int gt = blockIdx.x * NTHR + wave * 64 + lane, NGT = G * NTHR;
    for (int idx0 = gt; idx0 < M2 * 128; idx0 += 4 * NGT) {
        int id[4]; float gt4[4], sm[4], su[4], sv[4];
#pragma unroll
        for (int u = 0; u < 4; ++u) { const int idx = idx0 + u * NGT; const int ic = (idx < M2 * 128) ? idx : idx0;
            id[u] = TKid[ic]; gt4[u] = TKg[ic];
            unsigned short pr[8];
#pragma unroll
            for (int sl = 0; sl < 8; ++sl) pr[sl] = PART[(size_t)sl * M2 * 128 + ic];
            float s = 0.f;
#pragma unroll
            for (int sl = 0; sl < 8; ++sl) s += bf2f(pr[sl]);
            sm[u] = s; }
#pragma unroll
        for (int u = 0; u < 4; ++u) { su[u] = SU[id[u]]; sv[u] = SV[id[u]]; }
#pragma unroll
        for (int u = 0; u < 4; ++u) { const int idx = idx0 + u * NGT;
            if (idx < M2 * 128) CFb[idx] = f2bf_bits(gt4[u] * gelu_exact(sm[u] * (1.f / 16.f) * su[u]) * sv[u]); }
    }
}
__device__ __forceinline__ float wave_max_nn(float x) {
#define DPP_MAXNN(x, ctrl) fmaxf((x), __builtin_bit_cast(float, __builtin_amdgcn_update_dpp(0, __builtin_bit_cast(int, (x)), (ctrl), 0xf, 0xf, true)))
    x = DPP_MAXNN(x, 0xB1); x = DPP_MAXNN(x, 0x4E); x = DPP_MAXNN(x, 0x141); x = DPP_MAXNN(x, 0x140);
#undef DPP_MAXNN
    const int xi = __builtin_bit_cast(int, x);
    const float a = __builtin_bit_cast(float, __builtin_amdgcn_readlane(xi, 0)), b = __builtin_bit_cast(float, __builtin_amdgcn_readlane(xi, 16)), c = __builtin_bit_cast(float, __builtin_amdgcn_readlane(xi, 32)), d = __builtin_bit_cast(float, __builtin_amdgcn_readlane(xi, 48));
    return fmaxf(fmaxf(a, b), fmaxf(c, d));
}
typedef int v2i_t __attribute__((ext_vector_type(2)));
__device__ __forceinline__ void pv_output(const Args& a, LAS unsigned char* lds, const int wave, const XcdPart xp) {
    const int lane = pg8::get_lane(), kq = lane >> 4;
    const int* TKid = (const int*)(a.ws + WS_KK); const bf16_t* CFb = (const bf16_t*)(a.ws + WS_A2);
    const unsigned char* EV = a.ws + WS_EV; bf16_t* Y = (bf16_t*)(a.ws + WS_ZG);
    const int t_first = (int)xp.rnk * NWAVES + wave, t_stride = (int)xp.nloc * NWAVES;
    const int nt = (t_first < M2) ? (M2 - t_first + t_stride - 1) / t_stride : 0;
    if (nt == 0) return;
    const __amdgpu_buffer_rsrc_t rY = __builtin_amdgcn_make_buffer_rsrc((void*)Y, 0, 0x7fffffff, 0x00020000);
    LAS unsigned char* wl = lds + wave * 16384; LAS unsigned char* cv = lds + 131328 + wave * 128; LAS unsigned char* la = lds + 132352 + wave * 1536;
    const int pz0 = ((lane & 7) ^ (lane >> 4)) * 16, pz1 = ((lane & 7) ^ (4 + (lane >> 4))) * 16;
    const int q = (lane & 15) >> 1, jj = 8 * (kq & 1) + q, mm = (jj >> 1) & 7;
    const int trb = (kq >> 1) * 2048 + (jj >> 3) * 1024 + (jj & 7) * 128 + 8 * (lane & 1);
    for (int s = (int)xp.kx; s < 8; s += (int)xp.nx) {
        const unsigned char* EVs = EV + 128 * s;
        i64_t cf[4]; float yinv;
#define PV_X(j) do { const int jc_ = ((j) < nt) ? (j) : nt - 1; const int tk_ = t_first + jc_ * t_stride; LAS unsigned char* sl_ = la + ((j) & 1) * 768; \
            __builtin_amdgcn_global_load_lds((const unsigned*)(TKid + (size_t)tk_ * 128 + lane), (LAS unsigned*)sl_, 4, 0, 0); \
            __builtin_amdgcn_global_load_lds((const unsigned*)(TKid + (size_t)tk_ * 128 + 64 + lane), (LAS unsigned*)(sl_ + 256), 4, 0, 0); \
            __builtin_amdgcn_global_load_lds((const unsigned*)(CFb + (size_t)tk_ * 128 + 2 * lane), (LAS unsigned*)(sl_ + 512), 4, 0, 0); } while (0)
#define PV_CF(j) do { const LAS unsigned char* sl_ = la + ((j) & 1) * 768; const unsigned w_ = *(const LAS unsigned*)(sl_ + 512 + 4 * lane); const float c0_ = bflo(w_), c1_ = bfhi(w_); \
            const float m_ = fmaxf(wave_max_nn(fmaxf(fabsf(c0_), fabsf(c1_))), 1e-30f); const float sc_ = 256.f * __builtin_amdgcn_rcpf(m_); yinv = m_ * (1.f / 256.f); \
            const int p_ = __builtin_amdgcn_cvt_pk_fp8_f32(c0_ * sc_, c1_ * sc_, 0, false); \
            *(LAS unsigned short*)(cv + 2 * lane) = (unsigned short)(p_ & 0xffff); LDS_WAIT(); asm volatile("" ::: "memory"); \
            _Pragma("unroll") for (int k_ = 0; k_ < 4; ++k_) cf[k_] = *(const LAS i64_t*)(cv + 32 * k_ + 8 * kq); \
            LDS_WAIT(); asm volatile("" ::: "memory"); } while (0)
#define PV_Q(j, c) do { const LAS unsigned char* sl_ = la + ((j) & 1) * 768; _Pragma("unroll") for (int w_ = 0; w_ < 4; ++w_) { \
            const unsigned id_ = *(const LAS unsigned*)(sl_ + 4 * (32 * (c) + 8 * w_ + (lane >> 3))); \
            const unsigned char* gp_ = EVs + ((size_t)id_ << 10) + ((w_ & 1) ? pz1 : pz0); \
            __builtin_amdgcn_global_load_lds((const unsigned*)gp_, (LAS unsigned*)(wl + (c) * 4096 + w_ * 1024), 16, 0, 1); } } while (0)
#define PV_C(c) do { asm volatile("s_waitcnt vmcnt(15)" ::: "memory"); v2i_t b_[8]; \
            _Pragma("unroll") for (int n_ = 0; n_ < 8; ++n_) b_[n_] = __builtin_amdgcn_ds_read_tr8_b64_v2i32((LAS v2i_t*)(wl + (c) * 4096 + trb + ((n_ ^ mm) * 16))); \
            LDS_WAIT(); asm volatile("" ::: "memory");        \
            _Pragma("unroll") for (int n_ = 0; n_ < 8; ++n_) acc[n_] = __builtin_amdgcn_mfma_f32_16x16x32_fp8_fp8(cf[c], __builtin_bit_cast(i64_t, b_[n_]), acc[n_], 0, 0, 0); } while (0)
        PV_X(0); PV_X(1);
        asm volatile("s_waitcnt vmcnt(0)" ::: "memory");
        PV_CF(0);
        PV_Q(0, 0); PV_Q(0, 1); PV_Q(0, 2); PV_Q(0, 3);
        for (int j = 0; j < nt; ++j) {
            PV_X(j + 2);
            f32x4 acc[8];
#pragma unroll
            for (int n_ = 0; n_ < 8; ++n_) acc[n_] = (f32x4){0.f, 0.f, 0.f, 0.f};
            PV_C(0); PV_Q(j + 1, 0);
            PV_C(1); PV_Q(j + 1, 1);
            PV_C(2); PV_Q(j + 1, 2);
            PV_C(3); PV_Q(j + 1, 3);
            { const float v0 = ((kq == 0) ? acc[0][0] : (kq == 1) ? acc[1][0] : (kq == 2) ? acc[2][0] : acc[3][0]) * yinv, v1 = ((kq == 0) ? acc[4][0] : (kq == 1) ? acc[5][0] : (kq == 2) ? acc[6][0] : acc[7][0]) * yinv;
              const int so_ = (t_first + j * t_stride) * 2048 + 256 * s;
              __builtin_amdgcn_raw_buffer_store_b16(f2bf_bits(v0), rY, 2 * lane, so_, 0); __builtin_amdgcn_raw_buffer_store_b16(f2bf_bits(v1), rY, 2 * lane + 128, so_, 0); }
            PV_CF(j + 1);
        }
        asm volatile("s_waitcnt vmcnt(0)" ::: "memory");
#undef PV_C
#undef PV_Q
#undef PV_CF
#undef PV_X
    }
}
__device__ __forceinline__ void pf_final(const Args& a, int G, const int wave) {
    const int lane = pg8::get_lane();
    float* OUT = a.out; const bf16_t* H1b = (const bf16_t*)(a.ws + WS_ZC); const bf16_t* Y = (const bf16_t*)(a.ws + WS_ZG); const float* gfin = a.in[27];
    const int gw = blockIdx.x * NWAVES + wave, NGW = G * NWAVES;
    f32x4 g[4];
#pragma unroll
    for (int q = 0; q < 4; ++q) g[q] = *(const f32x4*)(gfin + 16 * lane + 4 * q);
    u32x4 hn0, hn1, yn0, yn1;
#define PF_LOAD(tok) do { hn0 = *(const u32x4*)(H1b + (size_t)(tok) * 1024 + 16 * lane); hn1 = *(const u32x4*)(H1b + (size_t)(tok) * 1024 + 16 * lane + 8); \
        yn0 = *(const u32x4*)(Y + (size_t)(tok) * 1024 + 16 * lane); yn1 = *(const u32x4*)(Y + (size_t)(tok) * 1024 + 16 * lane + 8); } while (0)
    if (gw < M2) PF_LOAD(gw);
    for (int tok = gw; tok < M2; tok += NGW) {
        const u32x4 h0 = hn0, h1 = hn1, y0 = yn0, y1 = yn1;
        { const int tn = (tok + NGW < M2) ? tok + NGW : tok; PF_LOAD(tn); }
        f32x4 h[4];
        h[0] = (f32x4){bflo(h0.x) + bflo(y0.x), bfhi(h0.x) + bfhi(y0.x), bflo(h0.y) + bflo(y0.y), bfhi(h0.y) + bfhi(y0.y)};
        h[1] = (f32x4){bflo(h0.z) + bflo(y0.z), bfhi(h0.z) + bfhi(y0.z), bflo(h0.w) + bflo(y0.w), bfhi(h0.w) + bfhi(y0.w)};
        h[2] = (f32x4){bflo(h1.x) + bflo(y1.x), bfhi(h1.x) + bfhi(y1.x), bflo(h1.y) + bflo(y1.y), bfhi(h1.y) + bfhi(y1.y)};
        h[3] = (f32x4){bflo(h1.z) + bflo(y1.z), bfhi(h1.z) + bfhi(y1.z), bflo(h1.w) + bflo(y1.w), bfhi(h1.w) + bfhi(y1.w)};
        float s = 0.f;
#pragma unroll
        for (int q = 0; q < 4; ++q) s += (h[q][0] * h[q][0] + h[q][1] * h[q][1]) + (h[q][2] * h[q][2] + h[q][3] * h[q][3]);
        const float rf = __builtin_amdgcn_rsqf(wave_sum(s) * (1.f / 1024.f) + 1e-6f);
        float* op = OUT + (size_t)tok * 1024 + 16 * lane;
#pragma unroll
        for (int q = 0; q < 4; ++q) *(f32x4*)(op + 4 * q) = h[q] * rf * g[q];
    }
#undef PF_LOAD
}

#define XB_TMO      128
#define XB_XCNT(j)  (256  + 64 * (j))
#define XB_XSUB(j)  (1280 + 64 * (j))
#define XB_XGEN(j)  (2304 + 64 * (j))
#define XB_TOP      3328
#define XB_TOPGEN   3392
#define XCD_BAR_WORDS 3456
#define XB_SPIN_CAP (1u << 23)
__device__ __forceinline__ unsigned xb_ld(unsigned* p)              { return __hip_atomic_load(p, __ATOMIC_RELAXED, __HIP_MEMORY_SCOPE_AGENT); }
__device__ __forceinline__ unsigned xb_add(unsigned* p, unsigned v) { return __hip_atomic_fetch_add(p, v, __ATOMIC_RELAXED, __HIP_MEMORY_SCOPE_AGENT); }
__device__ __forceinline__ unsigned xb_xcc_id() { return (unsigned)__builtin_amdgcn_s_getreg((3 << 11) | 20) & 0xFu; }
#define XB_SPIN(cond, bar) do { unsigned _sp = 0; while (cond) { __builtin_amdgcn_s_sleep(1); \
    if ((++_sp & 255u) == 0u) { if (xb_ld(&(bar)[XB_TMO])) break; if (_sp > XB_SPIN_CAP) { atomicAdd(&(bar)[XB_TMO], 1u); break; } } } } while (0)
struct XcdBarrier { unsigned* bar; unsigned x; volatile LAS unsigned* st; };
__device__ __forceinline__ void xcd_barrier_complete(unsigned* bar, unsigned x, unsigned G, unsigned& nloc, unsigned& nx, unsigned& below) {
    unsigned sum, cnt, mine, sp = 0u;
    for (;;) {
        sum = 0u; cnt = 0u; mine = 0u; below = 0u;
#pragma unroll
        for (unsigned j = 0; j < 16; ++j) { const unsigned c = xb_ld(&bar[XB_XCNT(j)]); sum += c; cnt += (c > 0u) ? 1u : 0u; mine = (j == x) ? c : mine; below += (j < x && c > 0u) ? 1u : 0u; }
        if (sum == G) break;
        __builtin_amdgcn_s_sleep(1);
        if ((++sp & 255u) == 0u) { if (xb_ld(&bar[XB_TMO])) break; if (sp > XB_SPIN_CAP) { atomicAdd(&bar[XB_TMO], 1u); break; } }
    }
    nloc = mine > 0u ? mine : 1u; nx = cnt > 0u ? cnt : 1u;
}
__device__ __forceinline__ void xcd_barrier(const XcdBarrier& b, const bool t0, const unsigned G) {
    asm volatile("s_waitcnt vmcnt(0)" ::: "memory");
    __syncthreads();
    if (t0) {
        unsigned* bar = b.bar;
        __builtin_amdgcn_s_waitcnt(0);
        unsigned nloc = b.st[0], nx = b.st[1];
        if (nloc == 0u) { unsigned below; xcd_barrier_complete(bar, b.x, G, nloc, nx, below); b.st[0] = nloc; b.st[1] = nx; b.st[3] = below; }
        const unsigned old = xb_add(&bar[XB_XSUB(b.x)], 1u);
        const unsigned gen = old / nloc;
        if (old + 1u == (gen + 1u) * nloc) {
            __builtin_amdgcn_fence(__ATOMIC_RELEASE, "agent");
            asm volatile("s_waitcnt vmcnt(0)" ::: "memory");
            const unsigned og = xb_add(&bar[XB_TOP], 1u);
            const unsigned tg = og / nx;
            if (og + 1u == (tg + 1u) * nx) xb_add(&bar[XB_TOPGEN], 1u);
            else XB_SPIN(xb_ld(&bar[XB_TOPGEN]) == tg, bar);
            __builtin_amdgcn_fence(__ATOMIC_ACQUIRE, "agent");
            xb_add(&bar[XB_XGEN(b.x)], 1u);
            asm volatile("s_waitcnt vmcnt(0)" ::: "memory");
        } else {
            XB_SPIN(xb_ld(&bar[XB_XGEN(b.x)]) == gen, bar);
            __builtin_amdgcn_fence(__ATOMIC_ACQUIRE, "agent");
            asm volatile("s_waitcnt vmcnt(0)" ::: "memory");
        }
    }
    __syncthreads();
}
constexpr size_t WS_BAR = 64 * 1024;
constexpr int LDS_BAR_OFF = 131072;

#if defined(MK_DUP_PH) && MK_DUP_PH == 5
#define MK_REP5 2
#else
#define MK_REP5 1
#endif
#if defined(MK_DUP_PH) && MK_DUP_PH == 7
#define MK_REP7 2
#else
#define MK_REP7 1
#endif
constexpr int NPH = 13;
__global__ void __launch_bounds__(NTHR, 2) fwd_kernel(Args a) {
    __shared__ __attribute__((aligned(16))) unsigned char lds_raw[LDS_BYTES];
    LAS unsigned char* lds = (LAS unsigned char*)lds_raw;
    const int G = gridDim.x;
    const int wave_s = __builtin_amdgcn_readfirstlane((int)threadIdx.x >> 6);
    const int lo = a.ph_lo, hi = a.ph_hi;
#define IN(k) (lo <= (k) && (k) < hi)
#if MK_ONE_LAUNCH
    XcdBarrier xbar; xbar.bar = (unsigned*)(a.ws + WS_BAR); xbar.st = (volatile LAS unsigned*)(lds + LDS_BAR_OFF); xbar.x = xb_xcc_id();
    { const int lane0 = pg8::get_lane(); if (wave_s == 0 && lane0 < 4) xbar.st[lane0] = 0u; __syncthreads(); if (wave_s == 0 && lane0 == 0) xbar.st[2] = xb_add(&xbar.bar[XB_XCNT(xbar.x)], 1u); }
#define SEAM(k) do { if (IN(k) && IN((k) + 1)) { if ((k) == 0) cg::this_grid().sync(); else { const bool t0_ = (wave_s == 0) && (pg8::get_lane() == 0); xcd_barrier(xbar, t0_, (unsigned)G); } } } while (0)
#else
#define SEAM(k) do { } while (0)
#endif
#if defined(MK_PROBE_PH)
    volatile LAS unsigned long long* stamps = (volatile LAS unsigned long long*)(lds + LDS_BAR_OFF + 64);
#define STAMP(i) do { if (blockIdx.x == 0 && wave_s == 0 && pg8::get_lane() == 0) stamps[(i)] = __builtin_amdgcn_s_memrealtime(); } while (0)
#else
#define STAMP(i) do { } while (0)
#endif
    STAMP(0);
    unsigned char* ws = a.ws;
    bf16_t* XN = (bf16_t*)(ws + WS_XN);
    const bool late_p0 = (G > NB * NHEAD);
    if (IN(0)) { if (late_p0) p0_prologue<0>(a, lds, (int)blockIdx.x, G, wave_s); else p0_prologue<2>(a, lds, (int)blockIdx.x, G, wave_s); } SEAM(0); STAMP(1);
    constexpr int NZ_LATE = 4;
    const int nz_early = late_p0 ? (INTOT / 256 - NZ_LATE) : INTOT / 256;
    if (IN(1)) {
        pg8::Gemm g{XN, (const bf16_t*)(ws + WS_WIN), MP, nz_early * 256, 1024, 1024, 1024}; pg8::StaticOrder S; S.init(MP, nz_early * 256, G, (int)blockIdx.x);
        pg8::EpiZ E{(bf16_t*)(ws + WS_ZC), (bf16_t*)(ws + WS_ZR), (bf16_t*)(ws + WS_ZG), 0};
        pg8::gemm_phase<pg8::EpiZ, pg8::StaticOrder, true, true>(lds, g, S, E, wave_s);
    } SEAM(1); STAMP(2);
#if defined(MK_DUP_PH) && MK_DUP_PH == 2
    if (IN(2)) { p2_conv(a, lds, G, wave_s, false); p2_lorag(a, G, wave_s); __syncthreads(); }
#endif
#if defined(MK_DUP_PH) && MK_DUP_PH == 21
    if (IN(2)) { p2_conv(a, lds, G, wave_s, false); __syncthreads(); }
#endif
    const bool split_tail = (G >= 64) && (G % 8 == 0);
    if (IN(2)) { p2_conv(a, lds, G, wave_s, split_tail);
        if (split_tail && (int)blockIdx.x >= G - NB) { __syncthreads(); p4a_fused<true>(a, lds, G, wave_s, (int)blockIdx.x - (G - NB)); }
        p2_lorag(a, G, wave_s); __syncthreads(); }
#if defined(MK_DUP_PH) && MK_DUP_PH == 43
    if (IN(4)) { p4a_fused<false>(a, lds, G, wave_s, 0); __syncthreads(); }
#endif
    if (IN(4)) { p4a_fused<false>(a, lds, G, wave_s, 0); if (!split_tail) { for (int tb_ = (int)blockIdx.x; tb_ < NB; tb_ += G) { __syncthreads(); p4a_fused<true>(a, lds, G, wave_s, tb_); } } }
#if MK_ONE_LAUNCH
    if (IN(4)) { const bool t0_ = (wave_s == 0) && (pg8::get_lane() == 0); xcd_barrier(xbar, t0_, (unsigned)G); }
#endif
#if defined(MK_DUP_PH) && MK_DUP_PH == 41
    if (IN(4)) { p4b_chain(a, lds, G, wave_s); __syncthreads(); }
#endif
#define G_GEMM(VG, VB) do { pg8::Gemm gg_{(const bf16_t*)(ws + WS_A2), (const bf16_t*)(ws + WS_WSM) + (size_t)1024 * 256 + 128, MP, 512, 128, 128, 256}; pg8::StaticOrder Sg_; Sg_.init(MP, 512, (VG), (VB)); \
        pg8::EpiG Eg_{(bf16_t*)(ws + WS_ZR + 33 * MiB)}; pg8::gemm_phase<pg8::EpiG, pg8::StaticOrder, true, true>(lds, gg_, Sg_, Eg_, wave_s); } while (0)
    if (IN(4)) {
        if (!late_p0) { G_GEMM(G, (int)blockIdx.x); __syncthreads(); }
        if ((int)blockIdx.x < NB * NHEAD || !late_p0) p4b_chain(a, lds, G, wave_s);
        else {
            G_GEMM(G - NB * NHEAD, (int)blockIdx.x - NB * NHEAD); __syncthreads();
            p0_prologue<1>(a, lds, (int)blockIdx.x - NB * NHEAD, G - NB * NHEAD, wave_s);
            __syncthreads();
            pg8::Gemm g{XN, (const bf16_t*)(ws + WS_WIN) + (size_t)nz_early * 256 * 1024, MP, NZ_LATE * 256, 1024, 1024, 1024}; pg8::StaticOrder S; S.init(MP, NZ_LATE * 256, G - NB * NHEAD, (int)blockIdx.x - NB * NHEAD);
            pg8::EpiZ E{(bf16_t*)(ws + WS_ZC), (bf16_t*)(ws + WS_ZR), (bf16_t*)(ws + WS_ZG), nz_early};
            pg8::gemm_phase<pg8::EpiZ, pg8::StaticOrder, true, true>(lds, g, S, E, wave_s);
        }
    }
#if MK_ONE_LAUNCH
    if (IN(4)) { const bool t0_ = (wave_s == 0) && (pg8::get_lane() == 0); xcd_barrier(xbar, t0_, (unsigned)G); }
#endif
#if defined(MK_DUP_PH) && MK_DUP_PH == 42
    if (IN(4)) { p4c_post(a, G, wave_s); __syncthreads(); }
#endif
    if (IN(4)) { p4c_post(a, G, wave_s); } SEAM(4); STAMP(5);
#if defined(MK_DUP_PH) && MK_DUP_PH == 99 && MK_ONE_LAUNCH
    { const bool t0_ = (wave_s == 0) && (pg8::get_lane() == 0); for (int r_ = 0; r_ < 10; ++r_) xcd_barrier(xbar, t0_, (unsigned)G); }
#endif
    for (int rep_ = 0; rep_ < MK_REP5; ++rep_)
    if (IN(5)) {
        bf16_t* Mx = (bf16_t*)(ws + WS_ZR); const bf16_t* Zg = (const bf16_t*)(ws + WS_ZG);
        pg8::Gemm g{(const bf16_t*)(ws + WS_ACL), (const bf16_t*)(ws + WS_WCR), M2, 1024, 1024, 512, 1024, (const bf16_t*)(ws + WS_XN)}; pg8::StaticOrder S; S.init(M2, 1024, G, (int)blockIdx.x);
        pg8::EpiMixF E{Mx, Zg}; pg8::gemm_phase<pg8::EpiMixF, pg8::StaticOrder, true, true>(lds, g, S, E, wave_s);
    } SEAM(5); STAMP(6);
#if defined(MK_DUP_PH) && MK_DUP_PH == 6
    if (IN(6)) {
        pg8::Gemm g{(const bf16_t*)(ws + WS_ZR), (const bf16_t*)(ws + WS_WO), M2, 1024, 1024, 1024, 1024}; pg8::StaticOrder S; S.init(M2, 1024, G, (int)blockIdx.x);
        pg8::EpiH1 E{a.in[0], a.out, (bf16_t*)(ws + WS_ZC), (float*)(ws + WS_CTL + 768 * 1024)};
        pg8::gemm_phase<pg8::EpiH1, pg8::StaticOrder, true, true>(lds, g, S, E, wave_s); __syncthreads();
    }
#endif
    if (IN(6)) {
        pg8::Gemm g{(const bf16_t*)(ws + WS_ZR), (const bf16_t*)(ws + WS_WO), M2, 1024, 1024, 1024, 1024}; pg8::StaticOrder S; S.init(M2, 1024, G, (int)blockIdx.x);
        pg8::EpiH1 E{a.in[0], a.out, (bf16_t*)(ws + WS_ZC), (float*)(ws + WS_SSQ)};
        pg8::gemm_phase<pg8::EpiH1, pg8::StaticOrder, true, true>(lds, g, S, E, wave_s);
    } SEAM(6); STAMP(7);
    for (int rep_ = 0; rep_ < MK_REP7; ++rep_)
    if (IN(7)) {
        pg8::Gemm g{(const bf16_t*)(ws + WS_ZC), (const bf16_t*)(ws + WS_WQ), M2, 2048, 1024, 1024, 1024}; pg8::StaticOrder S; S.init(M2, 2048, G, (int)blockIdx.x);
        pg8::EpiQ E{(bf16_t*)(ws + WS_ZG), (const float*)(ws + WS_SSQ)};
        pg8::gemm_phase<pg8::EpiQ, pg8::StaticOrder, true, true>(lds, g, S, E, wave_s);
    } SEAM(7); STAMP(8);
#if defined(MK_DUP_PH) && MK_DUP_PH == 8
    if (IN(8)) { p9_topk(a, lds, G, wave_s); __syncthreads(); }
#endif
    if (IN(8)) { p9_topk(a, lds, G, wave_s); } SEAM(8); STAMP(9);
    XcdPart xp;
#if MK_ONE_LAUNCH
    xp.nloc = __builtin_amdgcn_readfirstlane(xbar.st[0]); xp.nx = __builtin_amdgcn_readfirstlane(xbar.st[1]); xp.rnk = __builtin_amdgcn_readfirstlane(xbar.st[2]); xp.kx = __builtin_amdgcn_readfirstlane(xbar.st[3]);
    if (xp.nloc == 0u || xp.nx == 0u) { xp.nloc = (unsigned)G; xp.nx = 1u; xp.rnk = blockIdx.x; xp.kx = 0u; }
#else
    xp.nloc = (unsigned)G; xp.nx = 1u; xp.rnk = blockIdx.x; xp.kx = 0u;
#endif
#if defined(MK_DUP_PH) && MK_DUP_PH == 9
    if (IN(9)) { pu_partial(a, lds, wave_s, xp); __syncthreads(); }
#endif
    if (IN(9)) { pu_partial(a, lds, wave_s, xp); } SEAM(9);
    if (IN(10)) { pc_combine(a, G, wave_s); } SEAM(10);
#if defined(MK_DUP_PH) && MK_DUP_PH == 11
    if (IN(11)) { pv_output(a, lds, wave_s, xp); __syncthreads(); }
#endif
    if (IN(11)) { pv_output(a, lds, wave_s, xp); } SEAM(11);
    if (IN(12)) { pf_final(a, G, wave_s); }
#if defined(MK_PROBE_PH)
    STAMP(10);
    if (blockIdx.x == 0 && wave_s == 0 && pg8::get_lane() == 0) { asm volatile("s_waitcnt vmcnt(0) lgkmcnt(0)" ::: "memory"); const float us = (float)(stamps[MK_PROBE_PH + 1] - stamps[MK_PROBE_PH]) * 0.01f; a.out[0] += us; }
#endif
#undef IN
#undef SEAM
}

extern "C" void kernel_launch(void* const* d_in, const int* in_sizes, int n_in, void* d_out, int out_size, void* d_ws, size_t ws_size, hipStream_t stream) {
    static int grid = 0;
    if (grid == 0) {
        if (n_in != 28 || out_size != M2 * D || ws_size < WS_END) { fprintf(stderr, "kernel_launch: unexpected shapes (n_in %d out %d ws %zu)\n", n_in, out_size, ws_size); grid = -1; return; }
        int dev = 0, cus = 0, per_cu = 0;
        if (hipGetDevice(&dev) != hipSuccess || hipDeviceGetAttribute(&cus, hipDeviceAttributeMultiprocessorCount, dev) != hipSuccess) { grid = -1; return; }
        if (hipOccupancyMaxActiveBlocksPerMultiprocessor(&per_cu, (const void*)fwd_kernel, NTHR, 0) != hipSuccess || per_cu < 1) { fprintf(stderr, "kernel_launch: occupancy query says %d blocks per CU\n", per_cu); (void)hipGetLastError(); grid = -1; return; }
        grid = cus;
    }
    if (grid < 0) return;
    (void)hipMemsetAsync((char*)d_ws + WS_CTL, 0, CTL_ZERO_BYTES, stream);
    Args a{};
    for (int i = 0; i < 28; ++i) a.in[i] = (const float*)d_in[i];
    a.out = (float*)d_out; a.ws = (unsigned char*)d_ws;
#if MK_ONE_LAUNCH
    a.ph_lo = 0; a.ph_hi = NPH;
    void* args[] = {&a};
    hipError_t e = hipLaunchCooperativeKernel((const void*)fwd_kernel, dim3(grid), dim3(NTHR), args, 0, stream);
    if (e != hipSuccess) fprintf(stderr, "kernel_launch: cooperative launch failed: %s (grid %d)\n", hipGetErrorString(e), grid);
#else
#ifndef MK_PH_HI
#define MK_PH_HI NPH
#endif
#ifndef MK_PH_LO
#define MK_PH_LO 0
#endif
    for (int ph = MK_PH_LO; ph < MK_PH_HI; ++ph) { a.ph_lo = ph; a.ph_hi = ph + 1; hipLaunchKernelGGL(fwd_kernel, dim3(grid), dim3(NTHR), 0, stream, a); }
#endif
}
```

```cpp
#include <hip/hip_runtime.h>
#include <hip/hip_cooperative_groups.h>
#include <cstdio>
#include <cstdint>
namespace cg = cooperative_groups;

#ifndef MK_ONE_LAUNCH
#define MK_ONE_LAUNCH 1
#endif

#define LAS __attribute__((address_space(3)))
#define LDS_WAIT() asm volatile("s_waitcnt lgkmcnt(0)" ::: "memory")

namespace pg8 {
#define PG8_LAS __attribute__((address_space(3)))
typedef unsigned short bf16_t;
typedef short bf16x8 __attribute__((ext_vector_type(8)));
typedef float f32x4 __attribute__((ext_vector_type(4)));
typedef unsigned u32x4 __attribute__((ext_vector_type(4)));
constexpr int BM = 256, BK = 64, HALF = 128, HTB = HALF * BK * 2  , STAGE_BYTES = 8 * HTB, NXCD = 8, WGM = 8;

__host__ __device__ __forceinline__ int lds_byte(int r, int c) { const int st = (r >> 4) * 2 + (c >> 5), rr = r & 15, cc = c & 31, ob = rr * 64 + cc * 2; return st * 1024 + (ob ^ (((ob >> 9) & 1) << 5)); }
__host__ __device__ __forceinline__ void stage_rc(int b, int& R, int& C) { const int st = b / 1024, sb = b % 1024, swz = sb ^ (((sb >> 9) & 1) << 5); R = (st >> 1) * 16 + swz / 64; C = (st & 1) * 32 + (swz % 64) / 2; }
__host__ __device__ __forceinline__ int perm32(int rho) { const int n = rho >> 4, i = rho & 15; return 8 * (i >> 2) + 4 * n + (i & 3); }

struct Unit { int pm, pn; };
struct Gemm { const bf16_t* A; const bf16_t* Bt; int M, N, K, lda, ldb; const bf16_t* A2 = nullptr; };

struct StaticOrder {
    int nM, nN, nwg, G, c;
    __host__ __device__ void init(int M, int N, int G_, int c_) { nM = M / BM; nN = N / BM; nwg = nM * nN; G = G_; c = c_; }
    __host__ __device__ bool next(int i, Unit& u) const {
        const long L = (long)i * G + c; if (L >= nwg) return false;
        int wgid = (int)L; { const int q = nwg / NXCD, r = nwg % NXCD, xcd = wgid % NXCD, off = wgid / NXCD; wgid = (xcd < r ? xcd * (q + 1) : r * (q + 1) + (xcd - r) * q) + off; }
        const int nig = WGM * nN, gid = wgid / nig, fm = gid * WGM, gsz = (nM - fm) < WGM ? (nM - fm) : WGM;
        u.pm = fm + ((wgid % nig) % gsz); u.pn = (wgid % nig) / gsz; return true;
    }
    __device__ __forceinline__ void a_ready(const Unit&) const {}
    __device__ __forceinline__ void done(const Unit&) const {}
};

typedef float f32x2_cv __attribute__((ext_vector_type(2)));
typedef __bf16 bf16x2_cv __attribute__((ext_vector_type(2)));
__device__ __forceinline__ unsigned cvt_pk_bf16(float lo, float hi) { const f32x2_cv v = {lo, hi}; const bf16x2_cv b = __builtin_convertvector(v, bf16x2_cv); return __builtin_bit_cast(unsigned, b); }
__device__ __forceinline__ void store8(bf16_t* p, const f32x4 v0, const f32x4 v1) {
    u32x4 w; w.x = cvt_pk_bf16(v0[0], v0[1]); w.y = cvt_pk_bf16(v0[2], v0[3]); w.z = cvt_pk_bf16(v1[0], v1[1]); w.w = cvt_pk_bf16(v1[2], v1[3]);
    *(u32x4*)p = w;
}
__device__ __forceinline__ float bflo(unsigned w) { return __builtin_bit_cast(float, w << 16); }
__device__ __forceinline__ float bfhi(unsigned w) { return __builtin_bit_cast(float, w & 0xffff0000u); }
__device__ __forceinline__ void load8(const bf16_t* p, f32x4& v0, f32x4& v1) {
    const u32x4 w = *(const u32x4*)p;
    v0 = (f32x4){bflo(w.x), bfhi(w.x), bflo(w.y), bfhi(w.y)}; v1 = (f32x4){bflo(w.z), bfhi(w.z), bflo(w.w), bfhi(w.w)};
}
__device__ __forceinline__ float sigm(float x) { return __builtin_amdgcn_rcpf(1.f + __expf(-x)); }
__device__ __forceinline__ int get_lane() { unsigned m = 0xffffffffu; asm volatile("" : "+s"(m)); return (int)__builtin_amdgcn_mbcnt_hi(m, __builtin_amdgcn_mbcnt_lo(m, 0u)); }
__device__ __forceinline__ void lane_ids(int& fr, int& fq) { const int lane = get_lane(); fr = lane & 15; fq = lane >> 4; }


struct EpiZ {
    static constexpr bool PERM = true, AFTER_DRAIN = false, HAS_MID = false;
    bf16_t *Zc, *Zr, *Zg; int pn_off;
    __device__ __forceinline__ void operator()(const f32x4 (&acc)[2][2][4][2], const Unit& u, int wr, int wc, int, int) const {
        int fr, fq; lane_ids(fr, fq);
        const int pn = u.pn + pn_off;
        if (pn < 4) {
            const int row0 = u.pm * BM + wr * 64 + fr, col0 = pn * 128 + wc * 32 + 8 * fq;
#pragma unroll
            for (int ai = 0; ai < 2; ++ai)
#pragma unroll
                for (int m = 0; m < 4; ++m) { f32x4 u0, u1;
#pragma unroll
                    for (int j = 0; j < 4; ++j) { u0[j] = acc[ai][0][m][0][j] * sigm(acc[ai][1][m][0][j]); u1[j] = acc[ai][0][m][1][j] * sigm(acc[ai][1][m][1][j]); }
                    store8(Zc + (size_t)(row0 + ai * HALF + m * 16) * 512 + col0, u0, u1); }
        } else if (pn < 11) {
            bf16_t* base = Zr; const int ldc = 1792, colt = (pn - 4) * 256;
            const int row0 = u.pm * BM + wr * 64 + fr, col0 = colt + wc * 32 + 8 * fq;
#pragma unroll
            for (int ai = 0; ai < 2; ++ai)
#pragma unroll
                for (int m = 0; m < 4; ++m) { bf16_t* rowp = base + (size_t)(row0 + ai * HALF + m * 16) * ldc + col0;
#pragma unroll
                    for (int bj = 0; bj < 2; ++bj) store8(rowp + bj * HALF, acc[ai][bj][m][0], acc[ai][bj][m][1]); }
        } else {
            const int row0 = u.pm * BM + wr * 64 + fr, col0 = (pn - 11) * 128 + wc * 32 + 8 * fq;
#pragma unroll
            for (int ai = 0; ai < 2; ++ai)
#pragma unroll
                for (int m = 0; m < 4; ++m) { bf16_t* rowp = Zg + (size_t)(row0 + ai * HALF + m * 16) * 2048 + col0;
                    f32x4 r0, r1, b0, b1;
#pragma unroll
                    for (int j = 0; j < 4; ++j) { const float ea0 = __expf(fminf(-acc[ai][0][m][0][j], 60.f)), ea1 = __expf(fminf(-acc[ai][0][m][1][j], 60.f)), eb0 = __expf(fminf(-acc[ai][1][m][0][j], 60.f)), eb1 = __expf(fminf(-acc[ai][1][m][1][j], 60.f));
                        r0[j] = (1.f + eb0) * __builtin_amdgcn_rcpf(1.f + ea0); r1[j] = (1.f + eb1) * __builtin_amdgcn_rcpf(1.f + ea1);
                        b0[j] = __builtin_amdgcn_rcpf(1.f + eb0); b1[j] = __builtin_amdgcn_rcpf(1.f + eb1); }
                    store8(rowp, r0, r1); store8(rowp + 1024, b0, b1); }
        }
    }
};

template <bool DRY = false> struct EpiSmallT {
    static constexpr bool PERM = true, AFTER_DRAIN = false, HAS_MID = false;
    const float *w0, *a0, *k_a; float* E; bf16_t *Kb, *Bb, *Gb; const bf16_t* KKb;
    __device__ __forceinline__ void operator()(const f32x4 (&acc)[2][2][4][2], const Unit& u, int wr, int wc, int, int) const {
        int fr, fq; lane_ids(fr, fq);
        const int pn = u.pn, kind = pn >> 1;
        const int row0 = u.pm * BM + wr * 64 + fr, col0 = (pn & 1) * 256 + wc * 32 + 8 * fq;
        if (kind == 0) {
            f32x4 p[2][2];
#pragma unroll
            for (int bj = 0; bj < 2; ++bj) { p[bj][0] = *(const f32x4*)(w0 + col0 + bj * HALF); p[bj][1] = *(const f32x4*)(w0 + col0 + bj * HALF + 4); }
#pragma unroll
            for (int ai = 0; ai < 2; ++ai)
#pragma unroll
                for (int m = 0; m < 4; ++m) { const size_t rowoff = (size_t)(row0 + ai * HALF + m * 16) * 512;
#pragma unroll
                    for (int bj = 0; bj < 2; ++bj) { const int c = col0 + bj * HALF; f32x4 v0 = acc[ai][bj][m][0], v1 = acc[ai][bj][m][1];
#pragma unroll
                        for (int j = 0; j < 4; ++j) { v0[j] = 0.60653065971f * sigm(p[bj][0][j] + v0[j]); v1[j] = 0.60653065971f * sigm(p[bj][1][j] + v1[j]); }
                        *(f32x4*)(E + rowoff + c) = v0; *(f32x4*)(E + rowoff + c + 4) = v1; } }
        } else if (kind == 1) {
            f32x4 p[2][2], q[2][2];
#pragma unroll
            for (int bj = 0; bj < 2; ++bj) { const int c = col0 + bj * HALF; p[bj][0] = *(const f32x4*)(a0 + c); p[bj][1] = *(const f32x4*)(a0 + c + 4); q[bj][0] = *(const f32x4*)(k_a + c); q[bj][1] = *(const f32x4*)(k_a + c + 4); }
#pragma unroll
            for (int am = 0; am < 4; ++am) { const int ai = am >> 1;
                u32x4 kw[4][2], kkw[4][2];
#pragma unroll
                for (int m = 2 * (am & 1); m < 2 * (am & 1) + 2; ++m) { const size_t rowoff = (size_t)(row0 + ai * HALF + m * 16) * 512;
#pragma unroll
                    for (int bj = 0; bj < 2; ++bj) { const int c = col0 + bj * HALF; kw[m][bj] = *(const u32x4*)(Kb + rowoff + c); kkw[m][bj] = *(const u32x4*)(KKb + rowoff + c); } }
#pragma unroll
                for (int m = 2 * (am & 1); m < 2 * (am & 1) + 2; ++m) { const size_t rowoff = (size_t)(row0 + ai * HALF + m * 16) * 512;
#pragma unroll
                    for (int bj = 0; bj < 2; ++bj) { const int c = col0 + bj * HALF; const f32x4 v0 = acc[ai][bj][m][0], v1 = acc[ai][bj][m][1];
                        const u32x4 kx = kw[m][bj], kkx = kkw[m][bj];
                        const f32x4 k0 = {bflo(kx.x), bfhi(kx.x), bflo(kx.y), bfhi(kx.y)}, k1 = {bflo(kx.z), bfhi(kx.z), bflo(kx.w), bfhi(kx.w)};
                        const f32x4 kk0 = {bflo(kkx.x), bfhi(kkx.x), bflo(kkx.y), bfhi(kkx.y)}, kk1 = {bflo(kkx.z), bfhi(kkx.z), bflo(kkx.w), bfhi(kkx.w)};
                        f32x4 km0, km1, b0, b1;
#pragma unroll
                        for (int j = 0; j < 4; ++j) { const float a_0 = sigm(p[bj][0][j] + v0[j]), a_1 = sigm(p[bj][1][j] + v1[j]);
                            km0[j] = k0[j] * (1.f + (a_0 - 1.f) * q[bj][0][j]); km1[j] = k1[j] * (1.f + (a_1 - 1.f) * q[bj][1][j]); b0[j] = kk0[j] * a_0; b1[j] = kk1[j] * a_1; }
                        if (!DRY) store8(Kb + rowoff + c, km0, km1); store8(Bb + rowoff + c, b0, b1); } }
            }
        } else {
#pragma unroll
            for (int ai = 0; ai < 2; ++ai)
#pragma unroll
                for (int m = 0; m < 4; ++m) { const size_t rowoff = (size_t)(row0 + ai * HALF + m * 16) * 512;
#pragma unroll
                    for (int bj = 0; bj < 2; ++bj) store8(Gb + rowoff + col0 + bj * HALF, acc[ai][bj][m][0], acc[ai][bj][m][1]); }
        }
    }
};
typedef EpiSmallT<false> EpiSmall;

struct EpiG {
    static constexpr bool PERM = true, AFTER_DRAIN = false, HAS_MID = false;
    bf16_t* Gb;
    __device__ __forceinline__ void operator()(const f32x4 (&acc)[2][2][4][2], const Unit& u, int wr, int wc, int, int) const {
        int fr, fq; lane_ids(fr, fq);
        const int row0 = u.pm * BM + wr * 64 + fr, col0 = u.pn * BM + wc * 32 + 8 * fq;
#pragma unroll
        for (int ai = 0; ai < 2; ++ai)
#pragma unroll
            for (int m = 0; m < 4; ++m) { bf16_t* op = Gb + (size_t)(row0 + ai * HALF + m * 16) * 512 + col0;
#pragma unroll
                for (int bj = 0; bj < 2; ++bj) store8(op + bj * HALF, acc[ai][bj][m][0], acc[ai][bj][m][1]); }
    }
};

__device__ __forceinline__ int mfull_of(int m2) { return m2 + 16 * ((m2 >> 12) + 1); }

template <int MODE> struct EpiMix {
    static constexpr bool PERM = true, AFTER_DRAIN = false, HAS_MID = false;
    bf16_t* Mx; const bf16_t* Zg;
    __device__ __forceinline__ void operator()(const f32x4 (&acc)[2][2][4][2], const Unit& u, int wr, int wc, int, int) const {
        int fr, fq; lane_ids(fr, fq);
        const int row0 = u.pm * BM + wr * 64 + fr, col0 = u.pn * BM + wc * 32 + 8 * fq;
#pragma unroll
        for (int ai = 0; ai < 2; ++ai)
#pragma unroll
            for (int m = 0; m < 4; ++m) { const int row = row0 + ai * HALF + m * 16; const bf16_t* gp = Zg + (size_t)mfull_of(row) * 2048 + MODE * 1024 + col0; bf16_t* op = Mx + (size_t)row * 1024 + col0;
#pragma unroll
                for (int bj = 0; bj < 2; ++bj) { f32x4 g0, g1; load8(gp + bj * HALF, g0, g1); f32x4 v0 = acc[ai][bj][m][0] * g0, v1 = acc[ai][bj][m][1] * g1;
                    if (MODE == 1) { f32x4 o0, o1; load8(op + bj * HALF, o0, o1); v0 += o0; v1 += o1; }
                    store8(op + bj * HALF, v0, v1); } }
    }
};

struct EpiMixF {
    static constexpr bool PERM = true, AFTER_DRAIN = false, HAS_MID = true;
    bf16_t* Mx; const bf16_t* Zg;
    __device__ __forceinline__ void mid(f32x4 (&acc)[2][2][4][2], const Unit& u, int wr, int wc) const {
        int fr, fq; lane_ids(fr, fq);
        const int row0 = u.pm * BM + wr * 64 + fr, col0 = u.pn * BM + wc * 32 + 8 * fq;
        u32x4 rw[2][4][2];
#pragma unroll
        for (int ai = 0; ai < 2; ++ai)
#pragma unroll
            for (int m = 0; m < 4; ++m) { const bf16_t* gp = Zg + (size_t)mfull_of(row0 + ai * HALF + m * 16) * 2048 + col0;
#pragma unroll
                for (int bj = 0; bj < 2; ++bj) rw[ai][m][bj] = *(const u32x4*)(gp + bj * HALF); }
#pragma unroll
        for (int ai = 0; ai < 2; ++ai)
#pragma unroll
            for (int m = 0; m < 4; ++m)
#pragma unroll
                for (int bj = 0; bj < 2; ++bj) { const u32x4 w = rw[ai][m][bj];
                    acc[ai][bj][m][0] *= (f32x4){bflo(w.x), bfhi(w.x), bflo(w.y), bfhi(w.y)}; acc[ai][bj][m][1] *= (f32x4){bflo(w.z), bfhi(w.z), bflo(w.w), bfhi(w.w)}; }
    }
    __device__ __forceinline__ void operator()(const f32x4 (&acc)[2][2][4][2], const Unit& u, int wr, int wc, int, int) const {
        int fr, fq; lane_ids(fr, fq);
        const int row0 = u.pm * BM + wr * 64 + fr, col0 = u.pn * BM + wc * 32 + 8 * fq;
        u32x4 gw[2][4][2];
#pragma unroll
        for (int ai = 0; ai < 2; ++ai)
#pragma unroll
            for (int m = 0; m < 4; ++m) { const int row = row0 + ai * HALF + m * 16; const bf16_t* gp = Zg + (size_t)mfull_of(row) * 2048 + 1024 + col0;
#pragma unroll
                for (int bj = 0; bj < 2; ++bj) gw[ai][m][bj] = *(const u32x4*)(gp + bj * HALF); }
#pragma unroll
        for (int ai = 0; ai < 2; ++ai)
#pragma unroll
            for (int m = 0; m < 4; ++m) { const int row = row0 + ai * HALF + m * 16; bf16_t* op = Mx + (size_t)row * 1024 + col0;
#pragma unroll
                for (int bj = 0; bj < 2; ++bj) { const u32x4 w = gw[ai][m][bj]; const f32x4 g0 = {bflo(w.x), bfhi(w.x), bflo(w.y), bfhi(w.y)}, g1 = {bflo(w.z), bfhi(w.z), bflo(w.w), bfhi(w.w)};
                    store8(op + bj * HALF, acc[ai][bj][m][0] * g0, acc[ai][bj][m][1] * g1); } }
    }
};

struct EpiH1 {
    static constexpr bool PERM = true, AFTER_DRAIN = false, HAS_MID = false;
    const float* X; float* H1; bf16_t* H1b; float* ssq;
    __device__ __forceinline__ void operator()(const f32x4 (&acc)[2][2][4][2], const Unit& u, int wr, int wc, int, int) const {
        int fr, fq; lane_ids(fr, fq);
        const int row0 = u.pm * BM + wr * 64 + fr, col0 = u.pn * BM + wc * 32 + 8 * fq;
#pragma unroll
        for (int ai = 0; ai < 2; ++ai)
        {   f32x4 xv[4][2][2];
#pragma unroll
            for (int m = 0; m < 4; ++m) { const size_t off = (size_t)(row0 + ai * HALF + m * 16) * 1024 + col0;
#pragma unroll
                for (int bj = 0; bj < 2; ++bj) { xv[m][bj][0] = *(const f32x4*)(X + off + bj * HALF); xv[m][bj][1] = *(const f32x4*)(X + off + bj * HALF + 4); } }
#pragma unroll
            for (int m = 0; m < 4; ++m) { const int row = row0 + ai * HALF + m * 16; const size_t off = (size_t)row * 1024 + col0; float s = 0.f;
#pragma unroll
                for (int bj = 0; bj < 2; ++bj) {
                    const f32x4 v0 = acc[ai][bj][m][0] + xv[m][bj][0], v1 = acc[ai][bj][m][1] + xv[m][bj][1];
                    store8(H1b + off + bj * HALF, v0, v1);
                    s += (v0[0] * v0[0] + v0[1] * v0[1]) + (v0[2] * v0[2] + v0[3] * v0[3]) + (v1[0] * v1[0] + v1[1] * v1[1]) + (v1[2] * v1[2] + v1[3] * v1[3]); }
                s += __shfl_xor(s, 16); s += __shfl_xor(s, 32);
                if (fq == 0) atomicAdd(ssq + row, s); }
        }
    }
};

struct EpiQ {
    static constexpr bool PERM = true, AFTER_DRAIN = false, HAS_MID = false;
    bf16_t* Q; const float* ssq;
    __device__ __forceinline__ void operator()(const f32x4 (&acc)[2][2][4][2], const Unit& u, int wr, int wc, int, int) const {
        int fr, fq; lane_ids(fr, fq);
        const int row0 = u.pm * BM + wr * 64 + fr, col0 = u.pn * BM + wc * 32 + 8 * fq;
        float sq[2][4];
#pragma unroll
        for (int ai = 0; ai < 2; ++ai)
#pragma unroll
            for (int m = 0; m < 4; ++m) sq[ai][m] = ssq[row0 + ai * HALF + m * 16];
#pragma unroll
        for (int ai = 0; ai < 2; ++ai)
#pragma unroll
            for (int m = 0; m < 4; ++m) { const int row = row0 + ai * HALF + m * 16; const float rs = __builtin_amdgcn_rsqf(sq[ai][m] * (1.f / 1024.f) + 1e-6f); bf16_t* op = Q + (size_t)row * 2048 + col0;
#pragma unroll
                for (int bj = 0; bj < 2; ++bj) store8(op + bj * HALF, acc[ai][bj][m][0] * rs, acc[ai][bj][m][1] * rs); }
    }
};

template <class Epi, class Sched, bool ALIGN_EPI = false, bool SP2 = false>
__device__ __forceinline__ void gemm_phase(PG8_LAS unsigned char* lds, const Gemm g, const Sched& S, const Epi& E, const int wave_s) {
    const int wid = wave_s, lane = get_lane(), tid = wid * 64 + lane, wr = wid >> 2, wc = wid & 3, fr = lane & 15, fq = lane >> 4;
    const int K = g.K, nt = K / BK;
    unsigned voffA[2], voffB[2];
#pragma unroll
    for (int i = 0; i < 2; ++i) { int R, C; stage_rc(tid * 16 + i * 8192, R, C); const int Rb = Epi::PERM ? ((R & ~31) + perm32(R & 31)) : R;
        voffA[i] = (unsigned)(R * g.lda + C) * 2u; voffB[i] = (unsigned)(Rb * g.ldb + C) * 2u; }
    const size_t kstep = (size_t)(BK * 2);
    const size_t hstepA = (size_t)HALF * g.lda * 2, hstepB = (size_t)HALF * g.ldb * 2;
    const size_t tstepA = 2 * hstepA, tstepB = 2 * hstepB;
    const unsigned ldsw = (unsigned)wid * 1024u;
    const int aoff = lds_byte(wr * 64 + fr, fq * 8), boff = lds_byte(wc * 32 + fr, fq * 8);
#define PG8_SA(b, h) (((b) * 2 + (h)) * HTB)
#define PG8_SB(b, h) ((4 + (b) * 2 + (h)) * HTB)
#define PG8_STAGE(bufoff, gbase, voff) do { _Pragma("unroll") for (int _i = 0; _i < 2; ++_i) \
        __builtin_amdgcn_global_load_lds((const unsigned*)((const char*)(gbase) + (voff)[_i]), (PG8_LAS unsigned*)(lds + (bufoff) + ldsw + _i * 8192), 16, 0, 0); } while (0)
#define PG8_LDA(dst, b, h) do { unsigned _ab = (unsigned)(PG8_SA(b, h) + aoff); asm volatile("" : "+v"(_ab)); _Pragma("unroll") for (int m = 0; m < 4; ++m) _Pragma("unroll") for (int k = 0; k < 2; ++k) dst[m][k] = *(const PG8_LAS bf16x8*)(lds + _ab + m * 2048 + k * 1024); } while (0)
#define PG8_LDB(dst, b, h) do { unsigned _bb = (unsigned)(PG8_SB(b, h) + boff); asm volatile("" : "+v"(_bb)); _Pragma("unroll") for (int n = 0; n < 2; ++n) _Pragma("unroll") for (int k = 0; k < 2; ++k) dst[n][k] = *(const PG8_LAS bf16x8*)(lds + _bb + n * 2048 + k * 1024); } while (0)
#define PG8_MMA(ai, bj, At, Bt) do { __builtin_amdgcn_s_setprio(1); _Pragma("unroll") for (int m = 0; m < 4; ++m) _Pragma("unroll") for (int n = 0; n < 2; ++n) _Pragma("unroll") for (int k = 0; k < 2; ++k) \
        acc[ai][bj][m][n] = __builtin_amdgcn_mfma_f32_16x16x32_bf16(Bt[n][k], At[m][k], acc[ai][bj][m][n], 0, 0, 0); __builtin_amdgcn_s_setprio(0); } while (0)
#define PG8_WAIT_V(n) asm volatile("s_waitcnt vmcnt(" #n ")" ::: "memory")
#define PG8_WAIT_L(n) asm volatile("s_waitcnt lgkmcnt(" #n ")" ::: "memory")
#define PG8_BAR __builtin_amdgcn_s_barrier()
#define PG8_SCHED __builtin_amdgcn_sched_barrier(0)
    Unit cur, nxt; int ui = 0;
    if (!S.next(0, cur)) return;
    f32x4 acc[2][2][4][2];
#pragma unroll
    for (int a = 0; a < 2; ++a)
#pragma unroll
        for (int b = 0; b < 2; ++b)
#pragma unroll
            for (int m = 0; m < 4; ++m)
#pragma unroll
                for (int n = 0; n < 2; ++n) acc[a][b][m][n] = (f32x4){0.f, 0.f, 0.f, 0.f};
    bf16x8 At[4][2], B0[2][2], B1[2][2];
    const char* cA = (const char*)g.A + (size_t)cur.pm * tstepA; const char* cB = (const char*)g.Bt + (size_t)cur.pn * tstepB;
    S.a_ready(cur);
    if constexpr (SP2) {
        PG8_STAGE(PG8_SB(0, 0), cB, voffB); PG8_STAGE(PG8_SB(0, 1), cB + hstepB, voffB); PG8_STAGE(PG8_SA(0, 0), cA, voffA); PG8_STAGE(PG8_SA(0, 1), cA + hstepA, voffA);
        if (wr == 1) PG8_BAR;
        PG8_WAIT_V(2); PG8_BAR;
        PG8_STAGE(PG8_SB(1, 0), cB + kstep, voffB); PG8_STAGE(PG8_SA(1, 0), cA + kstep, voffA); PG8_STAGE(PG8_SB(1, 1), cB + hstepB + kstep, voffB);
        PG8_WAIT_V(6); PG8_BAR;
    } else {
        PG8_STAGE(PG8_SB(0, 0), cB, voffB); PG8_STAGE(PG8_SA(0, 0), cA, voffA); PG8_STAGE(PG8_SB(0, 1), cB + hstepB, voffB); PG8_STAGE(PG8_SA(0, 1), cA + hstepA, voffA);
        if (wr == 1) PG8_BAR;
        PG8_WAIT_V(4); PG8_BAR;
        PG8_STAGE(PG8_SB(1, 0), cB + kstep, voffB); PG8_STAGE(PG8_SA(1, 0), cA + kstep, voffA); PG8_STAGE(PG8_SB(1, 1), cB + hstepB + kstep, voffB);
        PG8_WAIT_V(6); PG8_BAR;
    }
    for (;;) {
        const bool has_next = S.next(ui + 1, nxt);
        const char* nA = has_next ? (const char*)g.A + (size_t)nxt.pm * tstepA : cA; const char* nB = has_next ? (const char*)g.Bt + (size_t)nxt.pn * tstepB : cB;
        for (int t = 0; t < nt; t += 2) {
            const bool last = (t == nt - 2);
            const char* cA2 = g.A2 ? (const char*)g.A2 + (cA - (const char*)g.A) - (size_t)(nt / 2) * kstep : cA;
            const int nh = g.A2 ? nt / 2 : nt;
            const char* a1 = ((t + 1 < nh) ? cA : cA2) + (size_t)(t + 1) * kstep;
            const char* a2 = last ? nA : ((t + 2 < nh) ? cA : cA2) + (size_t)(t + 2) * kstep; const char* b2 = last ? nB : cB + (size_t)(t + 2) * kstep;
            const char* a3 = a2 + kstep; const char* b3 = b2 + kstep;
            if (last && has_next) S.a_ready(nxt);
            if constexpr (Epi::HAS_MID) { if (t == nt / 2) E.mid(acc, cur, wr, wc); }
            if constexpr (SP2) {
            PG8_LDB(B0, 0, 0); PG8_LDB(B1, 0, 1); PG8_SCHED; PG8_LDA(At, 0, 0); PG8_STAGE(PG8_SA(1, 1), a1 + hstepA, voffA);
            PG8_WAIT_V(8); PG8_WAIT_L(0); PG8_BAR; PG8_MMA(0, 0, At, B0); PG8_MMA(0, 1, At, B1); PG8_BAR; PG8_SCHED;
            PG8_LDA(At, 0, 1); PG8_STAGE(PG8_SB(0, 0), b2, voffB); PG8_STAGE(PG8_SB(0, 1), b2 + hstepB, voffB); PG8_STAGE(PG8_SA(0, 0), a2, voffA);
            PG8_WAIT_V(8); PG8_WAIT_L(0); PG8_BAR; PG8_MMA(1, 0, At, B0); PG8_MMA(1, 1, At, B1); PG8_BAR; PG8_SCHED;
            PG8_LDB(B0, 1, 0); PG8_LDB(B1, 1, 1); PG8_SCHED; PG8_LDA(At, 1, 0); PG8_STAGE(PG8_SA(0, 1), a2 + hstepA, voffA);
            PG8_WAIT_V(8); PG8_WAIT_L(0); PG8_BAR; PG8_MMA(0, 0, At, B0); PG8_MMA(0, 1, At, B1); PG8_BAR; PG8_SCHED;
            PG8_LDA(At, 1, 1); PG8_STAGE(PG8_SB(1, 0), b3, voffB); PG8_STAGE(PG8_SB(1, 1), b3 + hstepB, voffB); PG8_STAGE(PG8_SA(1, 0), a3, voffA);
            PG8_WAIT_V(8); PG8_WAIT_L(0); PG8_BAR; PG8_MMA(1, 0, At, B0); PG8_MMA(1, 1, At, B1); PG8_BAR; PG8_SCHED;
            } else {
            PG8_LDB(B0, 0, 0); PG8_SCHED; PG8_LDA(At, 0, 0); PG8_STAGE(PG8_SA(1, 1), a1 + hstepA, voffA);
            PG8_WAIT_L(8); PG8_BAR; PG8_WAIT_L(0); PG8_MMA(0, 0, At, B0); PG8_BAR; PG8_SCHED;
            PG8_LDB(B1, 0, 1); PG8_STAGE(PG8_SB(0, 0), b2, voffB);
            PG8_BAR; PG8_WAIT_L(0); PG8_MMA(0, 1, At, B1); PG8_BAR;
            PG8_LDA(At, 0, 1); PG8_STAGE(PG8_SA(0, 0), a2, voffA);
            PG8_BAR; PG8_WAIT_L(0); PG8_MMA(1, 0, At, B0); PG8_BAR; PG8_SCHED;
            PG8_STAGE(PG8_SB(0, 1), b2 + hstepB, voffB);
            PG8_WAIT_V(6); PG8_BAR; PG8_MMA(1, 1, At, B1); PG8_BAR;
            PG8_LDB(B0, 1, 0); PG8_SCHED; PG8_LDA(At, 1, 0); PG8_STAGE(PG8_SA(0, 1), a2 + hstepA, voffA);
            PG8_WAIT_L(8); PG8_BAR; PG8_WAIT_L(0); PG8_MMA(0, 0, At, B0); PG8_BAR; PG8_SCHED;
            PG8_LDB(B1, 1, 1); PG8_STAGE(PG8_SB(1, 0), b3, voffB);
            PG8_BAR; PG8_WAIT_L(0); PG8_MMA(0, 1, At, B1); PG8_BAR;
            PG8_LDA(At, 1, 1); PG8_STAGE(PG8_SA(1, 0), a3, voffA);
            PG8_BAR; PG8_WAIT_L(0); PG8_MMA(1, 0, At, B0); PG8_BAR; PG8_SCHED;
            PG8_STAGE(PG8_SB(1, 1), b3 + hstepB, voffB);
            PG8_WAIT_V(6); PG8_BAR; PG8_MMA(1, 1, At, B1); PG8_BAR;
            }
        }
        if constexpr (ALIGN_EPI) { if (wr == 0) PG8_BAR; }
        if constexpr (!Epi::AFTER_DRAIN) { E(acc, cur, wr, wc, fr, fq); S.done(cur); }
        if (!has_next) break;
#pragma unroll
        for (int a = 0; a < 2; ++a)
#pragma unroll
            for (int b = 0; b < 2; ++b)
#pragma unroll
                for (int m = 0; m < 4; ++m)
#pragma unroll
                    for (int n = 0; n < 2; ++n) acc[a][b][m][n] = (f32x4){0.f, 0.f, 0.f, 0.f};
        cur = nxt; cA = nA; cB = nB; ++ui;
        if constexpr (ALIGN_EPI) { if (wr == 1) PG8_BAR; }
    }
    PG8_WAIT_V(0);
    if constexpr (!ALIGN_EPI) { if (wr == 0) PG8_BAR; }
    PG8_BAR;
    if constexpr (Epi::AFTER_DRAIN) { E.fused(acc, cur, wr, wc, fr, fq, lds, wid, lane); S.done(cur); }
#undef PG8_SA
#undef PG8_SB
#undef PG8_STAGE
#undef PG8_LDA
#undef PG8_LDB
#undef PG8_MMA
#undef PG8_WAIT_V
#undef PG8_WAIT_L
#undef PG8_BAR
#undef PG8_SCHED
}
}

typedef pg8::bf16_t bf16_t;
typedef pg8::f32x4 f32x4;
typedef pg8::u32x4 u32x4;
typedef pg8::bf16x8 bf16x8;
typedef unsigned u32x2 __attribute__((ext_vector_type(2)));
using pg8::bflo; using pg8::bfhi; using pg8::cvt_pk_bf16; using pg8::sigm; using pg8::load8; using pg8::store8;

constexpr int D = 1024, NB = 8, SEQ = 4096, NMETA = 16, T = SEQ + NMETA  , MT = NB * T  , MP = 33024  , M2 = NB * SEQ  ;
constexpr int INTOT = 4864, CCH = 512, RWW = 512, RWIN = 1792, NHEAD = 8;
constexpr int PH = 8, PK = 128, PDH = 128, PTOPK = 16, NEXP = 16384;
constexpr int NWAVES = 8, NTHR = 512;
constexpr int LDS_BYTES = 147456;

constexpr size_t MiB = 1u << 20;
constexpr size_t WS_CTL = 0, CTL_ZERO_BYTES = 1 * MiB;
constexpr size_t WS_SSQ = 256 * 1024;
constexpr size_t WS_SSQ2 = 512 * 1024;
constexpr size_t WS_WIN = 1 * MiB;
constexpr size_t WS_WCR = 11 * MiB;
constexpr size_t WS_WO = 13 * MiB;
constexpr size_t WS_WQ = 15 * MiB;
constexpr size_t WS_SK = 19 * MiB;
constexpr size_t WS_WSM = 19 * MiB + 512 * 1024;
constexpr size_t WS_EU = 20 * MiB + 256 * 1024, WS_EV = WS_EU + 16 * MiB + 256 * 1024;
constexpr size_t WS_ACL = 53 * MiB;
constexpr size_t WS_EU_OLD_ = 0, WS_EV_OLD_ = 0;
constexpr size_t WS_XN = 85 * MiB;
constexpr size_t WS_ZG = 150 * MiB;
constexpr size_t WS_ZR = 279 * MiB;
constexpr size_t WS_ZC = 392 * MiB;
constexpr size_t WS_KK = 457 * MiB;
constexpr size_t WS_A2 = 490 * MiB;
constexpr size_t WS_RK = 507 * MiB + 256 * 1024;
constexpr size_t WS_EM = WS_ZC + 32 * MiB + 512 * 1024;
constexpr size_t WS_WC = WS_A2 + 13 * MiB + 64 * 1024;
constexpr size_t WS_ORAW = 345 * MiB;
constexpr size_t WS_END = 509 * MiB;

struct Args { const float* in[28]; float* out; unsigned char* ws; int ph_lo, ph_hi; };

__device__ __forceinline__ float dpp_f(float x, const int ctrl_sel) { return x; }
#define DPP_ADD(x, ctrl) ((x) + __builtin_bit_cast(float, __builtin_amdgcn_update_dpp(0, __builtin_bit_cast(int, (x)), (ctrl), 0xf, 0xf, true)))
__device__ __forceinline__ float red8(float x) {
    x = DPP_ADD(x, 0xB1); x = DPP_ADD(x, 0x4E); x = DPP_ADD(x, 0x141); return x;
}
__device__ __forceinline__ float red16(float x) { x = red8(x); x = DPP_ADD(x, 0x140); return x; }
__device__ __forceinline__ float wave_sum(float x) {
    x = red16(x);
    const int xi = __builtin_bit_cast(int, x);
    const float a = __builtin_bit_cast(float, __builtin_amdgcn_readlane(xi, 0)), b = __builtin_bit_cast(float, __builtin_amdgcn_readlane(xi, 16)), c = __builtin_bit_cast(float, __builtin_amdgcn_readlane(xi, 32)), d = __builtin_bit_cast(float, __builtin_amdgcn_readlane(xi, 48));
    return (a + b) + (c + d);
}

template <bool GATEP = false>
__device__ __forceinline__ void p0_transpose_item(const float* W, int ldw, bf16_t* WT, int ldt, int koff, const float* kscale, int nblk, LAS float* scr, int item, int lane) {
    const int kb = item / nblk, nb = item % nblk, k0 = 64 * kb, n0 = 32 * nb;
    int no0 = n0; if (GATEP && n0 < 1024) { const int jb = n0 >= 512 ? 1 : 0, jc = n0 - 512 * jb; no0 = 256 * (jc >> 7) + 128 * jb + (jc & 127); }
    if (GATEP && n0 >= 2816) { const int j = n0 - 2816, jb = j >= 1024 ? 1 : 0, jc = j - 1024 * jb; no0 = 2816 + 256 * (jc >> 7) + 128 * jb + (jc & 127); }
#pragma unroll 8
    for (int i = 0; i < 32; ++i) { const int kk = 2 * i + (lane >> 5); float w = W[(size_t)(k0 + kk) * ldw + n0 + (lane & 31)]; if (kscale) w *= kscale[k0 + kk]; scr[kk * 33 + (lane & 31)] = w; }
    LDS_WAIT(); asm volatile("" ::: "memory");
    const int c = lane & 7;
#pragma unroll
    for (int j = 0; j < 4; ++j) { const int n = (lane >> 3) + 8 * j; const LAS float* s = scr + (8 * c) * 33 + n;
        u32x4 o; o.x = cvt_pk_bf16(s[0 * 33], s[1 * 33]); o.y = cvt_pk_bf16(s[2 * 33], s[3 * 33]); o.z = cvt_pk_bf16(s[4 * 33], s[5 * 33]); o.w = cvt_pk_bf16(s[6 * 33], s[7 * 33]);
        *(u32x4*)(WT + (size_t)(no0 + n) * ldt + koff + k0 + 8 * c) = o; }
    LDS_WAIT(); asm volatile("" ::: "memory");
}

template <int PART> __device__ __forceinline__ void p0_prologue(const Args& a, LAS unsigned char* lds, const int vb, const int VG, const int wave) {
    const int lane = pg8::get_lane(), tid = wave * 64 + lane;
    unsigned char* ws = a.ws;
    LAS float* scr = (LAS float*)(lds + wave * 16384);
    const int gw = vb * NWAVES + wave, NGW = VG * NWAVES;
    const int gt = vb * NTHR + tid, NGT = VG * NTHR;
    constexpr int I_IN = (1024 / 64) * (INTOT / 32), I_C = (512 / 64) * (1024 / 32), I_O = (1024 / 64) * (1024 / 32), I_Q = (1024 / 64) * (2048 / 32);
    constexpr int NITEMS = I_IN + 2 * I_C + I_O + I_Q;
    for (int it = gw; it < NITEMS; it += NGW) {
        int r = it;
        if ((r < I_IN) != (PART != 1) && PART != 2) continue;
        if (r < I_IN) { p0_transpose_item<true>(a.in[3], INTOT, (bf16_t*)(ws + WS_WIN), 1024, 0, nullptr, INTOT / 32, scr, r, lane); continue; } r -= I_IN;
        if (r < I_C) { p0_transpose_item(a.in[8], 1024, (bf16_t*)(ws + WS_WCR), 1024, 0, nullptr, 32, scr, r, lane); continue; } r -= I_C;
        if (r < I_C) { p0_transpose_item(a.in[20], 1024, (bf16_t*)(ws + WS_WCR), 1024, 512, nullptr, 32, scr, r, lane); continue; } r -= I_C;
        if (r < I_O) { p0_transpose_item(a.in[21], 1024, (bf16_t*)(ws + WS_WO), 1024, 0, nullptr, 32, scr, r, lane); continue; } r -= I_O;
        p0_transpose_item(a.in[23], 2048, (bf16_t*)(ws + WS_WQ), 1024, 0, a.in[22], 64, scr, r, lane);
    }
    if (PART != 0) { const float* sk = a.in[24]; bf16_t* o = (bf16_t*)(ws + WS_SK);
      for (int i = gt; i < 16 * 128 * 128 / 8; i += NGT) { const f32x4 x0 = *(const f32x4*)(sk + (size_t)i * 8), x1 = *(const f32x4*)(sk + (size_t)i * 8 + 4); store8(o + (size_t)i * 8, x0, x1); } }
    if (PART != 1) { const float* w_up = a.in[11]; const float* a_up = a.in[13]; const float* g_up = a.in[14]; bf16_t* o = (bf16_t*)(ws + WS_WSM);
      for (int i = gt; i < 1536 * 32; i += NGT) { const int n = i >> 5, k8 = (i & 31) * 8; float v[8];
#pragma unroll
          for (int j = 0; j < 8; ++j) { const int k = k8 + j; float x = 0.f;
              if (n < 512) { if (k < 64) x = w_up[k * 512 + n]; }
              else if (n < 1024) { if (k >= 64 && k < 128) x = a_up[(k - 64) * 512 + (n - 512)]; }
              else { if (k >= 128) x = g_up[(k - 128) * 512 + (n - 1024)]; }
              v[j] = x; }
          store8(o + (size_t)n * 256 + k8, (f32x4){v[0], v[1], v[2], v[3]}, (f32x4){v[4], v[5], v[6], v[7]}); } }
    if (PART != 0) { const float* gf = a.in[22]; unsigned char* t8[2] = {ws + WS_EU, ws + WS_EV};
      for (int it0 = gw; it0 < 2 * NEXP; it0 += 4 * NGW) {
          f32x4 v[4][4];
#pragma unroll
          for (int r = 0; r < 4; ++r) { const int it = it0 + r * NGW; if (it < 2 * NEXP) { const int tb = it >= NEXP ? 1 : 0, e = it - tb * NEXP;
              const float* src = (tb ? a.in[26] : a.in[25]) + (size_t)e * 1024 + 16 * lane;
#pragma unroll
              for (int j = 0; j < 4; ++j) v[r][j] = *(const f32x4*)(src + 4 * j); } }
#pragma unroll
          for (int r = 0; r < 4; ++r) { const int it = it0 + r * NGW; if (it < 2 * NEXP) { const int tb = it >= NEXP ? 1 : 0, e = it - tb * NEXP; float mx = 0.f;
#pragma unroll
              for (int j = 0; j < 4; ++j) { if (!tb) v[r][j] = v[r][j] * *(const f32x4*)(gf + 16 * lane + 4 * j);
                  mx = fmaxf(mx, fmaxf(fmaxf(fabsf(v[r][j][0]), fabsf(v[r][j][1])), fmaxf(fabsf(v[r][j][2]), fabsf(v[r][j][3])))); }
#pragma unroll
              for (int o = 1; o < 64; o <<= 1) mx = fmaxf(mx, __shfl_xor(mx, o));
              mx = fmaxf(mx, 1e-30f);
              const float sc = 384.f / mx;
              u32x4 w; int p;
              p = 0; p = __builtin_amdgcn_cvt_pk_fp8_f32(v[r][0][0] * sc, v[r][0][1] * sc, p, false); p = __builtin_amdgcn_cvt_pk_fp8_f32(v[r][0][2] * sc, v[r][0][3] * sc, p, true); w.x = (unsigned)p;
              p = 0; p = __builtin_amdgcn_cvt_pk_fp8_f32(v[r][1][0] * sc, v[r][1][1] * sc, p, false); p = __builtin_amdgcn_cvt_pk_fp8_f32(v[r][1][2] * sc, v[r][1][3] * sc, p, true); w.y = (unsigned)p;
              p = 0; p = __builtin_amdgcn_cvt_pk_fp8_f32(v[r][2][0] * sc, v[r][2][1] * sc, p, false); p = __builtin_amdgcn_cvt_pk_fp8_f32(v[r][2][2] * sc, v[r][2][3] * sc, p, true); w.z = (unsigned)p;
              p = 0; p = __builtin_amdgcn_cvt_pk_fp8_f32(v[r][3][0] * sc, v[r][3][1] * sc, p, false); p = __builtin_amdgcn_cvt_pk_fp8_f32(v[r][3][2] * sc, v[r][3][3] * sc, p, true); w.w = (unsigned)p;
              unsigned char* tab = tb ? (ws + WS_EV) : (ws + WS_EU);
              *(u32x4*)(tab + (size_t)e * 1024 + 16 * lane) = w;
              if (lane == 0) ((float*)(tab + 16 * MiB))[e] = mx * (1.f / 384.f); } }
      } }
    if (PART != 1) { const float* x = a.in[0]; const float* meta = a.in[1]; const float* gm = a.in[2]; bf16_t* XN = (bf16_t*)(ws + WS_XN);
      f32x4 nv[4];
#define XN_LOAD(mm) do { if ((mm) < MT) { const int b_ = (mm) / T, t_ = (mm) - b_ * T; const float* src_ = (t_ < NMETA) ? meta + (size_t)t_ * 1024 : x + ((size_t)b_ * SEQ + (t_ - NMETA)) * 1024; \
          _Pragma("unroll") for (int j = 0; j < 4; ++j) nv[j] = ((const f32x4*)src_)[lane + 64 * j]; } } while (0)
      if (gw < MP) XN_LOAD(gw);
      for (int m = gw; m < MP; m += NGW) {
          bf16_t* o = XN + (size_t)m * 1024;
          f32x4 v[4];
#pragma unroll
          for (int j = 0; j < 4; ++j) v[j] = nv[j];
          if (m + NGW < MP) XN_LOAD(m + NGW);
          if (m >= MT) { const u32x4 z = {0u, 0u, 0u, 0u}; ((u32x4*)o)[lane] = z; ((u32x4*)o)[lane + 64] = z; continue; }
          float s = 0.f;
#pragma unroll
          for (int j = 0; j < 4; ++j) s += (v[j][0] * v[j][0] + v[j][1] * v[j][1]) + (v[j][2] * v[j][2] + v[j][3] * v[j][3]);
          const float rs = 1.f / sqrtf(wave_sum(s) * (1.f / 1024.f) + 1e-6f);
#pragma unroll
          for (int j = 0; j < 4; ++j) { const f32x4 g = ((const f32x4*)gm)[lane + 64 * j]; const f32x4 y = v[j] * rs * g;
              u32x2 w; w.x = cvt_pk_bf16(y[0], y[1]); w.y = cvt_pk_bf16(y[2], y[3]); ((u32x2*)o)[lane + 64 * j] = w; }
      }
#undef XN_LOAD
    }
}

typedef float f32x2v __attribute__((ext_vector_type(2)));
__device__ __forceinline__ void p2_conv(const Args& a, LAS unsigned char* lds, int G, const int wave, const bool split) {
    const int lane = pg8::get_lane(), tid = wave * 64 + lane;
    const bf16_t* Zc = (const bf16_t*)(a.ws + WS_ZC); bf16_t* ACL = (bf16_t*)(a.ws + WS_ACL);
    const float* conv_w = a.in[4]; const float* conv_b = a.in[5]; const float* ln_g = a.in[6]; const float* ln_b = a.in[7];
    constexpr int CT = 66, HT = 33, NR = CT + 30, TPB = (T + CT - 1) / CT;
    LAS unsigned char* ul = lds;
    LAS unsigned* yl = (LAS unsigned*)lds;
    const int cp = tid & 255, tg = tid >> 8;
    f32x2v w[31];
#pragma unroll
    for (int j = 0; j < 31; ++j) w[j] = *(const f32x2v*)(conv_w + j * 512 + 2 * cp);
    const f32x2v bias = *(const f32x2v*)(conv_b + 2 * cp);
    const bool tailwg = split && (int)blockIdx.x >= G - NB;
    const int it_first = split ? (tailwg ? 0 : (int)blockIdx.x) : (int)blockIdx.x, it_step = split ? (G - NB) : G, it_end = split ? (tailwg ? 1 : NB * (TPB - 1)) : NB * TPB;
    for (int it = it_first; it < it_end; it += it_step) {
        const int b = split ? (tailwg ? (int)blockIdx.x - (G - NB) : it / (TPB - 1)) : it / TPB;
        const int t0 = (split ? (tailwg ? TPB - 1 : it - b * (TPB - 1)) : it - b * TPB) * CT;
        u32x4 vv[12];
#pragma unroll
        for (int k = 0; k < 12; ++k) { const int r = (tid >> 6) + 8 * k, ti = t0 - 30 + r; vv[k] = (u32x4){0u, 0u, 0u, 0u};
            if (ti >= 0 && ti < T) vv[k] = *(const u32x4*)(Zc + (size_t)(b * T + ti) * 512 + 8 * lane); }
#pragma unroll
        for (int k = 0; k < 12; ++k) { const int r = (tid >> 6) + 8 * k; *(LAS u32x4*)(ul + r * 1024 + lane * 16) = vv[k]; }
        __syncthreads();
        f32x2v u[HT + 30];
#pragma unroll
        for (int s = 0; s < HT + 30; ++s) { const unsigned uw = *(const LAS unsigned*)(ul + (tg * HT + s) * 1024 + cp * 4); u[s] = (f32x2v){bflo(uw), bfhi(uw)}; }
        unsigned yv[HT];
#pragma unroll
        for (int o = 0; o < HT; ++o) {
            f32x2v acc = bias;
#pragma unroll
            for (int j = 0; j < 31; ++j) acc = w[j] * u[o + j] + acc;
            yv[o] = cvt_pk_bf16(acc.x, acc.y);
        }
        __syncthreads();
#pragma unroll
        for (int o = 0; o < HT; ++o) yl[(tg * HT + o) * 256 + cp] = yv[o];
        __syncthreads();
        for (int o = wave; o < CT; o += NWAVES) {
            const int t = t0 + o;
            if (t >= NMETA && t < T) {
                const u32x4 yw = *(const LAS u32x4*)(yl + o * 256 + 4 * lane);
                const f32x4 y0 = {bflo(yw.x), bfhi(yw.x), bflo(yw.y), bfhi(yw.y)}, y1 = {bflo(yw.z), bfhi(yw.z), bflo(yw.w), bfhi(yw.w)};
                const float mean = wave_sum((y0[0] + y0[1]) + (y0[2] + y0[3]) + (y1[0] + y1[1]) + (y1[2] + y1[3])) * (1.f / 512.f);
                const f32x4 d0 = y0 - mean, d1 = y1 - mean;
                const float var = wave_sum((d0[0] * d0[0] + d0[1] * d0[1]) + (d0[2] * d0[2] + d0[3] * d0[3]) + (d1[0] * d1[0] + d1[1] * d1[1]) + (d1[2] * d1[2] + d1[3] * d1[3])) * (1.f / 512.f);
                const float rstd = __builtin_amdgcn_rsqf(var + 1e-5f);
                const f32x4 g0 = *(const f32x4*)(ln_g + 8 * lane), g1 = *(const f32x4*)(ln_g + 8 * lane + 4), b0 = *(const f32x4*)(ln_b + 8 * lane), b1 = *(const f32x4*)(ln_b + 8 * lane + 4);
                f32x4 z0 = d0 * rstd * g0 + b0, z1 = d1 * rstd * g1 + b1;
#pragma unroll
                for (int j = 0; j < 4; ++j) { z0[j] = z0[j] * sigm(z0[j]); z1[j] = z1[j] * sigm(z1[j]); }
                store8(ACL + ((size_t)b * SEQ + (t - NMETA)) * 512 + 8 * lane, z0, z1);
            }
        }
        __syncthreads();
    }
}

__device__ __forceinline__ void p2_lorag(const Args& a, int G, const int wave) {
    const int lane = pg8::get_lane();
    const bf16_t* Zr = (const bf16_t*)(a.ws + WS_ZR); bf16_t* A2g = (bf16_t*)(a.ws + WS_A2);
    const float mu0 = a.in[9][1664 + 2 * lane], mu1 = a.in[9][1664 + 2 * lane + 1];
    const int gw = blockIdx.x * NWAVES + wave, NGW = G * NWAVES;
    for (int run = gw; run < MT / 16; run += NGW) {
        const int m0 = run * 16, t0 = m0 % T;
        unsigned rw[17];
        rw[0] = 0u; if (t0 > 0) rw[0] = *(const unsigned*)(Zr + (size_t)(m0 - 1) * RWIN + 1664 + 2 * lane);
#pragma unroll
        for (int i = 0; i < 16; ++i) rw[i + 1] = *(const unsigned*)(Zr + (size_t)(m0 + i) * RWIN + 1664 + 2 * lane);
#pragma unroll
        for (int i = 0; i < 16; ++i) { const float c0 = bflo(rw[i + 1]), c1 = bfhi(rw[i + 1]);
            *(unsigned*)(A2g + (size_t)(m0 + i) * 128 + 2 * lane) = cvt_pk_bf16(sigm(c0 + (bflo(rw[i]) - c0) * mu0), sigm(c1 + (bfhi(rw[i]) - c1) * mu1)); }
    }
}

typedef short s16x4 __attribute__((ext_vector_type(4)));
__device__ __forceinline__ f32x4 mfma16(const s16x4 x, const s16x4 y, const f32x4 c) { return __builtin_amdgcn_mfma_f32_16x16x16bf16_1k(x, y, c, 0, 0, 0); }
__device__ __forceinline__ unsigned short f2bf_bits(float f) { return (unsigned short)(cvt_pk_bf16(f, 0.f) & 0xffffu); }
__device__ __forceinline__ s16x4 pack4(const f32x4 v) { u32x2 w; w.x = cvt_pk_bf16(v[0], v[1]); w.y = cvt_pk_bf16(v[2], v[3]); return __builtin_bit_cast(s16x4, w); }
__device__ __forceinline__ float bf2f(unsigned short b) { return __builtin_bit_cast(float, (unsigned)b << 16); }
constexpr int NCHK = T / 16;

__device__ __forceinline__ bf16_t* bb_base(const Args& a, int b) {
    return (b < 7) ? (bf16_t*)((unsigned char*)a.out + 99 * MiB) : (bf16_t*)(a.ws + WS_A2 + 9 * MiB) - (size_t)7 * T * 512;
}
__device__ __forceinline__ float tanh_fast(float x) { return 1.f - 2.f * __builtin_amdgcn_rcpf(1.f + __expf(2.f * x)); }
constexpr int P4_WSTRIDE = 13568, P4_WL = 8 * P4_WSTRIDE  , P4_MU = P4_WL + 2 * 9216  ;

template <bool TAIL> __device__ __forceinline__ void p4a_fused(const Args& a, LAS unsigned char* lds, int G, const int wave, const int tail_b) {
    const int lane_o = pg8::get_lane();
    const bf16_t* Zr = (const bf16_t*)(a.ws + WS_ZR);
    bf16_t* Rb = (bf16_t*)a.out; bf16_t* Vb = (bf16_t*)((unsigned char*)a.out + 33 * MiB); bf16_t* Kb = (bf16_t*)((unsigned char*)a.out + 66 * MiB);
    bf16_t* KKb = (bf16_t*)(a.ws + WS_KK); bf16_t* Em = (bf16_t*)(a.ws + WS_EM); float* WCa = (float*)(a.ws + WS_WC);
    float* RKs = (float*)(a.ws + WS_RK);
    LAS unsigned char* wl = lds + wave * P4_WSTRIDE;
    LAS unsigned char* mt = wl + 4352;
    LAS float* Al = (LAS float*)(wl + 2048);
    LAS float* ST = (LAS float*)wl;
    constexpr int NVB = 8 * 32, NITEM = TAIL ? 1 : NB * 256;
    const bf16_t* WsmG = (const bf16_t*)(a.ws + WS_WSM);
    for (int vb = TAIL ? 0 : (int)blockIdx.x; vb < (TAIL ? 1 : NVB); vb += G) {
    const int h = TAIL ? wave : (vb & 7), q8 = TAIL ? -wave : (vb >> 3) * 8;
    if (!TAIL) {   const bf16_t* Wsm = (const bf16_t*)(a.ws + WS_WSM); const int tid = wave * 64 + lane_o;
#pragma unroll
        for (int i = 0; i < 2; ++i) { const int q = tid + NTHR * i, kind = q >> 9, ch = (q >> 3) & 63, pc = q & 7;
            *(LAS u32x4*)(lds + P4_WL + kind * 9216 + ch * 144 + pc * 16) = *(const u32x4*)(Wsm + (size_t)(kind * 512 + h * 64 + ch) * 256 + kind * 64 + pc * 8); }
        if (tid < 128) *(LAS float*)(lds + P4_MU + tid * 4) = a.in[9][1536 + tid];
        __syncthreads(); }
    const int chn_o = h * 64 + lane_o;
    const float mu_r = a.in[9][chn_o], mu_k = a.in[9][512 + chn_o], mu_v = a.in[9][1024 + chn_o], w0c = a.in[10][chn_o], a0c = a.in[12][chn_o], kkc = a.in[15][chn_o], kac = a.in[16][chn_o], rkc2 = a.in[17][chn_o];
    u32x4 n_r0, n_r1, n_k0, n_k1, n_v0, n_v1, n_lw0, n_lw1, n_la0, n_la1, n_pw0, n_pw1, n_pa0, n_pa1; unsigned short n_pr, n_pk, n_pv;
#define F_LOAD(bcx) do { const int b_ = TAIL ? tail_b : ((bcx) >> 8), c_ = TAIL ? NCHK - 1 : ((bcx) & 255); const size_t m0_ = (size_t)b_ * T + (size_t)c_ * 16; \
        const bf16_t* zp_ = Zr + (m0_ + prow) * RWIN + h * 64 + pp * 8; \
        n_r0 = *(const u32x4*)zp_; n_r1 = *(const u32x4*)(zp_ + 8 * RWIN); n_k0 = *(const u32x4*)(zp_ + 512); n_k1 = *(const u32x4*)(zp_ + 8 * RWIN + 512); \
        n_v0 = *(const u32x4*)(zp_ + 1024); n_v1 = *(const u32x4*)(zp_ + 8 * RWIN + 1024); \
        const bf16_t* zl_ = Zr + (m0_ + x) * RWIN + 1536 + 8 * g; \
        n_lw0 = *(const u32x4*)zl_; n_lw1 = *(const u32x4*)(zl_ + 32); n_la0 = *(const u32x4*)(zl_ + 64); n_la1 = *(const u32x4*)(zl_ + 96); \
        n_pw0 = (u32x4){0u, 0u, 0u, 0u}; n_pw1 = n_pw0; n_pa0 = n_pw0; n_pa1 = n_pw0; n_pr = 0; n_pk = 0; n_pv = 0; \
        if (c_ > 0) { const bf16_t* zq_ = Zr + (m0_ - 1) * RWIN; \
            n_pr = *(const unsigned short*)(zq_ + chn); n_pk = *(const unsigned short*)(zq_ + 512 + chn); n_pv = *(const unsigned short*)(zq_ + 1024 + chn); \
            n_pw0 = *(const u32x4*)(zq_ + 1536 + 8 * g); n_pw1 = *(const u32x4*)(zq_ + 1568 + 8 * g); n_pa0 = *(const u32x4*)(zq_ + 1600 + 8 * g); n_pa1 = *(const u32x4*)(zq_ + 1632 + 8 * g); } } while (0)
    if (q8 + wave < NITEM) { const int lane = lane_o, x = lane & 15, g = lane >> 4, prow = lane >> 3, pp = lane & 7, chn = h * 64 + lane; F_LOAD(q8 + wave); }
    for (int bc = q8 + wave; bc < NITEM; bc += NVB) {
        int lx_ = lane_o; asm volatile("" : "+v"(lx_)); const int lane = lx_, x = lane & 15, g = lane >> 4, prow = lane >> 3, pp = lane & 7, chn = h * 64 + lane;
        const int b = TAIL ? tail_b : (bc >> 8), c = TAIL ? NCHK - 1 : (bc & 255);
        const size_t m0 = (size_t)b * T + (size_t)c * 16;
        const size_t e0 = m0 * 512 + h * 64;
        const size_t pb = e0 + (size_t)prow * 512 + pp * 8;
        bf16_t* Bb = bb_base(a, b);
        bf16x8 Aw0, Aw1, Aa0, Aa1;
#define LORA_FRAG(DST, CUR, PRV, MUOFF, TANH) do { f32x4 ma_, mb_; if (TAIL) { ma_ = *(const f32x4*)(a.in[9] + 1536 + (MUOFF) + 8 * g); mb_ = *(const f32x4*)(a.in[9] + 1536 + (MUOFF) + 8 * g + 4); } \
            else { ma_ = *(const LAS f32x4*)(lds + P4_MU + ((MUOFF) + 8 * g) * 4); mb_ = *(const LAS f32x4*)(lds + P4_MU + ((MUOFF) + 8 * g) * 4 + 16); } \
            const float mm_[8] = {ma_[0], ma_[1], ma_[2], ma_[3], mb_[0], mb_[1], mb_[2], mb_[3]}; u32x4 o_; \
            _Pragma("unroll") for (int i = 0; i < 4; ++i) { const unsigned cw_ = CUR[i]; const unsigned pw_ = (unsigned)__builtin_amdgcn_update_dpp((int)PRV[i], (int)cw_, 0x111, 0xf, 0xf, false); \
                float zl_ = bflo(cw_), zh_ = bfhi(cw_); zl_ += (bflo(pw_) - zl_) * mm_[2 * i]; zh_ += (bfhi(pw_) - zh_) * mm_[2 * i + 1]; \
                if (TANH) { zl_ = tanh_fast(zl_); zh_ = tanh_fast(zh_); } o_[i] = cvt_pk_bf16(zl_, zh_); } \
            DST = __builtin_bit_cast(bf16x8, o_); } while (0)
        LORA_FRAG(Aw0, n_lw0, n_pw0, 0, true); LORA_FRAG(Aw1, n_lw1, n_pw1, 32, true); LORA_FRAG(Aa0, n_la0, n_pa0, 64, false); LORA_FRAG(Aa1, n_la1, n_pa1, 96, false);
#undef LORA_FRAG
        *(LAS u32x4*)(mt + prow * 128 + pp * 16) = n_k0; *(LAS u32x4*)(mt + (prow + 8) * 128 + pp * 16) = n_k1;
        *(LAS u32x4*)(mt + 2048 + prow * 128 + pp * 16) = n_v0; *(LAS u32x4*)(mt + 2048 + (prow + 8) * 128 + pp * 16) = n_v1;
        *(LAS u32x4*)(mt + 4096 + prow * 128 + pp * 16) = n_r0; *(LAS u32x4*)(mt + 4096 + (prow + 8) * 128 + pp * 16) = n_r1;
        const float p_r = bf2f(n_pr), p_k = bf2f(n_pk), p_v = bf2f(n_pv);
        LDS_WAIT(); asm volatile("" ::: "memory");
        { const int bcn = (bc + NVB < NITEM) ? bc + NVB : bc; F_LOAD(bcn); }
        float ev[16], av[16];
        {   f32x4 accW[4], accA[4]; const f32x4 z4 = {0.f, 0.f, 0.f, 0.f};
#pragma unroll
            for (int n = 0; n < 4; ++n) { bf16x8 bw0, bw1, ba0, ba1;
                if (TAIL) { const bf16_t* gw_ = WsmG + (size_t)(h * 64 + 16 * n + x) * 256 + 8 * g; const bf16_t* ga_ = gw_ + (size_t)512 * 256 + 64;
                    bw0 = *(const bf16x8*)gw_; bw1 = *(const bf16x8*)(gw_ + 32); ba0 = *(const bf16x8*)ga_; ba1 = *(const bf16x8*)(ga_ + 32); }
                else { const LAS unsigned char* wp = lds + P4_WL + (16 * n + x) * 144 + g * 16;
                    bw0 = *(const LAS bf16x8*)wp; bw1 = *(const LAS bf16x8*)(wp + 64); ba0 = *(const LAS bf16x8*)(wp + 9216); ba1 = *(const LAS bf16x8*)(wp + 9216 + 64); }
                accW[n] = __builtin_amdgcn_mfma_f32_16x16x32_bf16(Aw0, bw0, z4, 0, 0, 0); accW[n] = __builtin_amdgcn_mfma_f32_16x16x32_bf16(Aw1, bw1, accW[n], 0, 0, 0);
                accA[n] = __builtin_amdgcn_mfma_f32_16x16x32_bf16(Aa0, ba0, z4, 0, 0, 0); accA[n] = __builtin_amdgcn_mfma_f32_16x16x32_bf16(Aa1, ba1, accA[n], 0, 0, 0); }
#pragma unroll
            for (int n = 0; n < 4; ++n)
#pragma unroll
                for (int r = 0; r < 4; ++r) ST[(4 * g + r) * 68 + 16 * n + x] = accW[n][r];
            LDS_WAIT(); asm volatile("" ::: "memory");
#pragma unroll
            for (int t = 0; t < 16; ++t) ev[t] = 0.60653065971f * sigm(w0c + ST[t * 68 + lane]);
            LDS_WAIT(); asm volatile("" ::: "memory");
#pragma unroll
            for (int n = 0; n < 4; ++n)
#pragma unroll
                for (int r = 0; r < 4; ++r) ST[(4 * g + r) * 68 + 16 * n + x] = accA[n][r];
            LDS_WAIT(); asm volatile("" ::: "memory");
#pragma unroll
            for (int t = 0; t < 16; ++t) av[t] = sigm(a0c + ST[t * 68 + lane]);
            LDS_WAIT(); asm volatile("" ::: "memory");
        }
        float kkv[16], bv[16], kv[16], rv[16]; unsigned short vbits[16];
#define UNSTAGE_SHIFT(dst, OFF, PREV, MU) do { float pv_ = (PREV); _Pragma("unroll") for (int t = 0; t < 16; ++t) { const float c_ = bf2f(*(const LAS unsigned short*)(mt + (OFF) + t * 128 + lane * 2)); dst[t] = c_ + (pv_ - c_) * (MU); pv_ = c_; } } while (0)
        UNSTAGE_SHIFT(rv, 4096, p_r, mu_r); UNSTAGE_SHIFT(kv, 0, p_k, mu_k); UNSTAGE_SHIFT(bv, 2048, p_v, mu_v);
        LDS_WAIT(); asm volatile("" ::: "memory");
#pragma unroll
        for (int t = 0; t < 16; ++t) vbits[t] = f2bf_bits(bv[t]);
#undef UNSTAGE_SHIFT
        {
#pragma unroll
          for (int t = 0; t < 16; ++t) { kkv[t] = kv[t] * kkc; ST[t * 65 + lane] = kkv[t] * kkv[t]; }
          LDS_WAIT(); asm volatile("" ::: "memory");
          float s = 0.f;
#pragma unroll
          for (int j = 0; j < 16; ++j) s += ST[x * 65 + 16 * g + j];
          s += __shfl_xor(s, 16); s += __shfl_xor(s, 32);
          const int rnb = __builtin_bit_cast(int, __builtin_amdgcn_rsqf(fmaxf(s, 1e-24f)));
          LDS_WAIT(); asm volatile("" ::: "memory");
#pragma unroll
          for (int t = 0; t < 16; ++t) { const float rn = __builtin_bit_cast(float, __builtin_amdgcn_readlane(rnb, t));
              kkv[t] *= rn; bv[t] = kkv[t] * av[t]; kv[t] = kv[t] * (1.f + (av[t] - 1.f) * kac); } }
        {
#pragma unroll
          for (int t = 0; t < 16; ++t) *(LAS float*)(wl + (t * 65 + lane) * 4) = rv[t] * kv[t] * rkc2;
          LDS_WAIT(); asm volatile("" ::: "memory");
          float s = 0.f;
#pragma unroll
          for (int j = 0; j < 16; ++j) s += *(const LAS float*)(wl + (x * 65 + 16 * g + j) * 4);
          s += __shfl_xor(s, 16); s += __shfl_xor(s, 32);
          if (lane < 16) RKs[(m0 + lane) * 8 + h] = s;
          LDS_WAIT(); asm volatile("" ::: "memory"); }
        float lw = 0.f, wprev = 1.f; float bts[16], kts[16];
#pragma unroll
        for (int t = 0; t < 16; ++t) {
            lw -= ev[t]; const float wt = __expf(lw), iw = __expf(-lw);
            bts[t] = bv[t] * iw; kts[t] = kv[t] * iw;
            *(LAS unsigned short*)(mt + 0 * 2304 + t * 144 + lane * 2) = f2bf_bits(-kkv[t] * wprev); *(LAS unsigned short*)(mt + 1 * 2304 + t * 144 + lane * 2) = f2bf_bits(rv[t] * wt);
            *(LAS unsigned short*)(mt + 2 * 2304 + t * 144 + lane * 2) = f2bf_bits(bts[t]); *(LAS unsigned short*)(mt + 3 * 2304 + t * 144 + lane * 2) = f2bf_bits(kts[t]);
            wprev = wt;
        }
        const float wc = wprev;
        {
            const size_t o = e0 + (size_t)(lane >> 2) * 512 + (lane & 3) * 16;
            u32x4 w0, w1;
            w0.x = cvt_pk_bf16(bts[0] * wc, bts[1] * wc); w0.y = cvt_pk_bf16(bts[2] * wc, bts[3] * wc); w0.z = cvt_pk_bf16(bts[4] * wc, bts[5] * wc); w0.w = cvt_pk_bf16(bts[6] * wc, bts[7] * wc);
            w1.x = cvt_pk_bf16(bts[8] * wc, bts[9] * wc); w1.y = cvt_pk_bf16(bts[10] * wc, bts[11] * wc); w1.z = cvt_pk_bf16(bts[12] * wc, bts[13] * wc); w1.w = cvt_pk_bf16(bts[14] * wc, bts[15] * wc);
            *(u32x4*)(Bb + o) = w0; *(u32x4*)(Bb + o + 8) = w1;
            w0.x = cvt_pk_bf16(kts[0] * wc, kts[1] * wc); w0.y = cvt_pk_bf16(kts[2] * wc, kts[3] * wc); w0.z = cvt_pk_bf16(kts[4] * wc, kts[5] * wc); w0.w = cvt_pk_bf16(kts[6] * wc, kts[7] * wc);
            w1.x = cvt_pk_bf16(kts[8] * wc, kts[9] * wc); w1.y = cvt_pk_bf16(kts[10] * wc, kts[11] * wc); w1.z = cvt_pk_bf16(kts[12] * wc, kts[13] * wc); w1.w = cvt_pk_bf16(kts[14] * wc, kts[15] * wc);
            *(u32x4*)(Kb + o) = w0; *(u32x4*)(Kb + o + 8) = w1;
            w0.x = vbits[0] | ((unsigned)vbits[1] << 16); w0.y = vbits[2] | ((unsigned)vbits[3] << 16); w0.z = vbits[4] | ((unsigned)vbits[5] << 16); w0.w = vbits[6] | ((unsigned)vbits[7] << 16);
            w1.x = vbits[8] | ((unsigned)vbits[9] << 16); w1.y = vbits[10] | ((unsigned)vbits[11] << 16); w1.z = vbits[12] | ((unsigned)vbits[13] << 16); w1.w = vbits[14] | ((unsigned)vbits[15] << 16);
            *(u32x4*)(Vb + o) = w0; *(u32x4*)(Vb + o + 8) = w1;
        }
        LDS_WAIT(); asm volatile("" ::: "memory");
        { const u32x4 a0 = *(const LAS u32x4*)(mt + 0 * 2304 + prow * 144 + pp * 16), a1 = *(const LAS u32x4*)(mt + 0 * 2304 + (prow + 8) * 144 + pp * 16);
          const u32x4 r0 = *(const LAS u32x4*)(mt + 1 * 2304 + prow * 144 + pp * 16), r1 = *(const LAS u32x4*)(mt + 1 * 2304 + (prow + 8) * 144 + pp * 16);
          *(u32x4*)(KKb + pb) = a0; *(u32x4*)(KKb + pb + 8 * 512) = a1; *(u32x4*)(Rb + pb) = r0; *(u32x4*)(Rb + pb + 8 * 512) = r1; }
        { int ly_ = lane_o; asm volatile("" : "+v"(ly_)); const int lane = ly_, x = lane & 15, g = lane >> 4, prow = lane >> 3, pp = lane & 7;
        f32x4 Aab = {0.f, 0.f, 0.f, 0.f}, Aak = Aab, Arb = Aab, Ark = Aab;
#pragma unroll
        for (int s = 0; s < 4; ++s) {
            const int fo = x * 144 + (16 * s + 4 * g) * 2;
            const s16x4 aF = *(const LAS s16x4*)(mt + 0 * 2304 + fo), rF = *(const LAS s16x4*)(mt + 1 * 2304 + fo), bF = *(const LAS s16x4*)(mt + 2 * 2304 + fo), kF = *(const LAS s16x4*)(mt + 3 * 2304 + fo);
            Aab = mfma16(aF, bF, Aab); Aak = mfma16(aF, kF, Aak); Arb = mfma16(rF, bF, Arb); Ark = mfma16(rF, kF, Ark);
        }
#pragma unroll
        for (int r = 0; r < 4; ++r) { const int t = 4 * g + r; if (!(x < t)) { Aab[r] = 0.f; Aak[r] = 0.f; } if (!(x <= t)) { Arb[r] = 0.f; Ark[r] = 0.f; }
            Al[t * 16 + x] = Aab[r];
            *(LAS unsigned short*)(wl + t * 128 + 32 + 2 * x) = f2bf_bits(Arb[r]); *(LAS unsigned short*)(wl + t * 128 + 64 + 2 * x) = f2bf_bits(Aak[r]); *(LAS unsigned short*)(wl + t * 128 + 96 + 2 * x) = f2bf_bits(Ark[r]); }
        LDS_WAIT(); asm volatile("" ::: "memory");
        float Trow[16];
#pragma unroll
        for (int t = 0; t < 16; ++t) {
            const f32x4 a0 = *(const LAS f32x4*)(Al + t * 16), a1 = *(const LAS f32x4*)(Al + t * 16 + 4), a2 = *(const LAS f32x4*)(Al + t * 16 + 8), a3 = *(const LAS f32x4*)(Al + t * 16 + 12);
            const float ar[16] = {a0[0], a0[1], a0[2], a0[3], a1[0], a1[1], a1[2], a1[3], a2[0], a2[1], a2[2], a2[3], a3[0], a3[1], a3[2], a3[3]};
            float acc = (x == t) ? 1.f : 0.f;
#pragma unroll
            for (int j = 0; j < 16; ++j) if (j < t) acc = fmaf(ar[j], Trow[j], acc);
            Trow[t] = acc;
        }
        if (g == 0) {
#pragma unroll
            for (int t = 0; t < 16; ++t) *(LAS unsigned short*)(wl + t * 128 + 2 * x) = f2bf_bits(Trow[t]);
        }
        LDS_WAIT(); asm volatile("" ::: "memory");
        { const u32x4 m0v = *(const LAS u32x4*)(wl + prow * 128 + pp * 16), m1v = *(const LAS u32x4*)(wl + (prow + 8) * 128 + pp * 16);
          *(u32x4*)(Em + pb) = m0v; *(u32x4*)(Em + pb + 8 * 512) = m1v;
          WCa[((size_t)(b * NHEAD + h) * NCHK + c) * 64 + lane] = wc; }
        LDS_WAIT(); asm volatile("" ::: "memory");
        }
    }
    __syncthreads();
    }
#undef F_LOAD
}

struct ScanOps { s16x4 Af[4], Rf[4], Mf[4], BTf[4], KTf[4], VTf; f32x4 WCf[4]; };
constexpr int RS_STRIDE = 13824, RS_NSLOT = 3, RS_OBUF = RS_NSLOT * RS_STRIDE;
constexpr int SCAN_NIT = 264;
__device__ __forceinline__ int rs_mk(int low3) { return low3 | (((low3 >> 2) & 1) << 3); }
__device__ __forceinline__ int rs_mig(int i, int g) { return rs_mk(2 * i + (g >> 1)); }
__device__ __forceinline__ int rs_mgh(int g, int h) { return rs_mk(2 * ((g >> 1) * 2 + h)); }
__device__ __forceinline__ s16x4 lo64(const u32x4 v) { const u32x2 w = {v.x, v.y}; return __builtin_bit_cast(s16x4, w); }
__device__ __forceinline__ s16x4 hi64(const u32x4 v) { const u32x2 w = {v.z, v.w}; return __builtin_bit_cast(s16x4, w); }
__device__ __forceinline__ void scan_frag_read(ScanOps& o, LAS unsigned char* slot, const int (&oar)[4], const int (&om)[2], const int ov, const int g) {
#pragma unroll
    for (int i = 0; i < 4; ++i) {
        const u32x4 ar = *(const LAS u32x4*)(slot + oar[i]), bk = *(const LAS u32x4*)(slot + 4096 + oar[i]);
        o.Af[i] = lo64(ar); o.Rf[i] = hi64(ar); o.BTf[i] = lo64(bk); o.KTf[i] = hi64(bk);
        o.WCf[i] = *(const LAS f32x4*)(slot + 12800 + (4 * i + g) * 16); }
    const u32x4 m0 = *(const LAS u32x4*)(slot + 8192 + om[0]), m1 = *(const LAS u32x4*)(slot + 8192 + om[1]);
    o.Mf[0] = lo64(m0); o.Mf[1] = hi64(m0); o.Mf[2] = lo64(m1); o.Mf[3] = hi64(m1);
    o.VTf = *(const LAS s16x4*)(slot + 10240 + ov);
}
__device__ __forceinline__ void scan_step(const ScanOps& o, f32x4 (&Sacc)[4], s16x4 (&Sb)[4], LAS float* ob, int x, int g, int w) {
    const f32x4 z = {0.f, 0.f, 0.f, 0.f};
    f32x4 X = mfma16(o.Mf[2], o.VTf, z);
#pragma unroll
    for (int i = 0; i < 4; ++i) X = mfma16(o.Af[i], Sb[i], X);
    const s16x4 Xb = pack4(X);
    const f32x4 U = mfma16(o.Mf[0], Xb, z); const s16x4 Ub = pack4(U);
    f32x4 Oc = mfma16(o.Mf[3], o.VTf, z);
#pragma unroll
    for (int i = 0; i < 4; ++i) Oc = mfma16(o.Rf[i], Sb[i], Oc);
    Oc = mfma16(o.Mf[1], Ub, Oc);
#pragma unroll
    for (int i = 0; i < 4; ++i) { f32x4 s = Sacc[i] * o.WCf[i]; s = mfma16(o.KTf[i], o.VTf, s); s = mfma16(o.BTf[i], Ub, s); Sacc[i] = s; Sb[i] = pack4(s); }
#pragma unroll
    for (int r = 0; r < 4; ++r) ob[(4 * g + r) * 64 + 16 * w + x] = Oc[r];
}

__device__ __forceinline__ void p4b_chain(const Args& a, LAS unsigned char* lds, int G, const int wave) {
    const int lane = pg8::get_lane(), x = lane & 15, g = lane >> 4;
    const bf16_t* Rb = (const bf16_t*)a.out; const bf16_t* Vb = (const bf16_t*)((unsigned char*)a.out + 33 * MiB); const bf16_t* Kb = (const bf16_t*)((unsigned char*)a.out + 66 * MiB);
    const bf16_t* KKb = (const bf16_t*)(a.ws + WS_KK);
    const bf16_t* Em = (const bf16_t*)(a.ws + WS_EM); const float* WCa = (const float*)(a.ws + WS_WC); bf16_t* ORAW = (bf16_t*)(a.ws + WS_ORAW);
    LAS float* obuf = (LAS float*)(lds + RS_OBUF);
#define SCAN_BAR() do { asm volatile("s_waitcnt lgkmcnt(0)" ::: "memory"); __builtin_amdgcn_s_barrier(); asm volatile("" ::: "memory"); } while (0)
    for (int it = blockIdx.x; it < NB * NHEAD; it += G) {
        const int b = it >> 3, h = it & 7;
        const bf16_t* Bb = bb_base(a, b);
        const size_t ebase = (size_t)b * T * 512 + h * 64;
        const int sb0 = (int)(ebase * 2);
        if (wave < 4) {
            f32x4 Sacc[4]; s16x4 Sb[4];
#pragma unroll
            for (int i = 0; i < 4; ++i) { Sacc[i] = (f32x4){0.f, 0.f, 0.f, 0.f}; Sb[i] = (s16x4){0, 0, 0, 0}; }
            int oar[4], om[2];
#pragma unroll
            for (int i = 0; i < 4; ++i) oar[i] = (4 * i + g) * 256 + ((x ^ rs_mig(i, g)) * 16);
            om[0] = (2 * g) * 256 + ((x ^ rs_mgh(g, 0)) * 16); om[1] = (2 * g + 1) * 256 + ((x ^ rs_mgh(g, 1)) * 16);
            const int ov = g * 640 + (16 * wave + x) * 8;
            SCAN_BAR();
            ScanOps opA, opB;
            scan_frag_read(opA, lds, oar, om, ov, g);
#define CONS_ITER(cc, CUR, NXT) do { { const int sn_ = ((cc) + 1) % 3; scan_frag_read(NXT, lds + sn_ * RS_STRIDE, oar, om, ov, g); } \
                if ((cc) < NCHK) scan_step(CUR, Sacc, Sb, obuf + ((cc) & 1) * 1024, x, g, wave); SCAN_BAR(); } while (0)
            for (int cc = 0; cc < SCAN_NIT; cc += 2) { CONS_ITER(cc, opA, opB); CONS_ITER(cc + 1, opB, opA); }
#undef CONS_ITER
        } else {
            __builtin_amdgcn_s_setprio(2);
            const int lw = wave - 4, hf = lw & 1, prow = 8 * hf + (lane >> 3), pp = lane & 7;
            const __amdgpu_buffer_rsrc_t rs0 = __builtin_amdgcn_make_buffer_rsrc((void*)(lw < 2 ? KKb : Rb), 0, 0x7fffffff, 0x00020000);
            const __amdgpu_buffer_rsrc_t rs1 = __builtin_amdgcn_make_buffer_rsrc((void*)(lw < 2 ? Bb : Kb), 0, 0x7fffffff, 0x00020000);
            const __amdgpu_buffer_rsrc_t rs2 = __builtin_amdgcn_make_buffer_rsrc((void*)(lw < 2 ? (const void*)Vb : (const void*)Em), 0, 0x7fffffff, 0x00020000);
            const __amdgpu_buffer_rsrc_t rsE = __builtin_amdgcn_make_buffer_rsrc((void*)WCa, 0, 0x7fffffff, 0x00020000), rsO = __builtin_amdgcn_make_buffer_rsrc((void*)ORAW, 0, 0x7fffffff, 0x00020000);
            const int vo01 = prow * 1024 + pp * 16;
            const int voW = (lane & 15) * 16, wcb0 = it * NCHK * 256;
            const int hi8 = (lw < 2) ? 0 : 8;
            int w0a[2], w1a[2], w2a[2];
#pragma unroll
            for (int hl = 0; hl < 2; ++hl) { const int gg = 2 * (pp & 1) + hl, ii = pp >> 1;
                w0a[hl] = (4 * ii + gg) * 256 + ((prow ^ rs_mig(ii, gg)) * 16) + hi8;
                const int kr = 4 * prow + (pp >> 1), ki = kr >> 4, kx = kr & 15;
                w1a[hl] = 4096 + (4 * ki + gg) * 256 + ((kx ^ rs_mig(ki, gg)) * 16) + hi8;
                w2a[hl] = (lw < 2) ? (10240 + gg * 640 + kr * 8) : (8192 + (2 * gg + (ii >> 1)) * 256 + ((prow ^ rs_mgh(gg, ii >> 1)) * 16) + 8 * (ii & 1)); }
            const int ldW = 12800 + (lane & 15) * 16;
            struct RSet { u32x4 r0, r1, r2, rw; };
            RSet s0, s1, s2, s3, s4, s5, s6, s7;
#define RING_LOAD(S, chunk) do { const int cn_ = ((chunk) < NCHK) ? (chunk) : NCHK - 1; const int so_ = sb0 + cn_ * 16 * 1024; \
                S.r0 = __builtin_amdgcn_raw_buffer_load_b128(rs0, vo01, so_, 0); S.r1 = __builtin_amdgcn_raw_buffer_load_b128(rs1, vo01, so_, 0); \
                S.r2 = __builtin_amdgcn_raw_buffer_load_b128(rs2, vo01, so_, 0); S.rw = __builtin_amdgcn_raw_buffer_load_b128(rsE, voW, wcb0 + cn_ * 256, 0); } while (0)
#define RING_WRITE(S, slotp) do { LAS unsigned char* sp_ = (slotp); \
                *(LAS u32x2*)(sp_ + w0a[0]) = (u32x2){S.r0.x, S.r0.y}; *(LAS u32x2*)(sp_ + w0a[1]) = (u32x2){S.r0.z, S.r0.w}; \
                *(LAS u32x2*)(sp_ + w1a[0]) = (u32x2){S.r1.x, S.r1.y}; *(LAS u32x2*)(sp_ + w1a[1]) = (u32x2){S.r1.z, S.r1.w}; \
                *(LAS u32x2*)(sp_ + w2a[0]) = (u32x2){S.r2.x, S.r2.y}; *(LAS u32x2*)(sp_ + w2a[1]) = (u32x2){S.r2.z, S.r2.w}; \
                if (lw == 0 && lane < 16) *(LAS u32x4*)(sp_ + ldW) = S.rw; } while (0)
            RING_LOAD(s0, 0); RING_LOAD(s1, 1); RING_LOAD(s2, 2); RING_LOAD(s3, 3); RING_LOAD(s4, 4); RING_LOAD(s5, 5); RING_LOAD(s6, 6); RING_LOAD(s7, 7);
            RING_WRITE(s0, lds); RING_LOAD(s0, 8); RING_WRITE(s1, lds + RS_STRIDE);
            SCAN_BAR();
#define LOADER_ITER(cc, WS, LS) do { \
                RING_WRITE(WS, lds + (((cc) + 2) % 3) * RS_STRIDE); RING_LOAD(LS, (cc) + 9); \
                if ((cc) >= 1 && (cc) <= NCHK) { const int pc = (cc) - 1; const LAS float* ob = obuf + (pc & 1) * 1024; \
                    _Pragma("unroll") for (int q = 0; q < 4; ++q) { const int ts = 4 * lw + q; \
                        __builtin_amdgcn_raw_buffer_store_b16(f2bf_bits(ob[ts * 64 + lane]), rsO, 2 * lane, sb0 + (pc * 16 + ts) * 1024, 0); } } \
                SCAN_BAR(); } while (0)
            static_assert(SCAN_NIT % 8 == 0 && SCAN_NIT > NCHK, "loader iterations come in eights");
            for (int cc = 0; cc < SCAN_NIT; cc += 8) { LOADER_ITER(cc, s2, s1); LOADER_ITER(cc + 1, s3, s2); LOADER_ITER(cc + 2, s4, s3); LOADER_ITER(cc + 3, s5, s4);
                                                      LOADER_ITER(cc + 4, s6, s5); LOADER_ITER(cc + 5, s7, s6); LOADER_ITER(cc + 6, s0, s7); LOADER_ITER(cc + 7, s1, s0); }
#undef LOADER_ITER
            __builtin_amdgcn_s_setprio(0);
#undef RING_WRITE
#undef RING_LOAD
        }
        __syncthreads();
    }
#undef SCAN_BAR
}

__device__ __forceinline__ void p4c_post(const Args& a, int G, const int wave) {
    const int lane = pg8::get_lane();
    const bf16_t* ORAW = (const bf16_t*)(a.ws + WS_ORAW); const bf16_t* Vb = (const bf16_t*)((unsigned char*)a.out + 33 * MiB); const bf16_t* Gb = (const bf16_t*)(a.ws + WS_ZR + 33 * MiB);
    const float* RKs = (const float*)(a.ws + WS_RK); bf16_t* ACR = (bf16_t*)(a.ws + WS_XN);
    const float* gn_g = a.in[18]; const float* gn_b = a.in[19];
    const int gw = blockIdx.x * NWAVES + wave, NGW = G * NWAVES;
    for (int m2 = gw; m2 < M2; m2 += NGW) {
        const int b = m2 >> 12, t = (m2 & 4095) + NMETA; const size_t m = (size_t)b * T + t;
        const int c = t >> 4, ts = t & 15;
        const float rkv = (lane < 8) ? RKs[m * 8 + lane] : 0.f;
#pragma unroll
        for (int h = 0; h < NHEAD; ++h) {
            const float o = bf2f(ORAW[m * 512 + h * 64 + lane]);
            const float vv = bf2f(Vb[((size_t)b * T + c * 16 + (lane >> 2)) * 512 + h * 64 + (lane & 3) * 16 + ts]);
            const float gg = bf2f(Gb[m * 512 + h * 64 + lane]);
            const float s1 = wave_sum(o), s2 = wave_sum(o * o);
            const float mean = s1 * (1.f / 64.f), var = fmaxf(s2 * (1.f / 64.f) - mean * mean, 0.f);
            const float rk = __builtin_bit_cast(float, __builtin_amdgcn_readlane(__builtin_bit_cast(int, rkv), h));
            const float res = ((o - mean) * (1.f / sqrtf(var + 64e-5f)) * gn_g[h * 64 + lane] + gn_b[h * 64 + lane] + rk * vv) * gg;
            ACR[(size_t)m2 * 512 + h * 64 + lane] = f2bf_bits(res);
        }
    }
}

#define CE_DESC(x, y) do { const float _hi = fmaxf((x), (y)), _lo = fminf((x), (y)); (x) = _hi; (y) = _lo; } while (0)
__device__ __forceinline__ void sort16_desc(float (&v)[16]) {
#pragma unroll
    for (int k = 2; k <= 16; k <<= 1) {
#pragma unroll
        for (int j = k >> 1; j > 0; j >>= 1) {
#pragma unroll
            for (int i = 0; i < 16; ++i) { const int l = i ^ j; if (l > i) { if ((i & k) == 0) CE_DESC(v[i], v[l]); else CE_DESC(v[l], v[i]); } }
        }
    }
}
__device__ __forceinline__ void merge16(float (&x)[16], const float (&y)[16]) {
#pragma unroll
    for (int i = 0; i < 16; ++i) x[i] = fmaxf(x[i], y[15 - i]);
#pragma unroll
    for (int j = 8; j > 0; j >>= 1) {
#pragma unroll
        for (int i = 0; i < 16; ++i) { const int l = i ^ j; if (l > i) CE_DESC(x[i], x[l]); }
    }
}
__device__ __forceinline__ void xmerge16(float (&x)[16], int mask) {
    float y[16];
#pragma unroll
    for (int i = 0; i < 16; ++i) y[i] = __shfl_xor(x[i], mask);
    merge16(x, y);
}
__device__ __forceinline__ float pk_low(float x, unsigned code, unsigned keep_mask) { return __builtin_bit_cast(float, (__builtin_bit_cast(unsigned, x) & keep_mask) | code); }

__device__ __forceinline__ void p9_topk(const Args& a, LAS unsigned char* lds, int G, const int wave) {
    const int lane = pg8::get_lane(), tid = wave * 64 + lane;
    const bf16_t* Q = (const bf16_t*)(a.ws + WS_ZG); const bf16_t* SK = (const bf16_t*)(a.ws + WS_SK);
    int* TKid = (int*)(a.ws + WS_KK); float* TKg = (float*)(a.ws + WS_KK + 16 * MiB);
    LAS unsigned char* wl = lds + 65536 + wave * 512;
    const int fr = lane & 15, fq = lane >> 4;
    const bool aligned = (G % 8 == 0);
    const int nhb = aligned ? G / 8 : G, rank = aligned ? (int)(blockIdx.x >> 3) : (int)blockIdx.x;
    constexpr int NGRP = M2 / 16;
    for (int h = aligned ? (int)(blockIdx.x & 7) : 0; h < PH; h += aligned ? 8 : 1) {
        __syncthreads();
#pragma unroll
        for (int k = 0; k < 8; ++k) { const int pi = wave * 64 + lane + 512 * k, c = pi >> 11, row = (pi >> 4) & 127, pp = pi & 15;
            const u32x4 v = *(const u32x4*)(SK + ((size_t)(h * 2 + c) * 128 + row) * 128 + pp * 8);
            *(LAS u32x4*)(lds + c * 32768 + row * 256 + ((pp ^ (row & 15)) * 16)) = v; }
        __syncthreads();
    for (int grp = rank * NWAVES + wave; grp < NGRP; grp += nhb * NWAVES) {
        const int tok0 = grp * 16;
        float top[2][16];
#pragma unroll
        for (int c = 0; c < 2; ++c) {
            f32x4 acc[8];
#pragma unroll
            for (int nt = 0; nt < 8; ++nt) acc[nt] = (f32x4){0.f, 0.f, 0.f, 0.f};
            const bf16_t* qrow = Q + (size_t)(tok0 + fr) * 2048 + h * 256 + c * 128 + fq * 8;
            bf16x8 qf[4];
#pragma unroll
            for (int ks = 0; ks < 4; ++ks) qf[ks] = *(const bf16x8*)(qrow + ks * 32);
            const LAS unsigned char* skl = lds + c * 32768 + fr * 256;
#pragma unroll
            for (int nt = 0; nt < 8; ++nt)
#pragma unroll
                for (int ks = 0; ks < 4; ++ks) { const bf16x8 kf = *(const LAS bf16x8*)(skl + nt * 4096 + (((4 * ks + fq) ^ fr) * 16));
                    acc[nt] = __builtin_amdgcn_mfma_f32_16x16x32_bf16(kf, qf[ks], acc[nt], 0, 0, 0); }
            float lo[16], hi[16];
#pragma unroll
            for (int nt = 0; nt < 4; ++nt)
#pragma unroll
                for (int r = 0; r < 4; ++r) { lo[nt * 4 + r] = pk_low(acc[nt][r], (unsigned)(16 * nt + 4 * fq + r), 0xffffff80u); hi[nt * 4 + r] = pk_low(acc[nt + 4][r], (unsigned)(16 * (nt + 4) + 4 * fq + r), 0xffffff80u); }
            sort16_desc(lo); sort16_desc(hi); merge16(lo, hi); xmerge16(lo, 16); xmerge16(lo, 32);
#pragma unroll
            for (int i = 0; i < 16; ++i) top[c][i] = lo[i];
        }
        float cand[16];
        const float PAD = -3.0e38f;
#pragma unroll
        for (int s = 0; s < 16; ++s) {
            const int i1 = (s < 8) ? 1 : (s < 13) ? 2 : 4, j1 = (s < 8) ? s : (s < 13) ? s - 8 : s - 13;
            const int i2 = (s < 4) ? 3 : (s < 6) ? 5 : (s < 8) ? 6 : 7, j2 = (s < 4) ? s : (s < 6) ? s - 4 : (s < 8) ? s - 6 : s - 8;
            const float c0 = pk_low(top[0][0] + top[1][s], (unsigned)s, 0xffffff00u);
            const float c1 = pk_low(top[0][i1] + top[1][j1], (unsigned)(i1 * 16 + j1), 0xffffff00u);
            const float c2 = (s < 10) ? pk_low(top[0][i2] + top[1][j2], (unsigned)(i2 * 16 + j2), 0xffffff00u) : PAD;
            const float c3 = (s < 8) ? pk_low(top[0][8 + s] + top[1][0], (unsigned)((8 + s) * 16), 0xffffff00u) : PAD;
            cand[s] = (fq == 0) ? c0 : (fq == 1) ? c1 : (fq == 2) ? c2 : c3;
        }
        sort16_desc(cand); xmerge16(cand, 16); xmerge16(cand, 32);
        if (fq == 0) {
            u32x4 wa, wb; unsigned pa[4], pb[4];
#pragma unroll
            for (int g = 0; g < 4; ++g) { pa[g] = 0u; pb[g] = 0u;
#pragma unroll
                for (int j = 0; j < 4; ++j) { pa[g] |= (__builtin_bit_cast(unsigned, top[0][4 * g + j]) & 0x7fu) << (8 * j); pb[g] |= (__builtin_bit_cast(unsigned, top[1][4 * g + j]) & 0x7fu) << (8 * j); } }
            wa.x = pa[0]; wa.y = pa[1]; wa.z = pa[2]; wa.w = pa[3]; wb.x = pb[0]; wb.y = pb[1]; wb.z = pb[2]; wb.w = pb[3];
            *(LAS u32x4*)(wl + fr * 32) = wa; *(LAS u32x4*)(wl + fr * 32 + 16) = wb;
            LDS_WAIT();
            float p[16], sum = 0.f; int eid[16];
            const float mx = cand[0];
#pragma unroll
            for (int i = 0; i < 16; ++i) { p[i] = __expf(cand[i] - mx); sum += p[i];
                const unsigned code = __builtin_bit_cast(unsigned, cand[i]) & 0xffu;
                const int i1 = wl[fr * 32 + (code >> 4)], i2 = wl[fr * 32 + 16 + (code & 15u)];
                eid[i] = i1 * PK + i2; }
            const float inv = 1.f / sum;
            int* ip = TKid + (size_t)(tok0 + fr) * 128 + h * 16; float* gp = TKg + (size_t)(tok0 + fr) * 128 + h * 16;
#pragma unroll
            for (int g = 0; g < 4; ++g) { *(int4*)(ip + 4 * g) = make_int4(eid[4 * g], eid[4 * g + 1], eid[4 * g + 2], eid[4 * g + 3]);
                *(f32x4*)(gp + 4 * g) = (f32x4){p[4 * g] * inv, p[4 * g + 1] * inv, p[4 * g + 2] * inv, p[4 * g + 3] * inv}; }
            LDS_WAIT();
        }
    }
    }
}

typedef __bf16 bf16v2 __attribute__((ext_vector_type(2)));
__device__ __forceinline__ float dot2bf(unsigned x, unsigned y, float acc) { return __builtin_amdgcn_fdot2_f32_bf16(__builtin_bit_cast(bf16v2, x), __builtin_bit_cast(bf16v2, y), acc, false); }
__device__ __forceinline__ float gelu_exact(float x) { return 0.5f * x * (1.f + erff(x * 0.70710678118f)); }

typedef float f32x2 __attribute__((ext_vector_type(2)));
struct XcdPart { unsigned nloc, nx, rnk, kx; };
typedef long i64_t;
__device__ __forceinline__ i64_t pack64(unsigned lo, unsigned hi) { const u32x2 w = {lo, hi}; return __builtin_bit_cast(i64_t, w); }
__device__ __forceinline__ void pu_partial(const Args& a, LAS unsigned char* lds, const int wave, const XcdPart xp) {
    const int lane = pg8::get_lane(), j16 = lane & 15, kq = lane >> 4;
    const bf16_t* H1b = (const bf16_t*)(a.ws + WS_ZC); const int* TKid = (const int*)(a.ws + WS_KK); const float* ssq = (const float*)(a.ws + WS_SSQ);
    const unsigned char* EU = a.ws + WS_EU; bf16_t* PART = (bf16_t*)(a.ws + WS_ZG);
    const int t_first = (int)xp.rnk * NWAVES + wave, t_stride = (int)xp.nloc * NWAVES;
    const int nt = (t_first < M2) ? (M2 - t_first + t_stride - 1) / t_stride : 0;
    if (nt == 0) return;
    const __amdgpu_buffer_rsrc_t rP = __builtin_amdgcn_make_buffer_rsrc((void*)PART, 0, 0x7fffffff, 0x00020000);
    LAS unsigned char* wl = lds + wave * 16384; LAS unsigned char* xs = lds + 132096 + wave * 128; LAS unsigned char* la = lds + 133120 + wave * 1664;
    const int pz0 = ((lane & 7) ^ (lane >> 4)) * 16, pz1 = ((lane & 7) ^ (4 + (lane >> 4))) * 16;
    const int mm = (j16 >> 1) & 7, rob = (j16 >> 3) * 1024 + (j16 & 7) * 128;
    const int ro0 = rob + (((2 * kq) ^ mm) * 16), ro1 = rob + (((2 * kq + 1) ^ mm) * 16);
    const f32x4 z4 = {0.f, 0.f, 0.f, 0.f};
    for (int s = (int)xp.kx; s < 8; s += (int)xp.nx) {
        const unsigned char* EUs = EU + 128 * s;
        i64_t xc[4];
#define PU_X(j) do { const int jc_ = ((j) < nt) ? (j) : nt - 1; const int tk_ = t_first + jc_ * t_stride; LAS unsigned char* sl_ = la + ((j) & 1) * 832; \
            __builtin_amdgcn_global_load_lds((const unsigned*)(TKid + (size_t)tk_ * 128 + lane), (LAS unsigned*)sl_, 4, 0, 0); \
            __builtin_amdgcn_global_load_lds((const unsigned*)(TKid + (size_t)tk_ * 128 + 64 + lane), (LAS unsigned*)(sl_ + 256), 4, 0, 0); \
            __builtin_amdgcn_global_load_lds((const unsigned*)(H1b + (size_t)tk_ * 1024 + 128 * s + 2 * lane), (LAS unsigned*)(sl_ + 512), 4, 0, 0); \
            if (lane == 0) __builtin_amdgcn_global_load_lds((const unsigned*)(ssq + tk_), (LAS unsigned*)(sl_ + 768), 4, 0, 0); } while (0)
#define PU_X8(j) do { const LAS unsigned char* sl_ = la + ((j) & 1) * 832; const u32x4 X = *(const LAS u32x4*)(sl_ + 512 + 16 * j16); const float sq_ = *(const LAS float*)(sl_ + 768); \
            const float sc_ = 16.f * __builtin_amdgcn_rsqf(sq_ * (1.f / 1024.f) + 1e-6f); \
            int p0_ = 0, p1_ = 0; \
            p0_ = __builtin_amdgcn_cvt_pk_fp8_f32(bflo(X.x) * sc_, bfhi(X.x) * sc_, p0_, false); p0_ = __builtin_amdgcn_cvt_pk_fp8_f32(bflo(X.y) * sc_, bfhi(X.y) * sc_, p0_, true); \
            p1_ = __builtin_amdgcn_cvt_pk_fp8_f32(bflo(X.z) * sc_, bfhi(X.z) * sc_, p1_, false); p1_ = __builtin_amdgcn_cvt_pk_fp8_f32(bflo(X.w) * sc_, bfhi(X.w) * sc_, p1_, true); \
            *(LAS u32x2*)(xs + 8 * j16) = (u32x2){(unsigned)p0_, (unsigned)p1_}; LDS_WAIT(); asm volatile("" ::: "memory"); \
            const u32x4 xa_ = *(const LAS u32x4*)(xs + 32 * kq), xb_ = *(const LAS u32x4*)(xs + 32 * kq + 16); LDS_WAIT(); asm volatile("" ::: "memory"); \
            xc[0] = pack64(xa_.x, xa_.y); xc[1] = pack64(xa_.z, xa_.w); xc[2] = pack64(xb_.x, xb_.y); xc[3] = pack64(xb_.z, xb_.w); } while (0)
#define PU_Q(j, c) do { const LAS unsigned char* sl_ = la + ((j) & 1) * 832; _Pragma("unroll") for (int w_ = 0; w_ < 4; ++w_) { \
            const unsigned id_ = *(const LAS unsigned*)(sl_ + 4 * (32 * (c) + 8 * w_ + (lane >> 3))); \
            const unsigned char* gp_ = EUs + ((size_t)id_ << 10) + ((w_ & 1) ? pz1 : pz0); \
            __builtin_amdgcn_global_load_lds((const unsigned*)gp_, (LAS unsigned*)(wl + (c) * 4096 + w_ * 1024), 16, 0, 1); } } while (0)
#define PU_G(ACC, P0, P1) do { ACC = __builtin_amdgcn_mfma_f32_16x16x32_fp8_fp8(xc[0], pack64(P0.x, P0.y), z4, 0, 0, 0); ACC = __builtin_amdgcn_mfma_f32_16x16x32_fp8_fp8(xc[1], pack64(P0.z, P0.w), ACC, 0, 0, 0); \
            ACC = __builtin_amdgcn_mfma_f32_16x16x32_fp8_fp8(xc[2], pack64(P1.x, P1.y), ACC, 0, 0, 0); ACC = __builtin_amdgcn_mfma_f32_16x16x32_fp8_fp8(xc[3], pack64(P1.z, P1.w), ACC, 0, 0, 0); } while (0)
#define PU_C(ACC0, ACC1, c) do { asm volatile("s_waitcnt vmcnt(16)" ::: "memory"); \
            const u32x4 a0_ = *(const LAS u32x4*)(wl + (c) * 4096 + ro0), a1_ = *(const LAS u32x4*)(wl + (c) * 4096 + ro1), b0_ = *(const LAS u32x4*)(wl + (c) * 4096 + 2048 + ro0), b1_ = *(const LAS u32x4*)(wl + (c) * 4096 + 2048 + ro1); \
            LDS_WAIT(); asm volatile("" ::: "memory");        \
            PU_G(ACC0, a0_, a1_); PU_G(ACC1, b0_, b1_); } while (0)
        PU_X(0); PU_X(1);
        asm volatile("s_waitcnt vmcnt(0)" ::: "memory");
        PU_X8(0);
        PU_Q(0, 0); PU_Q(0, 1); PU_Q(0, 2); PU_Q(0, 3);
        for (int j = 0; j < nt; ++j) {
            PU_X(j + 2);
            f32x4 c0, c1, c2, c3, c4, c5, c6, c7;
            PU_C(c0, c1, 0); PU_Q(j + 1, 0);
            PU_C(c2, c3, 1); PU_Q(j + 1, 1);
            PU_C(c4, c5, 2); PU_Q(j + 1, 2);
            PU_C(c6, c7, 3); PU_Q(j + 1, 3);
            { const float v0 = (kq == 0) ? c0[0] : (kq == 1) ? c1[0] : (kq == 2) ? c2[0] : c3[0], v1 = (kq == 0) ? c4[0] : (kq == 1) ? c5[0] : (kq == 2) ? c6[0] : c7[0];
              const int so_ = (s * M2 + t_first + j * t_stride) * 256;
              __builtin_amdgcn_raw_buffer_store_b16(f2bf_bits(v0), rP, 2 * lane, so_, 0); __builtin_amdgcn_raw_buffer_store_b16(f2bf_bits(v1), rP, 2 * lane + 128, so_, 0); }
            PU_X8(j + 1);
        }
        asm volatile("s_waitcnt vmcnt(0)" ::: "memory");
#undef PU_C
#undef PU_G
#undef PU_Q
#undef PU_X8
#undef PU_X
    }
}
__device__ __forceinline__ void pc_combine(const Args& a, int G, const int wave) {
    const int lane = pg8::get_lane();
    const int* TKid = (const int*)(a.ws + WS_KK); const float* TKg = (const float*)(a.ws + WS_KK + 16 * MiB); const bf16_t* PART = (const bf16_t*)(a.ws + WS_ZG); bf16_t* CFb = (bf16_t*)(a.ws + WS_A2);
    const float* SU = (const float*)(a.ws + WS_EU + 16 * MiB); const float* SV = (const float*)(a.ws + WS_EV + 16 * MiB);
    const int gt = blockIdx.x * NTHR + wave * 64 + lane, NGT = G * NTHR;
    for (int idx0 = gt; idx0 < M2 * 128; idx0 += 4 * NGT) {
        int id[4]; float gt4[4], sm[4], su[4], sv[4];
#pragma unroll
        for (int u = 0; u < 4; ++u) { const int idx = idx0 + u * NGT; const int ic = (idx < M2 * 128) ? idx : idx0;
            id[u] = TKid[ic]; gt4[u] = TKg[ic];
            unsigned short pr[8];
#pragma unroll
            for (int sl = 0; sl < 8; ++sl) pr[sl] = PART[(size_t)sl * M2 * 128 + ic];
            float s = 0.f;
#pragma unroll
            for (int sl = 0; sl < 8; ++sl) s += bf2f(pr[sl]);
            sm[u] = s; }
#pragma unroll
        for (int u = 0; u < 4; ++u) { su[u] = SU[id[u]]; sv[u] = SV[id[u]]; }
#pragma unroll
        for (int u = 0; u < 4; ++u) { const int idx = idx0 + u * NGT;
            if (idx < M2 * 128) CFb[idx] = f2bf_bits(gt4[u] * gelu_exact(sm[u] * (1.f / 16.f) * su[u]) * sv[u]); }
    }
}
__device__ __forceinline__ float wave_max_nn(float x) {
#define DPP_MAXNN(x, ctrl) fmaxf((x), __builtin_bit_cast(float, __builtin_amdgcn_update_dpp(0, __builtin_bit_cast(int, (x)), (ctrl), 0xf, 0xf, true)))
    x = DPP_MAXNN(x, 0xB1); x = DPP_MAXNN(x, 0x4E); x = DPP_MAXNN(x, 0x141); x = DPP_MAXNN(x, 0x140);
#undef DPP_MAXNN
    const int xi = __builtin_bit_cast(int, x);
    const float a = __builtin_bit_cast(float, __builtin_amdgcn_readlane(xi, 0)), b = __builtin_bit_cast(float, __builtin_amdgcn_readlane(xi, 16)), c = __builtin_bit_cast(float, __builtin_amdgcn_readlane(xi, 32)), d = __builtin_bit_cast(float, __builtin_amdgcn_readlane(xi, 48));
    return fmaxf(fmaxf(a, b), fmaxf(c, d));
}
typedef int v2i_t __attribute__((ext_vector_type(2)));
__device__ __forceinline__ void pv_output(const Args& a, LAS unsigned char* lds, const int wave, const XcdPart xp) {
    const int lane = pg8::get_lane(), kq = lane >> 4;
    const int* TKid = (const int*)(a.ws + WS_KK); const bf16_t* CFb = (const bf16_t*)(a.ws + WS_A2);
    const unsigned char* EV = a.ws + WS_EV; bf16_t* Y = (bf16_t*)(a.ws + WS_ZG);
    const int t_first = (int)xp.rnk * NWAVES + wave, t_stride = (int)xp.nloc * NWAVES;
    const int nt = (t_first < M2) ? (M2 - t_first + t_stride - 1) / t_stride : 0;
    if (nt == 0) return;
    const __amdgpu_buffer_rsrc_t rY = __builtin_amdgcn_make_buffer_rsrc((void*)Y, 0, 0x7fffffff, 0x00020000);
    LAS unsigned char* wl = lds + wave * 16384; LAS unsigned char* cv = lds + 131328 + wave * 128; LAS unsigned char* la = lds + 132352 + wave * 1536;
    const int pz0 = ((lane & 7) ^ (lane >> 4)) * 16, pz1 = ((lane & 7) ^ (4 + (lane >> 4))) * 16;
    const int q = (lane & 15) >> 1, jj = 8 * (kq & 1) + q, mm = (jj >> 1) & 7;
    const int trb = (kq >> 1) * 2048 + (jj >> 3) * 1024 + (jj & 7) * 128 + 8 * (lane & 1);
    for (int s = (int)xp.kx; s < 8; s += (int)xp.nx) {
        const unsigned char* EVs = EV + 128 * s;
        i64_t cf[4]; float yinv;
#define PV_X(j) do { const int jc_ = ((j) < nt) ? (j) : nt - 1; const int tk_ = t_first + jc_ * t_stride; LAS unsigned char* sl_ = la + ((j) & 1) * 768; \
            __builtin_amdgcn_global_load_lds((const unsigned*)(TKid + (size_t)tk_ * 128 + lane), (LAS unsigned*)sl_, 4, 0, 0); \
            __builtin_amdgcn_global_load_lds((const unsigned*)(TKid + (size_t)tk_ * 128 + 64 + lane), (LAS unsigned*)(sl_ + 256), 4, 0, 0); \
            __builtin_amdgcn_global_load_lds((const unsigned*)(CFb + (size_t)tk_ * 128 + 2 * lane), (LAS unsigned*)(sl_ + 512), 4, 0, 0); } while (0)
#define PV_CF(j) do { const LAS unsigned char* sl_ = la + ((j) & 1) * 768; const unsigned w_ = *(const LAS unsigned*)(sl_ + 512 + 4 * lane); const float c0_ = bflo(w_), c1_ = bfhi(w_); \
            const float m_ = fmaxf(wave_max_nn(fmaxf(fabsf(c0_), fabsf(c1_))), 1e-30f); const float sc_ = 256.f * __builtin_amdgcn_rcpf(m_); yinv = m_ * (1.f / 256.f); \
            const int p_ = __builtin_amdgcn_cvt_pk_fp8_f32(c0_ * sc_, c1_ * sc_, 0, false); \
            *(LAS unsigned short*)(cv + 2 * lane) = (unsigned short)(p_ & 0xffff); LDS_WAIT(); asm volatile("" ::: "memory"); \
            _Pragma("unroll") for (int k_ = 0; k_ < 4; ++k_) cf[k_] = *(const LAS i64_t*)(cv + 32 * k_ + 8 * kq); \
            LDS_WAIT(); asm volatile("" ::: "memory"); } while (0)
#define PV_Q(j, c) do { const LAS unsigned char* sl_ = la + ((j) & 1) * 768; _Pragma("unroll") for (int w_ = 0; w_ < 4; ++w_) { \
            const unsigned id_ = *(const LAS unsigned*)(sl_ + 4 * (32 * (c) + 8 * w_ + (lane >> 3))); \
            const unsigned char* gp_ = EVs + ((size_t)id_ << 10) + ((w_ & 1) ? pz1 : pz0); \
            __builtin_amdgcn_global_load_lds((const unsigned*)gp_, (LAS unsigned*)(wl + (c) * 4096 + w_ * 1024), 16, 0, 1); } } while (0)
#define PV_C(c) do { asm volatile("s_waitcnt vmcnt(15)" ::: "memory"); v2i_t b_[8]; \
            _Pragma("unroll") for (int n_ = 0; n_ < 8; ++n_) b_[n_] = __builtin_amdgcn_ds_read_tr8_b64_v2i32((LAS v2i_t*)(wl + (c) * 4096 + trb + ((n_ ^ mm) * 16))); \
            LDS_WAIT(); asm volatile("" ::: "memory");        \
            _Pragma("unroll") for (int n_ = 0; n_ < 8; ++n_) acc[n_] = __builtin_amdgcn_mfma_f32_16x16x32_fp8_fp8(cf[c], __builtin_bit_cast(i64_t, b_[n_]), acc[n_], 0, 0, 0); } while (0)
        PV_X(0); PV_X(1);
        asm volatile("s_waitcnt vmcnt(0)" ::: "memory");
        PV_CF(0);
        PV_Q(0, 0); PV_Q(0, 1); PV_Q(0, 2); PV_Q(0, 3);
        for (int j = 0; j < nt; ++j) {
            PV_X(j + 2);
            f32x4 acc[8];
#pragma unroll
            for (int n_ = 0; n_ < 8; ++n_) acc[n_] = (f32x4){0.f, 0.f, 0.f, 0.f};
            PV_C(0); PV_Q(j + 1, 0);
            PV_C(1); PV_Q(j + 1, 1);
            PV_C(2); PV_Q(j + 1, 2);
            PV_C(3); PV_Q(j + 1, 3);
            { const float v0 = ((kq == 0) ? acc[0][0] : (kq == 1) ? acc[1][0] : (kq == 2) ? acc[2][0] : acc[3][0]) * yinv, v1 = ((kq == 0) ? acc[4][0] : (kq == 1) ? acc[5][0] : (kq == 2) ? acc[6][0] : acc[7][0]) * yinv;
              const int so_ = (t_first + j * t_stride) * 2048 + 256 * s;
              __builtin_amdgcn_raw_buffer_store_b16(f2bf_bits(v0), rY, 2 * lane, so_, 0); __builtin_amdgcn_raw_buffer_store_b16(f2bf_bits(v1), rY, 2 * lane + 128, so_, 0); }
            PV_CF(j + 1);
        }
        asm volatile("s_waitcnt vmcnt(0)" ::: "memory");
#undef PV_C
#undef PV_Q
#undef PV_CF
#undef PV_X
    }
}
__device__ __forceinline__ void pf_final(const Args& a, int G, const int wave) {
    const int lane = pg8::get_lane();
    float* OUT = a.out; const bf16_t* H1b = (const bf16_t*)(a.ws + WS_ZC); const bf16_t* Y = (const bf16_t*)(a.ws + WS_ZG); const float* gfin = a.in[27];
    const int gw = blockIdx.x * NWAVES + wave, NGW = G * NWAVES;
    f32x4 g[4];
#pragma unroll
    for (int q = 0; q < 4; ++q) g[q] = *(const f32x4*)(gfin + 16 * lane + 4 * q);
    u32x4 hn0, hn1, yn0, yn1;
#define PF_LOAD(tok) do { hn0 = *(const u32x4*)(H1b + (size_t)(tok) * 1024 + 16 * lane); hn1 = *(const u32x4*)(H1b + (size_t)(tok) * 1024 + 16 * lane + 8); \
        yn0 = *(const u32x4*)(Y + (size_t)(tok) * 1024 + 16 * lane); yn1 = *(const u32x4*)(Y + (size_t)(tok) * 1024 + 16 * lane + 8); } while (0)
    if (gw < M2) PF_LOAD(gw);
    for (int tok = gw; tok < M2; tok += NGW) {
        const u32x4 h0 = hn0, h1 = hn1, y0 = yn0, y1 = yn1;
        { const int tn = (tok + NGW < M2) ? tok + NGW : tok; PF_LOAD(tn); }
        f32x4 h[4];
        h[0] = (f32x4){bflo(h0.x) + bflo(y0.x), bfhi(h0.x) + bfhi(y0.x), bflo(h0.y) + bflo(y0.y), bfhi(h0.y) + bfhi(y0.y)};
        h[1] = (f32x4){bflo(h0.z) + bflo(y0.z), bfhi(h0.z) + bfhi(y0.z), bflo(h0.w) + bflo(y0.w), bfhi(h0.w) + bfhi(y0.w)};
        h[2] = (f32x4){bflo(h1.x) + bflo(y1.x), bfhi(h1.x) + bfhi(y1.x), bflo(h1.y) + bflo(y1.y), bfhi(h1.y) + bfhi(y1.y)};
        h[3] = (f32x4){bflo(h1.z) + bflo(y1.z), bfhi(h1.z) + bfhi(y1.z), bflo(h1.w) + bflo(y1.w), bfhi(h1.w) + bfhi(y1.w)};
        float s = 0.f;
#pragma unroll
        for (int q = 0; q < 4; ++q) s += (h[q][0] * h[q][0] + h[q][1] * h[q][1]) + (h[q][2] * h[q][2] + h[q][3] * h[q][3]);
        const float rf = __builtin_amdgcn_rsqf(wave_sum(s) * (1.f / 1024.f) + 1e-6f);
        float* op = OUT + (size_t)tok * 1024 + 16 * lane;
#pragma unroll
        for (int q = 0; q < 4; ++q) *(f32x4*)(op + 4 * q) = h[q] * rf * g[q];
    }
#undef PF_LOAD
}

#define XB_TMO      128
#define XB_XCNT(j)  (256  + 64 * (j))
#define XB_XSUB(j)  (1280 + 64 * (j))
#define XB_XGEN(j)  (2304 + 64 * (j))
#define XB_TOP      3328
#define XB_TOPGEN   3392
#define XCD_BAR_WORDS 3456
#define XB_SPIN_CAP (1u << 23)
__device__ __forceinline__ unsigned xb_ld(unsigned* p)              { return __hip_atomic_load(p, __ATOMIC_RELAXED, __HIP_MEMORY_SCOPE_AGENT); }
__device__ __forceinline__ unsigned xb_add(unsigned* p, unsigned v) { return __hip_atomic_fetch_add(p, v, __ATOMIC_RELAXED, __HIP_MEMORY_SCOPE_AGENT); }
__device__ __forceinline__ unsigned xb_xcc_id() { return (unsigned)__builtin_amdgcn_s_getreg((3 << 11) | 20) & 0xFu; }
#define XB_SPIN(cond, bar) do { unsigned _sp = 0; while (cond) { __builtin_amdgcn_s_sleep(1); \
    if ((++_sp & 255u) == 0u) { if (xb_ld(&(bar)[XB_TMO])) break; if (_sp > XB_SPIN_CAP) { atomicAdd(&(bar)[XB_TMO], 1u); break; } } } } while (0)
struct XcdBarrier { unsigned* bar; unsigned x; volatile LAS unsigned* st; };
__device__ __forceinline__ void xcd_barrier_complete(unsigned* bar, unsigned x, unsigned G, unsigned& nloc, unsigned& nx, unsigned& below) {
    unsigned sum, cnt, mine, sp = 0u;
    for (;;) {
        sum = 0u; cnt = 0u; mine = 0u; below = 0u;
#pragma unroll
        for (unsigned j = 0; j < 16; ++j) { const unsigned c = xb_ld(&bar[XB_XCNT(j)]); sum += c; cnt += (c > 0u) ? 1u : 0u; mine = (j == x) ? c : mine; below += (j < x && c > 0u) ? 1u : 0u; }
        if (sum == G) break;
        __builtin_amdgcn_s_sleep(1);
        if ((++sp & 255u) == 0u) { if (xb_ld(&bar[XB_TMO])) break; if (sp > XB_SPIN_CAP) { atomicAdd(&bar[XB_TMO], 1u); break; } }
    }
    nloc = mine > 0u ? mine : 1u; nx = cnt > 0u ? cnt : 1u;
}
__device__ __forceinline__ void xcd_barrier(const XcdBarrier& b, const bool t0, const unsigned G) {
    asm volatile("s_waitcnt vmcnt(0)" ::: "memory");
    __syncthreads();
    if (t0) {
        unsigned* bar = b.bar;
        __builtin_amdgcn_s_waitcnt(0);
        unsigned nloc = b.st[0], nx = b.st[1];
        if (nloc == 0u) { unsigned below; xcd_barrier_complete(bar, b.x, G, nloc, nx, below); b.st[0] = nloc; b.st[1] = nx; b.st[3] = below; }
        const unsigned old = xb_add(&bar[XB_XSUB(b.x)], 1u);
        const unsigned gen = old / nloc;
        if (old + 1u == (gen + 1u) * nloc) {
            __builtin_amdgcn_fence(__ATOMIC_RELEASE, "agent");
            asm volatile("s_waitcnt vmcnt(0)" ::: "memory");
            const unsigned og = xb_add(&bar[XB_TOP], 1u);
            const unsigned tg = og / nx;
            if (og + 1u == (tg + 1u) * nx) xb_add(&bar[XB_TOPGEN], 1u);
            else XB_SPIN(xb_ld(&bar[XB_TOPGEN]) == tg, bar);
            __builtin_amdgcn_fence(__ATOMIC_ACQUIRE, "agent");
            xb_add(&bar[XB_XGEN(b.x)], 1u);
            asm volatile("s_waitcnt vmcnt(0)" ::: "memory");
        } else {
            XB_SPIN(xb_ld(&bar[XB_XGEN(b.x)]) == gen, bar);
            __builtin_amdgcn_fence(__ATOMIC_ACQUIRE, "agent");
            asm volatile("s_waitcnt vmcnt(0)" ::: "memory");
        }
    }
    __syncthreads();
}
constexpr size_t WS_BAR = 64 * 1024;
constexpr int LDS_BAR_OFF = 131072;

#if defined(MK_DUP_PH) && MK_DUP_PH == 5
#define MK_REP5 2
#else
#define MK_REP5 1
#endif
#if defined(MK_DUP_PH) && MK_DUP_PH == 7
#define MK_REP7 2
#else
#define MK_REP7 1
#endif
constexpr int NPH = 13;
__global__ void __launch_bounds__(NTHR, 2) fwd_kernel(Args a) {
    __shared__ __attribute__((aligned(16))) unsigned char lds_raw[LDS_BYTES];
    LAS unsigned char* lds = (LAS unsigned char*)lds_raw;
    const int G = gridDim.x;
    const int wave_s = __builtin_amdgcn_readfirstlane((int)threadIdx.x >> 6);
    const int lo = a.ph_lo, hi = a.ph_hi;
#define IN(k) (lo <= (k) && (k) < hi)
#if MK_ONE_LAUNCH
    XcdBarrier xbar; xbar.bar = (unsigned*)(a.ws + WS_BAR); xbar.st = (volatile LAS unsigned*)(lds + LDS_BAR_OFF); xbar.x = xb_xcc_id();
    { const int lane0 = pg8::get_lane(); if (wave_s == 0 && lane0 < 4) xbar.st[lane0] = 0u; __syncthreads(); if (wave_s == 0 && lane0 == 0) xbar.st[2] = xb_add(&xbar.bar[XB_XCNT(xbar.x)], 1u); }
#define SEAM(k) do { if (IN(k) && IN((k) + 1)) { if ((k) == 0) cg::this_grid().sync(); else { const bool t0_ = (wave_s == 0) && (pg8::get_lane() == 0); xcd_barrier(xbar, t0_, (unsigned)G); } } } while (0)
#else
#define SEAM(k) do { } while (0)
#endif
#if defined(MK_PROBE_PH)
    volatile LAS unsigned long long* stamps = (volatile LAS unsigned long long*)(lds + LDS_BAR_OFF + 64);
#define STAMP(i) do { if (blockIdx.x == 0 && wave_s == 0 && pg8::get_lane() == 0) stamps[(i)] = __builtin_amdgcn_s_memrealtime(); } while (0)
#else
#define STAMP(i) do { } while (0)
#endif
    STAMP(0);
    unsigned char* ws = a.ws;
    bf16_t* XN = (bf16_t*)(ws + WS_XN);
    const bool late_p0 = (G > NB * NHEAD);
    if (IN(0)) { if (late_p0) p0_prologue<0>(a, lds, (int)blockIdx.x, G, wave_s); else p0_prologue<2>(a, lds, (int)blockIdx.x, G, wave_s); } SEAM(0); STAMP(1);
    constexpr int NZ_LATE = 4;
    const int nz_early = late_p0 ? (INTOT / 256 - NZ_LATE) : INTOT / 256;
    if (IN(1)) {
        pg8::Gemm g{XN, (const bf16_t*)(ws + WS_WIN), MP, nz_early * 256, 1024, 1024, 1024}; pg8::StaticOrder S; S.init(MP, nz_early * 256, G, (int)blockIdx.x);
        pg8::EpiZ E{(bf16_t*)(ws + WS_ZC), (bf16_t*)(ws + WS_ZR), (bf16_t*)(ws + WS_ZG), 0};
        pg8::gemm_phase<pg8::EpiZ, pg8::StaticOrder, true, true>(lds, g, S, E, wave_s);
    } SEAM(1); STAMP(2);
#if defined(MK_DUP_PH) && MK_DUP_PH == 2
    if (IN(2)) { p2_conv(a, lds, G, wave_s, false); p2_lorag(a, G, wave_s); __syncthreads(); }
#endif
#if defined(MK_DUP_PH) && MK_DUP_PH == 21
    if (IN(2)) { p2_conv(a, lds, G, wave_s, false); __syncthreads(); }
#endif
    const bool split_tail = (G >= 64) && (G % 8 == 0);
    if (IN(2)) { p2_conv(a, lds, G, wave_s, split_tail);
        if (split_tail && (int)blockIdx.x >= G - NB) { __syncthreads(); p4a_fused<true>(a, lds, G, wave_s, (int)blockIdx.x - (G - NB)); }
        p2_lorag(a, G, wave_s); __syncthreads(); }
#if defined(MK_DUP_PH) && MK_DUP_PH == 43
    if (IN(4)) { p4a_fused<false>(a, lds, G, wave_s, 0); __syncthreads(); }
#endif
    if (IN(4)) { p4a_fused<false>(a, lds, G, wave_s, 0); if (!split_tail) { for (int tb_ = (int)blockIdx.x; tb_ < NB; tb_ += G) { __syncthreads(); p4a_fused<true>(a, lds, G, wave_s, tb_); } } }
#if MK_ONE_LAUNCH
    if (IN(4)) { const bool t0_ = (wave_s == 0) && (pg8::get_lane() == 0); xcd_barrier(xbar, t0_, (unsigned)G); }
#endif
#if defined(MK_DUP_PH) && MK_DUP_PH == 41
    if (IN(4)) { p4b_chain(a, lds, G, wave_s); __syncthreads(); }
#endif
#define G_GEMM(VG, VB) do { pg8::Gemm gg_{(const bf16_t*)(ws + WS_A2), (const bf16_t*)(ws + WS_WSM) + (size_t)1024 * 256 + 128, MP, 512, 128, 128, 256}; pg8::StaticOrder Sg_; Sg_.init(MP, 512, (VG), (VB)); \
        pg8::EpiG Eg_{(bf16_t*)(ws + WS_ZR + 33 * MiB)}; pg8::gemm_phase<pg8::EpiG, pg8::StaticOrder, true, true>(lds, gg_, Sg_, Eg_, wave_s); } while (0)
    if (IN(4)) {
        if (!late_p0) { G_GEMM(G, (int)blockIdx.x); __syncthreads(); }
        if ((int)blockIdx.x < NB * NHEAD || !late_p0) p4b_chain(a, lds, G, wave_s);
        else {
            G_GEMM(G - NB * NHEAD, (int)blockIdx.x - NB * NHEAD); __syncthreads();
            p0_prologue<1>(a, lds, (int)blockIdx.x - NB * NHEAD, G - NB * NHEAD, wave_s);
            __syncthreads();
            pg8::Gemm g{XN, (const bf16_t*)(ws + WS_WIN) + (size_t)nz_early * 256 * 1024, MP, NZ_LATE * 256, 1024, 1024, 1024}; pg8::StaticOrder S; S.init(MP, NZ_LATE * 256, G - NB * NHEAD, (int)blockIdx.x - NB * NHEAD);
            pg8::EpiZ E{(bf16_t*)(ws + WS_ZC), (bf16_t*)(ws + WS_ZR), (bf16_t*)(ws + WS_ZG), nz_early};
            pg8::gemm_phase<pg8::EpiZ, pg8::StaticOrder, true, true>(lds, g, S, E, wave_s);
        }
    }
#if MK_ONE_LAUNCH
    if (IN(4)) { const bool t0_ = (wave_s == 0) && (pg8::get_lane() == 0); xcd_barrier(xbar, t0_, (unsigned)G); }
#endif
#if defined(MK_DUP_PH) && MK_DUP_PH == 42
    if (IN(4)) { p4c_post(a, G, wave_s); __syncthreads(); }
#endif
    if (IN(4)) { p4c_post(a, G, wave_s); } SEAM(4); STAMP(5);
#if defined(MK_DUP_PH) && MK_DUP_PH == 99 && MK_ONE_LAUNCH
    { const bool t0_ = (wave_s == 0) && (pg8::get_lane() == 0); for (int r_ = 0; r_ < 10; ++r_) xcd_barrier(xbar, t0_, (unsigned)G); }
#endif
    for (int rep_ = 0; rep_ < MK_REP5; ++rep_)
    if (IN(5)) {
        bf16_t* Mx = (bf16_t*)(ws + WS_ZR); const bf16_t* Zg = (const bf16_t*)(ws + WS_ZG);
        pg8::Gemm g{(const bf16_t*)(ws + WS_ACL), (const bf16_t*)(ws + WS_WCR), M2, 1024, 1024, 512, 1024, (const bf16_t*)(ws + WS_XN)}; pg8::StaticOrder S; S.init(M2, 1024, G, (int)blockIdx.x);
        pg8::EpiMixF E{Mx, Zg}; pg8::gemm_phase<pg8::EpiMixF, pg8::StaticOrder, true, true>(lds, g, S, E, wave_s);
    } SEAM(5); STAMP(6);
#if defined(MK_DUP_PH) && MK_DUP_PH == 6
    if (IN(6)) {
        pg8::Gemm g{(const bf16_t*)(ws + WS_ZR), (const bf16_t*)(ws + WS_WO), M2, 1024, 1024, 1024, 1024}; pg8::StaticOrder S; S.init(M2, 1024, G, (int)blockIdx.x);
        pg8::EpiH1 E{a.in[0], a.out, (bf16_t*)(ws + WS_ZC), (float*)(ws + WS_CTL + 768 * 1024)};
        pg8::gemm_phase<pg8::EpiH1, pg8::StaticOrder, true, true>(lds, g, S, E, wave_s); __syncthreads();
    }
#endif
    if (IN(6)) {
        pg8::Gemm g{(const bf16_t*)(ws + WS_ZR), (const bf16_t*)(ws + WS_WO), M2, 1024, 1024, 1024, 1024}; pg8::StaticOrder S; S.init(M2, 1024, G, (int)blockIdx.x);
        pg8::EpiH1 E{a.in[0], a.out, (bf16_t*)(ws + WS_ZC), (float*)(ws + WS_SSQ)};
        pg8::gemm_phase<pg8::EpiH1, pg8::StaticOrder, true, true>(lds, g, S, E, wave_s);
    } SEAM(6); STAMP(7);
    for (int rep_ = 0; rep_ < MK_REP7; ++rep_)
    if (IN(7)) {
        pg8::Gemm g{(const bf16_t*)(ws + WS_ZC), (const bf16_t*)(ws + WS_WQ), M2, 2048, 1024, 1024, 1024}; pg8::StaticOrder S; S.init(M2, 2048, G, (int)blockIdx.x);
        pg8::EpiQ E{(bf16_t*)(ws + WS_ZG), (const float*)(ws + WS_SSQ)};
        pg8::gemm_phase<pg8::EpiQ, pg8::StaticOrder, true, true>(lds, g, S, E, wave_s);
    } SEAM(7); STAMP(8);
#if defined(MK_DUP_PH) && MK_DUP_PH == 8
    if (IN(8)) { p9_topk(a, lds, G, wave_s); __syncthreads(); }
#endif
    if (IN(8)) { p9_topk(a, lds, G, wave_s); } SEAM(8); STAMP(9);
    XcdPart xp;
#if MK_ONE_LAUNCH
    xp.nloc = __builtin_amdgcn_readfirstlane(xbar.st[0]); xp.nx = __builtin_amdgcn_readfirstlane(xbar.st[1]); xp.rnk = __builtin_amdgcn_readfirstlane(xbar.st[2]); xp.kx = __builtin_amdgcn_readfirstlane(xbar.st[3]);
    if (xp.nloc == 0u || xp.nx == 0u) { xp.nloc = (unsigned)G; xp.nx = 1u; xp.rnk = blockIdx.x; xp.kx = 0u; }
#else
    xp.nloc = (unsigned)G; xp.nx = 1u; xp.rnk = blockIdx.x; xp.kx = 0u;
#endif
#if defined(MK_DUP_PH) && MK_DUP_PH == 9
    if (IN(9)) { pu_partial(a, lds, wave_s, xp); __syncthreads(); }
#endif
    if (IN(9)) { pu_partial(a, lds, wave_s, xp); } SEAM(9);
    if (IN(10)) { pc_combine(a, G, wave_s); } SEAM(10);
#if defined(MK_DUP_PH) && MK_DUP_PH == 11
    if (IN(11)) { pv_output(a, lds, wave_s, xp); __syncthreads(); }
#endif
    if (IN(11)) { pv_output(a, lds, wave_s, xp); } SEAM(11);
    if (IN(12)) { pf_final(a, G, wave_s); }
#if defined(MK_PROBE_PH)
    STAMP(10);
    if (blockIdx.x == 0 && wave_s == 0 && pg8::get_lane() == 0) { asm volatile("s_waitcnt vmcnt(0) lgkmcnt(0)" ::: "memory"); const float us = (float)(stamps[MK_PROBE_PH + 1] - stamps[MK_PROBE_PH]) * 0.01f; a.out[0] += us; }
#endif
#undef IN
#undef SEAM
}

extern "C" void kernel_launch(void* const* d_in, const int* in_sizes, int n_in, void* d_out, int out_size, void* d_ws, size_t ws_size, hipStream_t stream) {
    static int grid = 0;
    if (grid == 0) {
        if (n_in != 28 || out_size != M2 * D || ws_size < WS_END) { fprintf(stderr, "kernel_launch: unexpected shapes (n_in %d out %d ws %zu)\n", n_in, out_size, ws_size); grid = -1; return; }
        int dev = 0, cus = 0, per_cu = 0;
        if (hipGetDevice(&dev) != hipSuccess || hipDeviceGetAttribute(&cus, hipDeviceAttributeMultiprocessorCount, dev) != hipSuccess) { grid = -1; return; }
        if (hipOccupancyMaxActiveBlocksPerMultiprocessor(&per_cu, (const void*)fwd_kernel, NTHR, 0) != hipSuccess || per_cu < 1) { fprintf(stderr, "kernel_launch: occupancy query says %d blocks per CU\n", per_cu); (void)hipGetLastError(); grid = -1; return; }
        grid = cus;
    }
    if (grid < 0) return;
    (void)hipMemsetAsync((char*)d_ws + WS_CTL, 0, CTL_ZERO_BYTES, stream);
    Args a{};
    for (int i = 0; i < 28; ++i) a.in[i] = (const float*)d_in[i];
    a.out = (float*)d_out; a.ws = (unsigned char*)d_ws;
#if MK_ONE_LAUNCH
    a.ph_lo = 0; a.ph_hi = NPH;
    void* args[] = {&a};
    hipError_t e = hipLaunchCooperativeKernel((const void*)fwd_kernel, dim3(grid), dim3(NTHR), args, 0, stream);
    if (e != hipSuccess) fprintf(stderr, "kernel_launch: cooperative launch failed: %s (grid %d)\n", hipGetErrorString(e), grid);
#else
#ifndef MK_PH_HI
#define MK_PH_HI NPH
#endif
#ifndef MK_PH_LO
#define MK_PH_LO 0
#endif
    for (int ph = MK_PH_LO; ph < MK_PH_HI; ++ph) { a.ph_lo = ph; a.ph_hi = ph + 1; hipLaunchKernelGGL(fwd_kernel, dim3(grid), dim3(NTHR), 0, stream, a); }
#endif
}
```

```cpp
#include <hip/hip_runtime.h>
#include <hip/hip_cooperative_groups.h>
#include <cstdio>
#include <cstdint>
namespace cg = cooperative_groups;

#ifndef MK_ONE_LAUNCH
#define MK_ONE_LAUNCH 1
#endif

#define LAS __attribute__((address_space(3)))
#define LDS_WAIT() asm volatile("s_waitcnt lgkmcnt(0)" ::: "memory")

namespace pg8 {
#define PG8_LAS __attribute__((address_space(3)))
typedef unsigned short bf16_t;
typedef short bf16x8 __attribute__((ext_vector_type(8)));
typedef float f32x4 __attribute__((ext_vector_type(4)));
typedef unsigned u32x4 __attribute__((ext_vector_type(4)));
constexpr int BM = 256, BK = 64, HALF = 128, HTB = HALF * BK * 2  , STAGE_BYTES = 8 * HTB, NXCD = 8, WGM = 8;

__host__ __device__ __forceinline__ int lds_byte(int r, int c) { const int st = (r >> 4) * 2 + (c >> 5), rr = r & 15, cc = c & 31, ob = rr * 64 + cc * 2; return st * 1024 + (ob ^ (((ob >> 9) & 1) << 5)); }
__host__ __device__ __forceinline__ void stage_rc(int b, int& R, int& C) { const int st = b / 1024, sb = b % 1024, swz = sb ^ (((sb >> 9) & 1) << 5); R = (st >> 1) * 16 + swz / 64; C = (st & 1) * 32 + (swz % 64) / 2; }
__host__ __device__ __forceinline__ int perm32(int rho) { const int n = rho >> 4, i = rho & 15; return 8 * (i >> 2) + 4 * n + (i & 3); }

struct Unit { int pm, pn; };
struct Gemm { const bf16_t* A; const bf16_t* Bt; int M, N, K, lda, ldb; const bf16_t* A2 = nullptr; };

struct StaticOrder {
    int nM, nN, nwg, G, c;
    __host__ __device__ void init(int M, int N, int G_, int c_) { nM = M / BM; nN = N / BM; nwg = nM * nN; G = G_; c = c_; }
    __host__ __device__ bool next(int i, Unit& u) const {
        const long L = (long)i * G + c; if (L >= nwg) return false;
        int wgid = (int)L; { const int q = nwg / NXCD, r = nwg % NXCD, xcd = wgid % NXCD, off = wgid / NXCD; wgid = (xcd < r ? xcd * (q + 1) : r * (q + 1) + (xcd - r) * q) + off; }
        const int nig = WGM * nN, gid = wgid / nig, fm = gid * WGM, gsz = (nM - fm) < WGM ? (nM - fm) : WGM;
        u.pm = fm + ((wgid % nig) % gsz); u.pn = (wgid % nig) / gsz; return true;
    }
    __device__ __forceinline__ void a_ready(const Unit&) const {}
    __device__ __forceinline__ void done(const Unit&) const {}
};

typedef float f32x2_cv __attribute__((ext_vector_type(2)));
typedef __bf16 bf16x2_cv __attribute__((ext_vector_type(2)));
__device__ __forceinline__ unsigned cvt_pk_bf16(float lo, float hi) { const f32x2_cv v = {lo, hi}; const bf16x2_cv b = __builtin_convertvector(v, bf16x2_cv); return __builtin_bit_cast(unsigned, b); }
__device__ __forceinline__ void store8(bf16_t* p, const f32x4 v0, const f32x4 v1) {
    u32x4 w; w.x = cvt_pk_bf16(v0[0], v0[1]); w.y = cvt_pk_bf16(v0[2], v0[3]); w.z = cvt_pk_bf16(v1[0], v1[1]); w.w = cvt_pk_bf16(v1[2], v1[3]);
    *(u32x4*)p = w;
}
__device__ __forceinline__ float bflo(unsigned w) { return __builtin_bit_cast(float, w << 16); }
__device__ __forceinline__ float bfhi(unsigned w) { return __builtin_bit_cast(float, w & 0xffff0000u); }
__device__ __forceinline__ void load8(const bf16_t* p, f32x4& v0, f32x4& v1) {
    const u32x4 w = *(const u32x4*)p;
    v0 = (f32x4){bflo(w.x), bfhi(w.x), bflo(w.y), bfhi(w.y)}; v1 = (f32x4){bflo(w.z), bfhi(w.z), bflo(w.w), bfhi(w.w)};
}
__device__ __forceinline__ float sigm(float x) { return __builtin_amdgcn_rcpf(1.f + __expf(-x)); }
__device__ __forceinline__ int get_lane() { unsigned m = 0xffffffffu; asm volatile("" : "+s"(m)); return (int)__builtin_amdgcn_mbcnt_hi(m, __builtin_amdgcn_mbcnt_lo(m, 0u)); }
__device__ __forceinline__ void lane_ids(int& fr, int& fq) { const int lane = get_lane(); fr = lane & 15; fq = lane >> 4; }


struct EpiZ {
    static constexpr bool PERM = true, AFTER_DRAIN = false, HAS_MID = false;
    bf16_t *Zc, *Zr, *Zg; int pn_off;
    __device__ __forceinline__ void operator()(const f32x4 (&acc)[2][2][4][2], const Unit& u, int wr, int wc, int, int) const {
        int fr, fq; lane_ids(fr, fq);
        const int pn = u.pn + pn_off;
        if (pn < 4) {
            const int row0 = u.pm * BM + wr * 64 + fr, col0 = pn * 128 + wc * 32 + 8 * fq;
#pragma unroll
            for (int ai = 0; ai < 2; ++ai)
#pragma unroll
                for (int m = 0; m < 4; ++m) { f32x4 u0, u1;
#pragma unroll
                    for (int j = 0; j < 4; ++j) { u0[j] = acc[ai][0][m][0][j] * sigm(acc[ai][1][m][0][j]); u1[j] = acc[ai][0][m][1][j] * sigm(acc[ai][1][m][1][j]); }
                    store8(Zc + (size_t)(row0 + ai * HALF + m * 16) * 512 + col0, u0, u1); }
        } else if (pn < 11) {
            bf16_t* base = Zr; const int ldc = 1792, colt = (pn - 4) * 256;
            const int row0 = u.pm * BM + wr * 64 + fr, col0 = colt + wc * 32 + 8 * fq;
#pragma unroll
            for (int ai = 0; ai < 2; ++ai)
#pragma unroll
                for (int m = 0; m < 4; ++m) { bf16_t* rowp = base + (size_t)(row0 + ai * HALF + m * 16) * ldc + col0;
#pragma unroll
                    for (int bj = 0; bj < 2; ++bj) store8(rowp + bj * HALF, acc[ai][bj][m][0], acc[ai][bj][m][1]); }
        } else {
            const int row0 = u.pm * BM + wr * 64 + fr, col0 = (pn - 11) * 128 + wc * 32 + 8 * fq;
#pragma unroll
            for (int ai = 0; ai < 2; ++ai)
#pragma unroll
                for (int m = 0; m < 4; ++m) { bf16_t* rowp = Zg + (size_t)(row0 + ai * HALF + m * 16) * 2048 + col0;
                    f32x4 r0, r1, b0, b1;
#pragma unroll
                    for (int j = 0; j < 4; ++j) { const float ea0 = __expf(fminf(-acc[ai][0][m][0][j], 60.f)), ea1 = __expf(fminf(-acc[ai][0][m][1][j], 60.f)), eb0 = __expf(fminf(-acc[ai][1][m][0][j], 60.f)), eb1 = __expf(fminf(-acc[ai][1][m][1][j], 60.f));
                        r0[j] = (1.f + eb0) * __builtin_amdgcn_rcpf(1.f + ea0); r1[j] = (1.f + eb1) * __builtin_amdgcn_rcpf(1.f + ea1);
                        b0[j] = __builtin_amdgcn_rcpf(1.f + eb0); b1[j] = __builtin_amdgcn_rcpf(1.f + eb1); }
                    store8(rowp, r0, r1); store8(rowp + 1024, b0, b1); }
        }
    }
};

template <bool DRY = false> struct EpiSmallT {
    static constexpr bool PERM = true, AFTER_DRAIN = false, HAS_MID = false;
    const float *w0, *a0, *k_a; float* E; bf16_t *Kb, *Bb, *Gb; const bf16_t* KKb;
    __device__ __forceinline__ void operator()(const f32x4 (&acc)[2][2][4][2], const Unit& u, int wr, int wc, int, int) const {
        int fr, fq; lane_ids(fr, fq);
        const int pn = u.pn, kind = pn >> 1;
        const int row0 = u.pm * BM + wr * 64 + fr, col0 = (pn & 1) * 256 + wc * 32 + 8 * fq;
        if (kind == 0) {
            f32x4 p[2][2];
#pragma unroll
            for (int bj = 0; bj < 2; ++bj) { p[bj][0] = *(const f32x4*)(w0 + col0 + bj * HALF); p[bj][1] = *(const f32x4*)(w0 + col0 + bj * HALF + 4); }
#pragma unroll
            for (int ai = 0; ai < 2; ++ai)
#pragma unroll
                for (int m = 0; m < 4; ++m) { const size_t rowoff = (size_t)(row0 + ai * HALF + m * 16) * 512;
#pragma unroll
                    for (int bj = 0; bj < 2; ++bj) { const int c = col0 + bj * HALF; f32x4 v0 = acc[ai][bj][m][0], v1 = acc[ai][bj][m][1];
#pragma unroll
                        for (int j = 0; j < 4; ++j) { v0[j] = 0.60653065971f * sigm(p[bj][0][j] + v0[j]); v1[j] = 0.60653065971f * sigm(p[bj][1][j] + v1[j]); }
                        *(f32x4*)(E + rowoff + c) = v0; *(f32x4*)(E + rowoff + c + 4) = v1; } }
        } else if (kind == 1) {
            f32x4 p[2][2], q[2][2];
#pragma unroll
            for (int bj = 0; bj < 2; ++bj) { const int c = col0 + bj * HALF; p[bj][0] = *(const f32x4*)(a0 + c); p[bj][1] = *(const f32x4*)(a0 + c + 4); q[bj][0] = *(const f32x4*)(k_a + c); q[bj][1] = *(const f32x4*)(k_a + c + 4); }
#pragma unroll
            for (int am = 0; am < 4; ++am) { const int ai = am >> 1;
                u32x4 kw[4][2], kkw[4][2];
#pragma unroll
                for (int m = 2 * (am & 1); m < 2 * (am & 1) + 2; ++m) { const size_t rowoff = (size_t)(row0 + ai * HALF + m * 16) * 512;
#pragma unroll
                    for (int bj = 0; bj < 2; ++bj) { const int c = col0 + bj * HALF; kw[m][bj] = *(const u32x4*)(Kb + rowoff + c); kkw[m][bj] = *(const u32x4*)(KKb + rowoff + c); } }
#pragma unroll
                for (int m = 2 * (am & 1); m < 2 * (am & 1) + 2; ++m) { const size_t rowoff = (size_t)(row0 + ai * HALF + m * 16) * 512;
#pragma unroll
                    for (int bj = 0; bj < 2; ++bj) { const int c = col0 + bj * HALF; const f32x4 v0 = acc[ai][bj][m][0], v1 = acc[ai][bj][m][1];
                        const u32x4 kx = kw[m][bj], kkx = kkw[m][bj];
                        const f32x4 k0 = {bflo(kx.x), bfhi(kx.x), bflo(kx.y), bfhi(kx.y)}, k1 = {bflo(kx.z), bfhi(kx.z), bflo(kx.w), bfhi(kx.w)};
                        const f32x4 kk0 = {bflo(kkx.x), bfhi(kkx.x), bflo(kkx.y), bfhi(kkx.y)}, kk1 = {bflo(kkx.z), bfhi(kkx.z), bflo(kkx.w), bfhi(kkx.w)};
                        f32x4 km0, km1, b0, b1;
#pragma unroll
                        for (int j = 0; j < 4; ++j) { const float a_0 = sigm(p[bj][0][j] + v0[j]), a_1 = sigm(p[bj][1][j] + v1[j]);
                            km0[j] = k0[j] * (1.f + (a_0 - 1.f) * q[bj][0][j]); km1[j] = k1[j] * (1.f + (a_1 - 1.f) * q[bj][1][j]); b0[j] = kk0[j] * a_0; b1[j] = kk1[j] * a_1; }
                        if (!DRY) store8(Kb + rowoff + c, km0, km1); store8(Bb + rowoff + c, b0, b1); } }
            }
        } else {
#pragma unroll
            for (int ai = 0; ai < 2; ++ai)
#pragma unroll
                for (int m = 0; m < 4; ++m) { const size_t rowoff = (size_t)(row0 + ai * HALF + m * 16) * 512;
#pragma unroll
                    for (int bj = 0; bj < 2; ++bj) store8(Gb + rowoff + col0 + bj * HALF, acc[ai][bj][m][0], acc[ai][bj][m][1]); }
        }
    }
};
typedef EpiSmallT<false> EpiSmall;

struct EpiG {
    static constexpr bool PERM = true, AFTER_DRAIN = false, HAS_MID = false;
    bf16_t* Gb;
    __device__ __forceinline__ void operator()(const f32x4 (&acc)[2][2][4][2], const Unit& u, int wr, int wc, int, int) const {
        int fr, fq; lane_ids(fr, fq);
        const int row0 = u.pm * BM + wr * 64 + fr, col0 = u.pn * BM + wc * 32 + 8 * fq;
#pragma unroll
        for (int ai = 0; ai < 2; ++ai)
#pragma unroll
            for (int m = 0; m < 4; ++m) { bf16_t* op = Gb + (size_t)(row0 + ai * HALF + m * 16) * 512 + col0;
#pragma unroll
                for (int bj = 0; bj < 2; ++bj) store8(op + bj * HALF, acc[ai][bj][m][0], acc[ai][bj][m][1]); }
    }
};

__device__ __forceinline__ int mfull_of(int m2) { return m2 + 16 * ((m2 >> 12) + 1); }

template <int MODE> struct EpiMix {
    static constexpr bool PERM = true, AFTER_DRAIN = false, HAS_MID = false;
    bf16_t* Mx; const bf16_t* Zg;
    __device__ __forceinline__ void operator()(const f32x4 (&acc)[2][2][4][2], const Unit& u, int wr, int wc, int, int) const {
        int fr, fq; lane_ids(fr, fq);
        const int row0 = u.pm * BM + wr * 64 + fr, col0 = u.pn * BM + wc * 32 + 8 * fq;
#pragma unroll
        for (int ai = 0; ai < 2; ++ai)
#pragma unroll
            for (int m = 0; m < 4; ++m) { const int row = row0 + ai * HALF + m * 16; const bf16_t* gp = Zg + (size_t)mfull_of(row) * 2048 + MODE * 1024 + col0; bf16_t* op = Mx + (size_t)row * 1024 + col0;
#pragma unroll
                for (int bj = 0; bj < 2; ++bj) { f32x4 g0, g1; load8(gp + bj * HALF, g0, g1); f32x4 v0 = acc[ai][bj][m][0] * g0, v1 = acc[ai][bj][m][1] * g1;
                    if (MODE == 1) { f32x4 o0, o1; load8(op + bj * HALF, o0, o1); v0 += o0; v1 += o1; }
                    store8(op + bj * HALF, v0, v1); } }
    }
};

struct EpiMixF {
    static constexpr bool PERM = true, AFTER_DRAIN = false, HAS_MID = true;
    bf16_t* Mx; const bf16_t* Zg;
    __device__ __forceinline__ void mid(f32x4 (&acc)[2][2][4][2], const Unit& u, int wr, int wc) const {
        int fr, fq; lane_ids(fr, fq);
        const int row0 = u.pm * BM + wr * 64 + fr, col0 = u.pn * BM + wc * 32 + 8 * fq;
        u32x4 rw[2][4][2];
#pragma unroll
        for (int ai = 0; ai < 2; ++ai)
#pragma unroll
            for (int m = 0; m < 4; ++m) { const bf16_t* gp = Zg + (size_t)mfull_of(row0 + ai * HALF + m * 16) * 2048 + col0;
#pragma unroll
                for (int bj = 0; bj < 2; ++bj) rw[ai][m][bj] = *(const u32x4*)(gp + bj * HALF); }
#pragma unroll
        for (int ai = 0; ai < 2; ++ai)
#pragma unroll
            for (int m = 0; m < 4; ++m)
#pragma unroll
                for (int bj = 0; bj < 2; ++bj) { const u32x4 w = rw[ai][m][bj];
                    acc[ai][bj][m][0] *= (f32x4){bflo(w.x), bfhi(w.x), bflo(w.y), bfhi(w.y)}; acc[ai][bj][m][1] *= (f32x4){bflo(w.z), bfhi(w.z), bflo(w.w), bfhi(w.w)}; }
    }
    __device__ __forceinline__ void operator()(const f32x4 (&acc)[2][2][4][2], const Unit& u, int wr, int wc, int, int) const {
        int fr, fq; lane_ids(fr, fq);
        const int row0 = u.pm * BM + wr * 64 + fr, col0 = u.pn * BM + wc * 32 + 8 * fq;
        u32x4 gw[2][4][2];
#pragma unroll
        for (int ai = 0; ai < 2; ++ai)
#pragma unroll
            for (int m = 0; m < 4; ++m) { const int row = row0 + ai * HALF + m * 16; const bf16_t* gp = Zg + (size_t)mfull_of(row) * 2048 + 1024 + col0;
#pragma unroll
                for (int bj = 0; bj < 2; ++bj) gw[ai][m][bj] = *(const u32x4*)(gp + bj * HALF); }
#pragma unroll
        for (int ai = 0; ai < 2; ++ai)
#pragma unroll
            for (int m = 0; m < 4; ++m) { const int row = row0 + ai * HALF + m * 16; bf16_t* op = Mx + (size_t)row * 1024 + col0;
#pragma unroll
                for (int bj = 0; bj < 2; ++bj) { const u32x4 w = gw[ai][m][bj]; const f32x4 g0 = {bflo(w.x), bfhi(w.x), bflo(w.y), bfhi(w.y)}, g1 = {bflo(w.z), bfhi(w.z), bflo(w.w), bfhi(w.w)};
                    store8(op + bj * HALF, acc[ai][bj][m][0] * g0, acc[ai][bj][m][1] * g1); } }
    }
};

struct EpiH1 {
    static constexpr bool PERM = true, AFTER_DRAIN = false, HAS_MID = false;
    const float* X; float* H1; bf16_t* H1b; float* ssq;
    __device__ __forceinline__ void operator()(const f32x4 (&acc)[2][2][4][2], const Unit& u, int wr, int wc, int, int) const {
        int fr, fq; lane_ids(fr, fq);
        const int row0 = u.pm * BM + wr * 64 + fr, col0 = u.pn * BM + wc * 32 + 8 * fq;
#pragma unroll
        for (int ai = 0; ai < 2; ++ai)
        {   f32x4 xv[4][2][2];
#pragma unroll
            for (int m = 0; m < 4; ++m) { const size_t off = (size_t)(row0 + ai * HALF + m * 16) * 1024 + col0;
#pragma unroll
                for (int bj = 0; bj < 2; ++bj) { xv[m][bj][0] = *(const f32x4*)(X + off + bj * HALF); xv[m][bj][1] = *(const f32x4*)(X + off + bj * HALF + 4); } }
#pragma unroll
            for (int m = 0; m < 4; ++m) { const int row = row0 + ai * HALF + m * 16; const size_t off = (size_t)row * 1024 + col0; float s = 0.f;
#pragma unroll
                for (int bj = 0; bj < 2; ++bj) {
                    const f32x4 v0 = acc[ai][bj][m][0] + xv[m][bj][0], v1 = acc[ai][bj][m][1] + xv[m][bj][1];
                    store8(H1b + off + bj * HALF, v0, v1);
                    s += (v0[0] * v0[0] + v0[1] * v0[1]) + (v0[2] * v0[2] + v0[3] * v0[3]) + (v1[0] * v1[0] + v1[1] * v1[1]) + (v1[2] * v1[2] + v1[3] * v1[3]); }
                s += __shfl_xor(s, 16); s += __shfl_xor(s, 32);
                if (fq == 0) atomicAdd(ssq + row, s); }
        }
    }
};

struct EpiQ {
    static constexpr bool PERM = true, AFTER_DRAIN = false, HAS_MID = false;
    bf16_t* Q; const float* ssq;
    __device__ __forceinline__ void operator()(const f32x4 (&acc)[2][2][4][2], const Unit& u, int wr, int wc, int, int) const {
        int fr, fq; lane_ids(fr, fq);
        const int row0 = u.pm * BM + wr * 64 + fr, col0 = u.pn * BM + wc * 32 + 8 * fq;
        float sq[2][4];
#pragma unroll
        for (int ai = 0; ai < 2; ++ai)
#pragma unroll
            for (int m = 0; m < 4; ++m) sq[ai][m] = ssq[row0 + ai * HALF + m * 16];
#pragma unroll
        for (int ai = 0; ai < 2; ++ai)
#pragma unroll
            for (int m = 0; m < 4; ++m) { const int row = row0 + ai * HALF + m * 16; const float rs = __builtin_amdgcn_rsqf(sq[ai][m] * (1.f / 1024.f) + 1e-6f); bf16_t* op = Q + (size_t)row * 2048 + col0;
#pragma unroll
                for (int bj = 0; bj < 2; ++bj) store8(op + bj * HALF, acc[ai][bj][m][0] * rs, acc[ai][bj][m][1] * rs); }
    }
};

template <class Epi, class Sched, bool ALIGN_EPI = false, bool SP2 = false>
__device__ __forceinline__ void gemm_phase(PG8_LAS unsigned char* lds, const Gemm g, const Sched& S, const Epi& E, const int wave_s) {
    const int wid = wave_s, lane = get_lane(), tid = wid * 64 + lane, wr = wid >> 2, wc = wid & 3, fr = lane & 15, fq = lane >> 4;
    const int K = g.K, nt = K / BK;
    unsigned voffA[2], voffB[2];
#pragma unroll
    for (int i = 0; i < 2; ++i) { int R, C; stage_rc(tid * 16 + i * 8192, R, C); const int Rb = Epi::PERM ? ((R & ~31) + perm32(R & 31)) : R;
        voffA[i] = (unsigned)(R * g.lda + C) * 2u; voffB[i] = (unsigned)(Rb * g.ldb + C) * 2u; }
    const size_t kstep = (size_t)(BK * 2);
    const size_t hstepA = (size_t)HALF * g.lda * 2, hstepB = (size_t)HALF * g.ldb * 2;
    const size_t tstepA = 2 * hstepA, tstepB = 2 * hstepB;
    const unsigned ldsw = (unsigned)wid * 1024u;
    const int aoff = lds_byte(wr * 64 + fr, fq * 8), boff = lds_byte(wc * 32 + fr, fq * 8);
#define PG8_SA(b, h) (((b) * 2 + (h)) * HTB)
#define PG8_SB(b, h) ((4 + (b) * 2 + (h)) * HTB)
#define PG8_STAGE(bufoff, gbase, voff) do { _Pragma("unroll") for (int _i = 0; _i < 2; ++_i) \
        __builtin_amdgcn_global_load_lds((const unsigned*)((const char*)(gbase) + (voff)[_i]), (PG8_LAS unsigned*)(lds + (bufoff) + ldsw + _i * 8192), 16, 0, 0); } while (0)
#define PG8_LDA(dst, b, h) do { unsigned _ab = (unsigned)(PG8_SA(b, h) + aoff); asm volatile("" : "+v"(_ab)); _Pragma("unroll") for (int m = 0; m < 4; ++m) _Pragma("unroll") for (int k = 0; k < 2; ++k) dst[m][k] = *(const PG8_LAS bf16x8*)(lds + _ab + m * 2048 + k * 1024); } while (0)
#define PG8_LDB(dst, b, h) do { unsigned _bb = (unsigned)(PG8_SB(b, h) + boff); asm volatile("" : "+v"(_bb)); _Pragma("unroll") for (int n = 0; n < 2; ++n) _Pragma("unroll") for (int k = 0; k < 2; ++k) dst[n][k] = *(const PG8_LAS bf16x8*)(lds + _bb + n * 2048 + k * 1024); } while (0)
#define PG8_MMA(ai, bj, At, Bt) do { __builtin_amdgcn_s_setprio(1); _Pragma("unroll") for (int m = 0; m < 4; ++m) _Pragma("unroll") for (int n = 0; n < 2; ++n) _Pragma("unroll") for (int k = 0; k < 2; ++k) \
        acc[ai][bj][m][n] = __builtin_amdgcn_mfma_f32_16x16x32_bf16(Bt[n][k], At[m][k], acc[ai][bj][m][n], 0, 0, 0); __builtin_amdgcn_s_setprio(0); } while (0)
#define PG8_WAIT_V(n) asm volatile("s_waitcnt vmcnt(" #n ")" ::: "memory")
#define PG8_WAIT_L(n) asm volatile("s_waitcnt lgkmcnt(" #n ")" ::: "memory")
#define PG8_BAR __builtin_amdgcn_s_barrier()
#define PG8_SCHED __builtin_amdgcn_sched_barrier(0)
    Unit cur, nxt; int ui = 0;
    if (!S.next(0, cur)) return;
    f32x4 acc[2][2][4][2];
#pragma unroll
    for (int a = 0; a < 2; ++a)
#pragma unroll
        for (int b = 0; b < 2; ++b)
#pragma unroll
            for (int m = 0; m < 4; ++m)
#pragma unroll
                for (int n = 0; n < 2; ++n) acc[a][b][m][n] = (f32x4){0.f, 0.f, 0.f, 0.f};
    bf16x8 At[4][2], B0[2][2], B1[2][2];
    const char* cA = (const char*)g.A + (size_t)cur.pm * tstepA; const char* cB = (const char*)g.Bt + (size_t)cur.pn * tstepB;
    S.a_ready(cur);
    if constexpr (SP2) {
        PG8_STAGE(PG8_SB(0, 0), cB, voffB); PG8_STAGE(PG8_SB(0, 1), cB + hstepB, voffB); PG8_STAGE(PG8_SA(0, 0), cA, voffA); PG8_STAGE(PG8_SA(0, 1), cA + hstepA, voffA);
        if (wr == 1) PG8_BAR;
        PG8_WAIT_V(2); PG8_BAR;
        PG8_STAGE(PG8_SB(1, 0), cB + kstep, voffB); PG8_STAGE(PG8_SA(1, 0), cA + kstep, voffA); PG8_STAGE(PG8_SB(1, 1), cB + hstepB + kstep, voffB);
        PG8_WAIT_V(6); PG8_BAR;
    } else {
        PG8_STAGE(PG8_SB(0, 0), cB, voffB); PG8_STAGE(PG8_SA(0, 0), cA, voffA); PG8_STAGE(PG8_SB(0, 1), cB + hstepB, voffB); PG8_STAGE(PG8_SA(0, 1), cA + hstepA, voffA);
        if (wr == 1) PG8_BAR;
        PG8_WAIT_V(4); PG8_BAR;
        PG8_STAGE(PG8_SB(1, 0), cB + kstep, voffB); PG8_STAGE(PG8_SA(1, 0), cA + kstep, voffA); PG8_STAGE(PG8_SB(1, 1), cB + hstepB + kstep, voffB);
        PG8_WAIT_V(6); PG8_BAR;
    }
    for (;;) {
        const bool has_next = S.next(ui + 1, nxt);
        const char* nA = has_next ? (const char*)g.A + (size_t)nxt.pm * tstepA : cA; const char* nB = has_next ? (const char*)g.Bt + (size_t)nxt.pn * tstepB : cB;
        for (int t = 0; t < nt; t += 2) {
            const bool last = (t == nt - 2);
            const char* cA2 = g.A2 ? (const char*)g.A2 + (cA - (const char*)g.A) - (size_t)(nt / 2) * kstep : cA;
            const int nh = g.A2 ? nt / 2 : nt;
            const char* a1 = ((t + 1 < nh) ? cA : cA2) + (size_t)(t + 1) * kstep;
            const char* a2 = last ? nA : ((t + 2 < nh) ? cA : cA2) + (size_t)(t + 2) * kstep; const char* b2 = last ? nB : cB + (size_t)(t + 2) * kstep;
            const char* a3 = a2 + kstep; const char* b3 = b2 + kstep;
            if (last && has_next) S.a_ready(nxt);
            if constexpr (Epi::HAS_MID) { if (t == nt / 2) E.mid(acc, cur, wr, wc); }
            if constexpr (SP2) {
            PG8_LDB(B0, 0, 0); PG8_LDB(B1, 0, 1); PG8_SCHED; PG8_LDA(At, 0, 0); PG8_STAGE(PG8_SA(1, 1), a1 + hstepA, voffA);
            PG8_WAIT_V(8); PG8_WAIT_L(0); PG8_BAR; PG8_MMA(0, 0, At, B0); PG8_MMA(0, 1, At, B1); PG8_BAR; PG8_SCHED;
            PG8_LDA(At, 0, 1); PG8_STAGE(PG8_SB(0, 0), b2, voffB); PG8_STAGE(PG8_SB(0, 1), b2 + hstepB, voffB); PG8_STAGE(PG8_SA(0, 0), a2, voffA);
            PG8_WAIT_V(8); PG8_WAIT_L(0); PG8_BAR; PG8_MMA(1, 0, At, B0); PG8_MMA(1, 1, At, B1); PG8_BAR; PG8_SCHED;
            PG8_LDB(B0, 1, 0); PG8_LDB(B1, 1, 1); PG8_SCHED; PG8_LDA(At, 1, 0); PG8_STAGE(PG8_SA(0, 1), a2 + hstepA, voffA);
            PG8_WAIT_V(8); PG8_WAIT_L(0); PG8_BAR; PG8_MMA(0, 0, At, B0); PG8_MMA(0, 1, At, B1); PG8_BAR; PG8_SCHED;
            PG8_LDA(At, 1, 1); PG8_STAGE(PG8_SB(1, 0), b3, voffB); PG8_STAGE(PG8_SB(1, 1), b3 + hstepB, voffB); PG8_STAGE(PG8_SA(1, 0), a3, voffA);
            PG8_WAIT_V(8); PG8_WAIT_L(0); PG8_BAR; PG8_MMA(1, 0, At, B0); PG8_MMA(1, 1, At, B1); PG8_BAR; PG8_SCHED;
            } else {
            PG8_LDB(B0, 0, 0); PG8_SCHED; PG8_LDA(At, 0, 0); PG8_STAGE(PG8_SA(1, 1), a1 + hstepA, voffA);
            PG8_WAIT_L(8); PG8_BAR; PG8_WAIT_L(0); PG8_MMA(0, 0, At, B0); PG8_BAR; PG8_SCHED;
            PG8_LDB(B1, 0, 1); PG8_STAGE(PG8_SB(0, 0), b2, voffB);
            PG8_BAR; PG8_WAIT_L(0); PG8_MMA(0, 1, At, B1); PG8_BAR;
            PG8_LDA(At, 0, 1); PG8_STAGE(PG8_SA(0, 0), a2, voffA);
            PG8_BAR; PG8_WAIT_L(0); PG8_MMA(1, 0, At, B0); PG8_BAR; PG8_SCHED;
            PG8_STAGE(PG8_SB(0, 1), b2 + hstepB, voffB);
            PG8_WAIT_V(6); PG8_BAR; PG8_MMA(1, 1, At, B1); PG8_BAR;
            PG8_LDB(B0, 1, 0); PG8_SCHED; PG8_LDA(At, 1, 0); PG8_STAGE(PG8_SA(0, 1), a2 + hstepA, voffA);
            PG8_WAIT_L(8); PG8_BAR; PG8_WAIT_L(0); PG8_MMA(0, 0, At, B0); PG8_BAR; PG8_SCHED;
            PG8_LDB(B1, 1, 1); PG8_STAGE(PG8_SB(1, 0), b3, voffB);
            PG8_BAR; PG8_WAIT_L(0); PG8_MMA(0, 1, At, B1); PG8_BAR;
            PG8_LDA(At, 1, 1); PG8_STAGE(PG8_SA(1, 0), a3, voffA);
            PG8_BAR; PG8_WAIT_L(0); PG8_MMA(1, 0, At, B0); PG8_BAR; PG8_SCHED;
            PG8_STAGE(PG8_SB(1, 1), b3 + hstepB, voffB);
            PG8_WAIT_V(6); PG8_BAR; PG8_MMA(1, 1, At, B1); PG8_BAR;
            }
        }
        if constexpr (ALIGN_EPI) { if (wr == 0) PG8_BAR; }
        if constexpr (!Epi::AFTER_DRAIN) { E(acc, cur, wr, wc, fr, fq); S.done(cur); }
        if (!has_next) break;
#pragma unroll
        for (int a = 0; a < 2; ++a)
#pragma unroll
            for (int b = 0; b < 2; ++b)
#pragma unroll
                for (int m = 0; m < 4; ++m)
#pragma unroll
                    for (int n = 0; n < 2; ++n) acc[a][b][m][n] = (f32x4){0.f, 0.f, 0.f, 0.f};
        cur = nxt; cA = nA; cB = nB; ++ui;
        if constexpr (ALIGN_EPI) { if (wr == 1) PG8_BAR; }
    }
    PG8_WAIT_V(0);
    if constexpr (!ALIGN_EPI) { if (wr == 0) PG8_BAR; }
    PG8_BAR;
    if constexpr (Epi::AFTER_DRAIN) { E.fused(acc, cur, wr, wc, fr, fq, lds, wid, lane); S.done(cur); }
#undef PG8_SA
#undef PG8_SB
#undef PG8_STAGE
#undef PG8_LDA
#undef PG8_LDB
#undef PG8_MMA
#undef PG8_WAIT_V
#undef PG8_WAIT_L
#undef PG8_BAR
#undef PG8_SCHED
}
}

typedef pg8::bf16_t bf16_t;
typedef pg8::f32x4 f32x4;
typedef pg8::u32x4 u32x4;
typedef pg8::bf16x8 bf16x8;
typedef unsigned u32x2 __attribute__((ext_vector_type(2)));
using pg8::bflo; using pg8::bfhi; using pg8::cvt_pk_bf16; using pg8::sigm; using pg8::load8; using pg8::store8;

constexpr int D = 1024, NB = 8, SEQ = 4096, NMETA = 16, T = SEQ + NMETA  , MT = NB * T  , MP = 33024  , M2 = NB * SEQ  ;
constexpr int INTOT = 4864, CCH = 512, RWW = 512, RWIN = 1792, NHEAD = 8;
constexpr int PH = 8, PK = 128, PDH = 128, PTOPK = 16, NEXP = 16384;
constexpr int NWAVES = 8, NTHR = 512;
constexpr int LDS_BYTES = 147456;

constexpr size_t MiB = 1u << 20;
constexpr size_t WS_CTL = 0, CTL_ZERO_BYTES = 1 * MiB;
constexpr size_t WS_SSQ = 256 * 1024;
constexpr size_t WS_SSQ2 = 512 * 1024;
constexpr size_t WS_WIN = 1 * MiB;
constexpr size_t WS_WCR = 11 * MiB;
constexpr size_t WS_WO = 13 * MiB;
constexpr size_t WS_WQ = 15 * MiB;
constexpr size_t WS_SK = 19 * MiB;
constexpr size_t WS_WSM = 19 * MiB + 512 * 1024;
constexpr size_t WS_EU = 20 * MiB + 256 * 1024, WS_EV = WS_EU + 16 * MiB + 256 * 1024;
constexpr size_t WS_ACL = 53 * MiB;
constexpr size_t WS_EU_OLD_ = 0, WS_EV_OLD_ = 0;
constexpr size_t WS_XN = 85 * MiB;
constexpr size_t WS_ZG = 150 * MiB;
constexpr size_t WS_ZR = 279 * MiB;
constexpr size_t WS_ZC = 392 * MiB;
constexpr size_t WS_KK = 457 * MiB;
constexpr size_t WS_A2 = 490 * MiB;
constexpr size_t WS_RK = 507 * MiB + 256 * 1024;
constexpr size_t WS_EM = WS_ZC + 32 * MiB + 512 * 1024;
constexpr size_t WS_WC = WS_A2 + 13 * MiB + 64 * 1024;
constexpr size_t WS_ORAW = 345 * MiB;
constexpr size_t WS_END = 509 * MiB;

struct Args { const float* in[28]; float* out; unsigned char* ws; int ph_lo, ph_hi; };

__device__ __forceinline__ float dpp_f(float x, const int ctrl_sel) { return x; }
#define DPP_ADD(x, ctrl) ((x) + __builtin_bit_cast(float, __builtin_amdgcn_update_dpp(0, __builtin_bit_cast(int, (x)), (ctrl), 0xf, 0xf, true)))
__device__ __forceinline__ float red8(float x) {
    x = DPP_ADD(x, 0xB1); x = DPP_ADD(x, 0x4E); x = DPP_ADD(x, 0x141); return x;
}
__device__ __forceinline__ float red16(float x) { x = red8(x); x = DPP_ADD(x, 0x140); return x; }
__device__ __forceinline__ float wave_sum(float x) {
    x = red16(x);
    const int xi = __builtin_bit_cast(int, x);
    const float a = __builtin_bit_cast(float, __builtin_amdgcn_readlane(xi, 0)), b = __builtin_bit_cast(float, __builtin_amdgcn_readlane(xi, 16)), c = __builtin_bit_cast(float, __builtin_amdgcn_readlane(xi, 32)), d = __builtin_bit_cast(float, __builtin_amdgcn_readlane(xi, 48));
    return (a + b) + (c + d);
}

template <bool GATEP = false>
__device__ __forceinline__ void p0_transpose_item(const float* W, int ldw, bf16_t* WT, int ldt, int koff, const float* kscale, int nblk, LAS float* scr, int item, int lane) {
    const int kb = item / nblk, nb = item % nblk, k0 = 64 * kb, n0 = 32 * nb;
    int no0 = n0; if (GATEP && n0 < 1024) { const int jb = n0 >= 512 ? 1 : 0, jc = n0 - 512 * jb; no0 = 256 * (jc >> 7) + 128 * jb + (jc & 127); }
    if (GATEP && n0 >= 2816) { const int j = n0 - 2816, jb = j >= 1024 ? 1 : 0, jc = j - 1024 * jb; no0 = 2816 + 256 * (jc >> 7) + 128 * jb + (jc & 127); }
#pragma unroll 8
    for (int i = 0; i < 32; ++i) { const int kk = 2 * i + (lane >> 5); float w = W[(size_t)(k0 + kk) * ldw + n0 + (lane & 31)]; if (kscale) w *= kscale[k0 + kk]; scr[kk * 33 + (lane & 31)] = w; }
    LDS_WAIT(); asm volatile("" ::: "memory");
    const int c = lane & 7;
#pragma unroll
    for (int j = 0; j < 4; ++j) { const int n = (lane >> 3) + 8 * j; const LAS float* s = scr + (8 * c) * 33 + n;
        u32x4 o; o.x = cvt_pk_bf16(s[0 * 33], s[1 * 33]); o.y = cvt_pk_bf16(s[2 * 33], s[3 * 33]); o.z = cvt_pk_bf16(s[4 * 33], s[5 * 33]); o.w = cvt_pk_bf16(s[6 * 33], s[7 * 33]);
        *(u32x4*)(WT + (size_t)(no0 + n) * ldt + koff + k0 + 8 * c) = o; }
    LDS_WAIT(); asm volatile("" ::: "memory");
}

template <int PART> __device__ __forceinline__ void p0_prologue(const Args& a, LAS unsigned char* lds, const int vb, const int VG, const int wave) {
    const int lane = pg8::get_lane(), tid = wave * 64 + lane;
    unsigned char* ws = a.ws;
    LAS float* scr = (LAS float*)(lds + wave * 16384);
    const int gw = vb * NWAVES + wave, NGW = VG * NWAVES;
    const int gt = vb * NTHR + tid, NGT = VG * NTHR;
    constexpr int I_IN = (1024 / 64) * (INTOT / 32), I_C = (512 / 64) * (1024 / 32), I_O = (1024 / 64) * (1024 / 32), I_Q = (1024 / 64) * (2048 / 32);
    constexpr int NITEMS = I_IN + 2 * I_C + I_O + I_Q;
    for (int it = gw; it < NITEMS; it += NGW) {
        int r = it;
        if ((r < I_IN) != (PART != 1) && PART != 2) continue;
        if (r < I_IN) { p0_transpose_item<true>(a.in[3], INTOT, (bf16_t*)(ws + WS_WIN), 1024, 0, nullptr, INTOT / 32, scr, r, lane); continue; } r -= I_IN;
        if (r < I_C) { p0_transpose_item(a.in[8], 1024, (bf16_t*)(ws + WS_WCR), 1024, 0, nullptr, 32, scr, r, lane); continue; } r -= I_C;
        if (r < I_C) { p0_transpose_item(a.in[20], 1024, (bf16_t*)(ws + WS_WCR), 1024, 512, nullptr, 32, scr, r, lane); continue; } r -= I_C;
        if (r < I_O) { p0_transpose_item(a.in[21], 1024, (bf16_t*)(ws + WS_WO), 1024, 0, nullptr, 32, scr, r, lane); continue; } r -= I_O;
        p0_transpose_item(a.in[23], 2048, (bf16_t*)(ws + WS_WQ), 1024, 0, a.in[22], 64, scr, r, lane);
    }
    if (PART != 0) { const float* sk = a.in[24]; bf16_t* o = (bf16_t*)(ws + WS_SK);
      for (int i = gt; i < 16 * 128 * 128 / 8; i += NGT) { const f32x4 x0 = *(const f32x4*)(sk + (size_t)i * 8), x1 = *(const f32x4*)(sk + (size_t)i * 8 + 4); store8(o + (size_t)i * 8, x0, x1); } }
    if (PART != 1) { const float* w_up = a.in[11]; const float* a_up = a.in[13]; const float* g_up = a.in[14]; bf16_t* o = (bf16_t*)(ws + WS_WSM);
      for (int i = gt; i < 1536 * 32; i += NGT) { const int n = i >> 5, k8 = (i & 31) * 8; float v[8];
#pragma unroll
          for (int j = 0; j < 8; ++j) { const int k = k8 + j; float x = 0.f;
              if (n < 512) { if (k < 64) x = w_up[k * 512 + n]; }
              else if (n < 1024) { if (k >= 64 && k < 128) x = a_up[(k - 64) * 512 + (n - 512)]; }
              else { if (k >= 128) x = g_up[(k - 128) * 512 + (n - 1024)]; }
              v[j] = x; }
          store8(o + (size_t)n * 256 + k8, (f32x4){v[0], v[1], v[2], v[3]}, (f32x4){v[4], v[5], v[6], v[7]}); } }
    if (PART != 0) { const float* gf = a.in[22]; unsigned char* t8[2] = {ws + WS_EU, ws + WS_EV};
      for (int it0 = gw; it0 < 2 * NEXP; it0 += 4 * NGW) {
          f32x4 v[4][4];
#pragma unroll
          for (int r = 0; r < 4; ++r) { const int it = it0 + r * NGW; if (it < 2 * NEXP) { const int tb = it >= NEXP ? 1 : 0, e = it - tb * NEXP;
              const float* src = (tb ? a.in[26] : a.in[25]) + (size_t)e * 1024 + 16 * lane;
#pragma unroll
              for (int j = 0; j < 4; ++j) v[r][j] = *(const f32x4*)(src + 4 * j); } }
#pragma unroll
          for (int r = 0; r < 4; ++r) { const int it = it0 + r * NGW; if (it < 2 * NEXP) { const int tb = it >= NEXP ? 1 : 0, e = it - tb * NEXP; float mx = 0.f;
#pragma unroll
              for (int j = 0; j < 4; ++j) { if (!tb) v[r][j] = v[r][j] * *(const f32x4*)(gf + 16 * lane + 4 * j);
                  mx = fmaxf(mx, fmaxf(fmaxf(fabsf(v[r][j][0]), fabsf(v[r][j][1])), fmaxf(fabsf(v[r][j][2]), fabsf(v[r][j][3])))); }
#pragma unroll
              for (int o = 1; o < 64; o <<= 1) mx = fmaxf(mx, __shfl_xor(mx, o));
              mx = fmaxf(mx, 1e-30f);
              const float sc = 384.f / mx;
              u32x4 w; int p;
              p = 0; p = __builtin_amdgcn_cvt_pk_fp8_f32(v[r][0][0] * sc, v[r][0][1] * sc, p, false); p = __builtin_amdgcn_cvt_pk_fp8_f32(v[r][0][2] * sc, v[r][0][3] * sc, p, true); w.x = (unsigned)p;
              p = 0; p = __builtin_amdgcn_cvt_pk_fp8_f32(v[r][1][0] * sc, v[r][1][1] * sc, p, false); p = __builtin_amdgcn_cvt_pk_fp8_f32(v[r][1][2] * sc, v[r][1][3] * sc, p, true); w.y = (unsigned)p;
              p = 0; p = __builtin_amdgcn_cvt_pk_fp8_f32(v[r][2][0] * sc, v[r][2][1] * sc, p, false); p = __builtin_amdgcn_cvt_pk_fp8_f32(v[r][2][2] * sc, v[r][2][3] * sc, p, true); w.z = (unsigned)p;
              p = 0; p = __builtin_amdgcn_cvt_pk_fp8_f32(v[r][3][0] * sc, v[r][3][1] * sc, p, false); p = __builtin_amdgcn_cvt_pk_fp8_f32(v[r][3][2] * sc, v[r][3][3] * sc, p, true); w.w = (unsigned)p;
              unsigned char* tab = tb ? (ws + WS_EV) : (ws + WS_EU);
              *(u32x4*)(tab + (size_t)e * 1024 + 16 * lane) = w;
              if (lane == 0) ((float*)(tab + 16 * MiB))[e] = mx * (1.f / 384.f); } }
      } }
    if (PART != 1) { const float* x = a.in[0]; const float* meta = a.in[1]; const float* gm = a.in[2]; bf16_t* XN = (bf16_t*)(ws + WS_XN);
      f32x4 nv[4];
#define XN_LOAD(mm) do { if ((mm) < MT) { const int b_ = (mm) / T, t_ = (mm) - b_ * T; const float* src_ = (t_ < NMETA) ? meta + (size_t)t_ * 1024 : x + ((size_t)b_ * SEQ + (t_ - NMETA)) * 1024; \
          _Pragma("unroll") for (int j = 0; j < 4; ++j) nv[j] = ((const f32x4*)src_)[lane + 64 * j]; } } while (0)
      if (gw < MP) XN_LOAD(gw);
      for (int m = gw; m < MP; m += NGW) {
          bf16_t* o = XN + (size_t)m * 1024;
          f32x4 v[4];
#pragma unroll
          for (int j = 0; j < 4; ++j) v[j] = nv[j];
          if (m + NGW < MP) XN_LOAD(m + NGW);
          if (m >= MT) { const u32x4 z = {0u, 0u, 0u, 0u}; ((u32x4*)o)[lane] = z; ((u32x4*)o)[lane + 64] = z; continue; }
          float s = 0.f;
#pragma unroll
          for (int j = 0; j < 4; ++j) s += (v[j][0] * v[j][0] + v[j][1] * v[j][1]) + (v[j][2] * v[j][2] + v[j][3] * v[j][3]);
          const float rs = 1.f / sqrtf(wave_sum(s) * (1.f / 1024.f) + 1e-6f);
#pragma unroll
          for (int j = 0; j < 4; ++j) { const f32x4 g = ((const f32x4*)gm)[lane + 64 * j]; const f32x4 y = v[j] * rs * g;
              u32x2 w; w.x = cvt_pk_bf16(y[0], y[1]); w.y = cvt_pk_bf16(y[2], y[3]); ((u32x2*)o)[lane + 64 * j] = w; }
      }
#undef XN_LOAD
    }
}

typedef float f32x2v __attribute__((ext_vector_type(2)));
__device__ __forceinline__ void p2_conv(const Args& a, LAS unsigned char* lds, int G, const int wave, const bool split) {
    const int lane = pg8::get_lane(), tid = wave * 64 + lane;
    const bf16_t* Zc = (const bf16_t*)(a.ws + WS_ZC); bf16_t* ACL = (bf16_t*)(a.ws + WS_ACL);
    const float* conv_w = a.in[4]; const float* conv_b = a.in[5]; const float* ln_g = a.in[6]; const float* ln_b = a.in[7];
    constexpr int CT = 66, HT = 33, NR = CT + 30, TPB = (T + CT - 1) / CT;
    LAS unsigned char* ul = lds;
    LAS unsigned* yl = (LAS unsigned*)lds;
    const int cp = tid & 255, tg = tid >> 8;
    f32x2v w[31];
#pragma unroll
    for (int j = 0; j < 31; ++j) w[j] = *(const f32x2v*)(conv_w + j * 512 + 2 * cp);
    const f32x2v bias = *(const f32x2v*)(conv_b + 2 * cp);
    const bool tailwg = split && (int)blockIdx.x >= G - NB;
    const int it_first = split ? (tailwg ? 0 : (int)blockIdx.x) : (int)blockIdx.x, it_step = split ? (G - NB) : G, it_end = split ? (tailwg ? 1 : NB * (TPB - 1)) : NB * TPB;
    for (int it = it_first; it < it_end; it += it_step) {
        const int b = split ? (tailwg ? (int)blockIdx.x - (G - NB) : it / (TPB - 1)) : it / TPB;
        const int t0 = (split ? (tailwg ? TPB - 1 : it - b * (TPB - 1)) : it - b * TPB) * CT;
        u32x4 vv[12];
#pragma unroll
        for (int k = 0; k < 12; ++k) { const int r = (tid >> 6) + 8 * k, ti = t0 - 30 + r; vv[k] = (u32x4){0u, 0u, 0u, 0u};
            if (ti >= 0 && ti < T) vv[k] = *(const u32x4*)(Zc + (size_t)(b * T + ti) * 512 + 8 * lane); }
#pragma unroll
        for (int k = 0; k < 12; ++k) { const int r = (tid >> 6) + 8 * k; *(LAS u32x4*)(ul + r * 1024 + lane * 16) = vv[k]; }
        __syncthreads();
        f32x2v u[HT + 30];
#pragma unroll
        for (int s = 0; s < HT + 30; ++s) { const unsigned uw = *(const LAS unsigned*)(ul + (tg * HT + s) * 1024 + cp * 4); u[s] = (f32x2v){bflo(uw), bfhi(uw)}; }
        unsigned yv[HT];
#pragma unroll
        for (int o = 0; o < HT; ++o) {
            f32x2v acc = bias;
#pragma unroll
            for (int j = 0; j < 31; ++j) acc = w[j] * u[o + j] + acc;
            yv[o] = cvt_pk_bf16(acc.x, acc.y);
        }
        __syncthreads();
#pragma unroll
        for (int o = 0; o < HT; ++o) yl[(tg * HT + o) * 256 + cp] = yv[o];
        __syncthreads();
        for (int o = wave; o < CT; o += NWAVES) {
            const int t = t0 + o;
            if (t >= NMETA && t < T) {
                const u32x4 yw = *(const LAS u32x4*)(yl + o * 256 + 4 * lane);
                const f32x4 y0 = {bflo(yw.x), bfhi(yw.x), bflo(yw.y), bfhi(yw.y)}, y1 = {bflo(yw.z), bfhi(yw.z), bflo(yw.w), bfhi(yw.w)};
                const float mean = wave_sum((y0[0] + y0[1]) + (y0[2] + y0[3]) + (y1[0] + y1[1]) + (y1[2] + y1[3])) * (1.f / 512.f);
                const f32x4 d0 = y0 - mean, d1 = y1 - mean;
                const float var = wave_sum((d0[0] * d0[0] + d0[1] * d0[1]) + (d0[2] * d0[2] + d0[3] * d0[3]) + (d1[0] * d1[0] + d1[1] * d1[1]) + (d1[2] * d1[2] + d1[3] * d1[3])) * (1.f / 512.f);
                const float rstd = __builtin_amdgcn_rsqf(var + 1e-5f);
                const f32x4 g0 = *(const f32x4*)(ln_g + 8 * lane), g1 = *(const f32x4*)(ln_g + 8 * lane + 4), b0 = *(const f32x4*)(ln_b + 8 * lane), b1 = *(const f32x4*)(ln_b + 8 * lane + 4);
                f32x4 z0 = d0 * rstd * g0 + b0, z1 = d1 * rstd * g1 + b1;
#pragma unroll
                for (int j = 0; j < 4; ++j) { z0[j] = z0[j] * sigm(z0[j]); z1[j] = z1[j] * sigm(z1[j]); }
                store8(ACL + ((size_t)b * SEQ + (t - NMETA)) * 512 + 8 * lane, z0, z1);
            }
        }
        __syncthreads();
    }
}

__device__ __forceinline__ void p2_lorag(const Args& a, int G, const int wave) {
    const int lane = pg8::get_lane();
    const bf16_t* Zr = (const bf16_t*)(a.ws + WS_ZR); bf16_t* A2g = (bf16_t*)(a.ws + WS_A2);
    const float mu0 = a.in[9][1664 + 2 * lane], mu1 = a.in[9][1664 + 2 * lane + 1];
    const int gw = blockIdx.x * NWAVES + wave, NGW = G * NWAVES;
    for (int run = gw; run < MT / 16; run += NGW) {
        const int m0 = run * 16, t0 = m0 % T;
        unsigned rw[17];
        rw[0] = 0u; if (t0 > 0) rw[0] = *(const unsigned*)(Zr + (size_t)(m0 - 1) * RWIN + 1664 + 2 * lane);
#pragma unroll
        for (int i = 0; i < 16; ++i) rw[i + 1] = *(const unsigned*)(Zr + (size_t)(m0 + i) * RWIN + 1664 + 2 * lane);
#pragma unroll
        for (int i = 0; i < 16; ++i) { const float c0 = bflo(rw[i + 1]), c1 = bfhi(rw[i + 1]);
            *(unsigned*)(A2g + (size_t)(m0 + i) * 128 + 2 * lane) = cvt_pk_bf16(sigm(c0 + (bflo(rw[i]) - c0) * mu0), sigm(c1 + (bfhi(rw[i]) - c1) * mu1)); }
    }
}

typedef short s16x4 __attribute__((ext_vector_type(4)));
__device__ __forceinline__ f32x4 mfma16(const s16x4 x, const s16x4 y, const f32x4 c) { return __builtin_amdgcn_mfma_f32_16x16x16bf16_1k(x, y, c, 0, 0, 0); }
__device__ __forceinline__ unsigned short f2bf_bits(float f) { return (unsigned short)(cvt_pk_bf16(f, 0.f) & 0xffffu); }
__device__ __forceinline__ s16x4 pack4(const f32x4 v) { u32x2 w; w.x = cvt_pk_bf16(v[0], v[1]); w.y = cvt_pk_bf16(v[2], v[3]); return __builtin_bit_cast(s16x4, w); }
__device__ __forceinline__ float bf2f(unsigned short b) { return __builtin_bit_cast(float, (unsigned)b << 16); }
constexpr int NCHK = T / 16;

__device__ __forceinline__ bf16_t* bb_base(const Args& a, int b) {
    return (b < 7) ? (bf16_t*)((unsigned char*)a.out + 99 * MiB) : (bf16_t*)(a.ws + WS_A2 + 9 * MiB) - (size_t)7 * T * 512;
}
__device__ __forceinline__ float tanh_fast(float x) { return 1.f - 2.f * __builtin_amdgcn_rcpf(1.f + __expf(2.f * x)); }
constexpr int P4_WSTRIDE = 13568, P4_WL = 8 * P4_WSTRIDE  , P4_MU = P4_WL + 2 * 9216  ;

template <bool TAIL> __device__ __forceinline__ void p4a_fused(const Args& a, LAS unsigned char* lds, int G, const int wave, const int tail_b) {
    const int lane_o = pg8::get_lane();
    const bf16_t* Zr = (const bf16_t*)(a.ws + WS_ZR);
    bf16_t* Rb = (bf16_t*)a.out; bf16_t* Vb = (bf16_t*)((unsigned char*)a.out + 33 * MiB); bf16_t* Kb = (bf16_t*)((unsigned char*)a.out + 66 * MiB);
    bf16_t* KKb = (bf16_t*)(a.ws + WS_KK); bf16_t* Em = (bf16_t*)(a.ws + WS_EM); float* WCa = (float*)(a.ws + WS_WC);
    float* RKs = (float*)(a.ws + WS_RK);
    LAS unsigned char* wl = lds + wave * P4_WSTRIDE;
    LAS unsigned char* mt = wl + 4352;
    LAS float* Al = (LAS float*)(wl + 2048);
    LAS float* ST = (LAS float*)wl;
    constexpr int NVB = 8 * 32, NITEM = TAIL ? 1 : NB * 256;
    const bf16_t* WsmG = (const bf16_t*)(a.ws + WS_WSM);
    for (int vb = TAIL ? 0 : (int)blockIdx.x; vb < (TAIL ? 1 : NVB); vb += G) {
    const int h = TAIL ? wave : (vb & 7), q8 = TAIL ? -wave : (vb >> 3) * 8;
    if (!TAIL) {   const bf16_t* Wsm = (const bf16_t*)(a.ws + WS_WSM); const int tid = wave * 64 + lane_o;
#pragma unroll
        for (int i = 0; i < 2; ++i) { const int q = tid + NTHR * i, kind = q >> 9, ch = (q >> 3) & 63, pc = q & 7;
            *(LAS u32x4*)(lds + P4_WL + kind * 9216 + ch * 144 + pc * 16) = *(const u32x4*)(Wsm + (size_t)(kind * 512 + h * 64 + ch) * 256 + kind * 64 + pc * 8); }
        if (tid < 128) *(LAS float*)(lds + P4_MU + tid * 4) = a.in[9][1536 + tid];
        __syncthreads(); }
    const int chn_o = h * 64 + lane_o;
    const float mu_r = a.in[9][chn_o], mu_k = a.in[9][512 + chn_o], mu_v = a.in[9][1024 + chn_o], w0c = a.in[10][chn_o], a0c = a.in[12][chn_o], kkc = a.in[15][chn_o], kac = a.in[16][chn_o], rkc2 = a.in[17][chn_o];
    u32x4 n_r0, n_r1, n_k0, n_k1, n_v0, n_v1, n_lw0, n_lw1, n_la0, n_la1, n_pw0, n_pw1, n_pa0, n_pa1; unsigned short n_pr, n_pk, n_pv;
#define F_LOAD(bcx) do { const int b_ = TAIL ? tail_b : ((bcx) >> 8), c_ = TAIL ? NCHK - 1 : ((bcx) & 255); const size_t m0_ = (size_t)b_ * T + (size_t)c_ * 16; \
        const bf16_t* zp_ = Zr + (m0_ + prow) * RWIN + h * 64 + pp * 8; \
        n_r0 = *(const u32x4*)zp_; n_r1 = *(const u32x4*)(zp_ + 8 * RWIN); n_k0 = *(const u32x4*)(zp_ + 512); n_k1 = *(const u32x4*)(zp_ + 8 * RWIN + 512); \
        n_v0 = *(const u32x4*)(zp_ + 1024); n_v1 = *(const u32x4*)(zp_ + 8 * RWIN + 1024); \
        const bf16_t* zl_ = Zr + (m0_ + x) * RWIN + 1536 + 8 * g; \
        n_lw0 = *(const u32x4*)zl_; n_lw1 = *(const u32x4*)(zl_ + 32); n_la0 = *(const u32x4*)(zl_ + 64); n_la1 = *(const u32x4*)(zl_ + 96); \
        n_pw0 = (u32x4){0u, 0u, 0u, 0u}; n_pw1 = n_pw0; n_pa0 = n_pw0; n_pa1 = n_pw0; n_pr = 0; n_pk = 0; n_pv = 0; \
        if (c_ > 0) { const bf16_t* zq_ = Zr + (m0_ - 1) * RWIN; \
            n_pr = *(const unsigned short*)(zq_ + chn); n_pk = *(const unsigned short*)(zq_ + 512 + chn); n_pv = *(const unsigned short*)(zq_ + 1024 + chn); \
            n_pw0 = *(const u32x4*)(zq_ + 1536 + 8 * g); n_pw1 = *(const u32x4*)(zq_ + 1568 + 8 * g); n_pa0 = *(const u32x4*)(zq_ + 1600 + 8 * g); n_pa1 = *(const u32x4*)(zq_ + 1632 + 8 * g); } } while (0)
    if (q8 + wave < NITEM) { const int lane = lane_o, x = lane & 15, g = lane >> 4, prow = lane >> 3, pp = lane & 7, chn = h * 64 + lane; F_LOAD(q8 + wave); }
    for (int bc = q8 + wave; bc < NITEM; bc += NVB) {
        int lx_ = lane_o; asm volatile("" : "+v"(lx_)); const int lane = lx_, x = lane & 15, g = lane >> 4, prow = lane >> 3, pp = lane & 7, chn = h * 64 + lane;
        const int b = TAIL ? tail_b : (bc >> 8), c = TAIL ? NCHK - 1 : (bc & 255);
        const size_t m0 = (size_t)b * T + (size_t)c * 16;
        const size_t e0 = m0 * 512 + h * 64;
        const size_t pb = e0 + (size_t)prow * 512 + pp * 8;
        bf16_t* Bb = bb_base(a, b);
        bf16x8 Aw0, Aw1, Aa0, Aa1;
#define LORA_FRAG(DST, CUR, PRV, MUOFF, TANH) do { f32x4 ma_, mb_; if (TAIL) { ma_ = *(const f32x4*)(a.in[9] + 1536 + (MUOFF) + 8 * g); mb_ = *(const f32x4*)(a.in[9] + 1536 + (MUOFF) + 8 * g + 4); } \
            else { ma_ = *(const LAS f32x4*)(lds + P4_MU + ((MUOFF) + 8 * g) * 4); mb_ = *(const LAS f32x4*)(lds + P4_MU + ((MUOFF) + 8 * g) * 4 + 16); } \
            const float mm_[8] = {ma_[0], ma_[1], ma_[2], ma_[3], mb_[0], mb_[1], mb_[2], mb_[3]}; u32x4 o_; \
            _Pragma("unroll") for (int i = 0; i < 4; ++i) { const unsigned cw_ = CUR[i]; const unsigned pw_ = (unsigned)__builtin_amdgcn_update_dpp((int)PRV[i], (int)cw_, 0x111, 0xf, 0xf, false); \
                float zl_ = bflo(cw_), zh_ = bfhi(cw_); zl_ += (bflo(pw_) - zl_) * mm_[2 * i]; zh_ += (bfhi(pw_) - zh_) * mm_[2 * i + 1]; \
                if (TANH) { zl_ = tanh_fast(zl_); zh_ = tanh_fast(zh_); } o_[i] = cvt_pk_bf16(zl_, zh_); } \
            DST = __builtin_bit_cast(bf16x8, o_); } while (0)
        LORA_FRAG(Aw0, n_lw0, n_pw0, 0, true); LORA_FRAG(Aw1, n_lw1, n_pw1, 32, true); LORA_FRAG(Aa0, n_la0, n_pa0, 64, false); LORA_FRAG(Aa1, n_la1, n_pa1, 96, false);
#undef LORA_FRAG
        *(LAS u32x4*)(mt + prow * 128 + pp * 16) = n_k0; *(LAS u32x4*)(mt + (prow + 8) * 128 + pp * 16) = n_k1;
        *(LAS u32x4*)(mt + 2048 + prow * 128 + pp * 16) = n_v0; *(LAS u32x4*)(mt + 2048 + (prow + 8) * 128 + pp * 16) = n_v1;
        *(LAS u32x4*)(mt + 4096 + prow * 128 + pp * 16) = n_r0; *(LAS u32x4*)(mt + 4096 + (prow + 8) * 128 + pp * 16) = n_r1;
        const float p_r = bf2f(n_pr), p_k = bf2f(n_pk), p_v = bf2f(n_pv);
        LDS_WAIT(); asm volatile("" ::: "memory");
        { const int bcn = (bc + NVB < NITEM) ? bc + NVB : bc; F_LOAD(bcn); }
        float ev[16], av[16];
        {   f32x4 accW[4], accA[4]; const f32x4 z4 = {0.f, 0.f, 0.f, 0.f};
#pragma unroll
            for (int n = 0; n < 4; ++n) { bf16x8 bw0, bw1, ba0, ba1;
                if (TAIL) { const bf16_t* gw_ = WsmG + (size_t)(h * 64 + 16 * n + x) * 256 + 8 * g; const bf16_t* ga_ = gw_ + (size_t)512 * 256 + 64;
                    bw0 = *(const bf16x8*)gw_; bw1 = *(const bf16x8*)(gw_ + 32); ba0 = *(const bf16x8*)ga_; ba1 = *(const bf16x8*)(ga_ + 32); }
                else { const LAS unsigned char* wp = lds + P4_WL + (16 * n + x) * 144 + g * 16;
                    bw0 = *(const LAS bf16x8*)wp; bw1 = *(const LAS bf16x8*)(wp + 64); ba0 = *(const LAS bf16x8*)(wp + 9216); ba1 = *(const LAS bf16x8*)(wp + 9216 + 64); }
                accW[n] = __builtin_amdgcn_mfma_f32_16x16x32_bf16(Aw0, bw0, z4, 0, 0, 0); accW[n] = __builtin_amdgcn_mfma_f32_16x16x32_bf16(Aw1, bw1, accW[n], 0, 0, 0);
                accA[n] = __builtin_amdgcn_mfma_f32_16x16x32_bf16(Aa0, ba0, z4, 0, 0, 0); accA[n] = __builtin_amdgcn_mfma_f32_16x16x32_bf16(Aa1, ba1, accA[n], 0, 0, 0); }
#pragma unroll
            for (int n = 0; n < 4; ++n)
#pragma unroll
                for (int r = 0; r < 4; ++r) ST[(4 * g + r) * 68 + 16 * n + x] = accW[n][r];
            LDS_WAIT(); asm volatile("" ::: "memory");
#pragma unroll
            for (int t = 0; t < 16; ++t) ev[t] = (0.60653065971f * 1.44269504089f) * sigm(w0c + ST[t * 68 + lane]);
            LDS_WAIT(); asm volatile("" ::: "memory");
#pragma unroll
            for (int n = 0; n < 4; ++n)
#pragma unroll
                for (int r = 0; r < 4; ++r) ST[(4 * g + r) * 68 + 16 * n + x] = accA[n][r];
            LDS_WAIT(); asm volatile("" ::: "memory");
#pragma unroll
            for (int t = 0; t < 16; ++t) av[t] = sigm(a0c + ST[t * 68 + lane]);
            LDS_WAIT(); asm volatile("" ::: "memory");
        }
        float kkv[16], bv[16], kv[16], rv[16]; unsigned short vbits[16];
#define UNSTAGE_SHIFT(dst, OFF, PREV, MU) do { float pv_ = (PREV); _Pragma("unroll") for (int t = 0; t < 16; ++t) { const float c_ = bf2f(*(const LAS unsigned short*)(mt + (OFF) + t * 128 + lane * 2)); dst[t] = c_ + (pv_ - c_) * (MU); pv_ = c_; } } while (0)
        UNSTAGE_SHIFT(rv, 4096, p_r, mu_r); UNSTAGE_SHIFT(kv, 0, p_k, mu_k); UNSTAGE_SHIFT(bv, 2048, p_v, mu_v);
        LDS_WAIT(); asm volatile("" ::: "memory");
#pragma unroll
        for (int t = 0; t < 16; ++t) vbits[t] = f2bf_bits(bv[t]);
#undef UNSTAGE_SHIFT
        {
#pragma unroll
          for (int t = 0; t < 16; ++t) { kkv[t] = kv[t] * kkc; ST[t * 65 + lane] = kkv[t] * kkv[t]; }
          LDS_WAIT(); asm volatile("" ::: "memory");
          float s = 0.f;
#pragma unroll
          for (int j = 0; j < 16; ++j) s += ST[x * 65 + 16 * g + j];
          s += __shfl_xor(s, 16); s += __shfl_xor(s, 32);
          const int rnb = __builtin_bit_cast(int, __builtin_amdgcn_rsqf(fmaxf(s, 1e-24f)));
          LDS_WAIT(); asm volatile("" ::: "memory");
#pragma unroll
          for (int t = 0; t < 16; ++t) { const float rn = __builtin_bit_cast(float, __builtin_amdgcn_readlane(rnb, t));
              kkv[t] *= rn; bv[t] = kkv[t] * av[t]; kv[t] = kv[t] * (1.f + (av[t] - 1.f) * kac); } }
        {
#pragma unroll
          for (int t = 0; t < 16; ++t) *(LAS float*)(wl + (t * 65 + lane) * 4) = rv[t] * kv[t] * rkc2;
          LDS_WAIT(); asm volatile("" ::: "memory");
          float s = 0.f;
#pragma unroll
          for (int j = 0; j < 16; ++j) s += *(const LAS float*)(wl + (x * 65 + 16 * g + j) * 4);
          s += __shfl_xor(s, 16); s += __shfl_xor(s, 32);
          if (lane < 16) RKs[(m0 + lane) * 8 + h] = s;
          LDS_WAIT(); asm volatile("" ::: "memory"); }
        float lw = 0.f, wprev = 1.f; float bts[16], kts[16];
#pragma unroll
        for (int t = 0; t < 16; ++t) {
            lw -= ev[t]; const float wt = __builtin_amdgcn_exp2f(lw), iw = __builtin_amdgcn_exp2f(-lw);
            bts[t] = bv[t] * iw; kts[t] = kv[t] * iw;
            *(LAS unsigned short*)(mt + 0 * 2304 + t * 144 + lane * 2) = f2bf_bits(-kkv[t] * wprev); *(LAS unsigned short*)(mt + 1 * 2304 + t * 144 + lane * 2) = f2bf_bits(rv[t] * wt);
            *(LAS unsigned short*)(mt + 2 * 2304 + t * 144 + lane * 2) = f2bf_bits(bts[t]); *(LAS unsigned short*)(mt + 3 * 2304 + t * 144 + lane * 2) = f2bf_bits(kts[t]);
            wprev = wt;
        }
        const float wc = wprev;
        {
            const size_t o = e0 + (size_t)(lane >> 2) * 512 + (lane & 3) * 16;
            u32x4 w0, w1;
            w0.x = cvt_pk_bf16(bts[0] * wc, bts[1] * wc); w0.y = cvt_pk_bf16(bts[2] * wc, bts[3] * wc); w0.z = cvt_pk_bf16(bts[4] * wc, bts[5] * wc); w0.w = cvt_pk_bf16(bts[6] * wc, bts[7] * wc);
            w1.x = cvt_pk_bf16(bts[8] * wc, bts[9] * wc); w1.y = cvt_pk_bf16(bts[10] * wc, bts[11] * wc); w1.z = cvt_pk_bf16(bts[12] * wc, bts[13] * wc); w1.w = cvt_pk_bf16(bts[14] * wc, bts[15] * wc);
            *(u32x4*)(Bb + o) = w0; *(u32x4*)(Bb + o + 8) = w1;
            w0.x = cvt_pk_bf16(kts[0] * wc, kts[1] * wc); w0.y = cvt_pk_bf16(kts[2] * wc, kts[3] * wc); w0.z = cvt_pk_bf16(kts[4] * wc, kts[5] * wc); w0.w = cvt_pk_bf16(kts[6] * wc, kts[7] * wc);
            w1.x = cvt_pk_bf16(kts[8] * wc, kts[9] * wc); w1.y = cvt_pk_bf16(kts[10] * wc, kts[11] * wc); w1.z = cvt_pk_bf16(kts[12] * wc, kts[13] * wc); w1.w = cvt_pk_bf16(kts[14] * wc, kts[15] * wc);
            *(u32x4*)(Kb + o) = w0; *(u32x4*)(Kb + o + 8) = w1;
            w0.x = vbits[0] | ((unsigned)vbits[1] << 16); w0.y = vbits[2] | ((unsigned)vbits[3] << 16); w0.z = vbits[4] | ((unsigned)vbits[5] << 16); w0.w = vbits[6] | ((unsigned)vbits[7] << 16);
            w1.x = vbits[8] | ((unsigned)vbits[9] << 16); w1.y = vbits[10] | ((unsigned)vbits[11] << 16); w1.z = vbits[12] | ((unsigned)vbits[13] << 16); w1.w = vbits[14] | ((unsigned)vbits[15] << 16);
            *(u32x4*)(Vb + o) = w0; *(u32x4*)(Vb + o + 8) = w1;
        }
        LDS_WAIT(); asm volatile("" ::: "memory");
        { const u32x4 a0 = *(const LAS u32x4*)(mt + 0 * 2304 + prow * 144 + pp * 16), a1 = *(const LAS u32x4*)(mt + 0 * 2304 + (prow + 8) * 144 + pp * 16);
          const u32x4 r0 = *(const LAS u32x4*)(mt + 1 * 2304 + prow * 144 + pp * 16), r1 = *(const LAS u32x4*)(mt + 1 * 2304 + (prow + 8) * 144 + pp * 16);
          *(u32x4*)(KKb + pb) = a0; *(u32x4*)(KKb + pb + 8 * 512) = a1; *(u32x4*)(Rb + pb) = r0; *(u32x4*)(Rb + pb + 8 * 512) = r1; }
        { int ly_ = lane_o; asm volatile("" : "+v"(ly_)); const int lane = ly_, x = lane & 15, g = lane >> 4, prow = lane >> 3, pp = lane & 7;
        f32x4 Aab = {0.f, 0.f, 0.f, 0.f}, Aak = Aab, Arb = Aab, Ark = Aab, AabT = Aab;
#pragma unroll
        for (int s = 0; s < 4; ++s) {
            const int fo = x * 144 + (16 * s + 4 * g) * 2;
            const s16x4 aF = *(const LAS s16x4*)(mt + 0 * 2304 + fo), rF = *(const LAS s16x4*)(mt + 1 * 2304 + fo), bF = *(const LAS s16x4*)(mt + 2 * 2304 + fo), kF = *(const LAS s16x4*)(mt + 3 * 2304 + fo);
            Aab = mfma16(aF, bF, Aab); Aak = mfma16(aF, kF, Aak); Arb = mfma16(rF, bF, Arb); Ark = mfma16(rF, kF, Ark); AabT = mfma16(bF, aF, AabT);
        }
        f32x4 idr;
#pragma unroll
        for (int r = 0; r < 4; ++r) { const int t = 4 * g + r; if (!(x < t)) { Aab[r] = 0.f; Aak[r] = 0.f; } if (!(x <= t)) { Arb[r] = 0.f; Ark[r] = 0.f; } if (!(t < x)) AabT[r] = 0.f; idr[r] = (x == t) ? 1.f : 0.f;
            *(LAS unsigned short*)(wl + t * 128 + 32 + 2 * x) = f2bf_bits(Arb[r]); *(LAS unsigned short*)(wl + t * 128 + 64 + 2 * x) = f2bf_bits(Aak[r]); *(LAS unsigned short*)(wl + t * 128 + 96 + 2 * x) = f2bf_bits(Ark[r]); }
        {   const f32x4 z4 = {0.f, 0.f, 0.f, 0.f};
            const s16x4 pA = pack4(Aab), pAT = pack4(AabT);
            const f32x4 A2 = mfma16(pAT, pA, z4), A2T = mfma16(pA, pAT, z4);
            const s16x4 pA2 = pack4(A2), pA2T = pack4(A2T);
            const f32x4 A4 = mfma16(pA2T, pA2, z4), A4T = mfma16(pA2, pA2T, z4);
            const f32x4 A8 = mfma16(pack4(A4T), pack4(A4), z4);
            const s16x4 pIAT = pack4(AabT + idr), pIA2 = pack4(A2 + idr), pIA4 = pack4(A4 + idr), pIA8 = pack4(A8 + idr);
            const f32x4 T1T = mfma16(pIA2, pIAT, z4);
            const f32x4 T2T = mfma16(pIA4, pack4(T1T), z4);
            const f32x4 T3 = mfma16(pack4(T2T), pIA8, z4);
#pragma unroll
            for (int r = 0; r < 4; ++r) *(LAS unsigned short*)(wl + (4 * g + r) * 128 + 2 * x) = f2bf_bits(T3[r]);
        }
        LDS_WAIT(); asm volatile("" ::: "memory");
        { const u32x4 m0v = *(const LAS u32x4*)(wl + prow * 128 + pp * 16), m1v = *(const LAS u32x4*)(wl + (prow + 8) * 128 + pp * 16);
          *(u32x4*)(Em + pb) = m0v; *(u32x4*)(Em + pb + 8 * 512) = m1v;
          WCa[((size_t)(b * NHEAD + h) * NCHK + c) * 64 + lane] = wc; }
        LDS_WAIT(); asm volatile("" ::: "memory");
        }
    }
    __syncthreads();
    }
#undef F_LOAD
}

struct ScanOps { s16x4 Af[4], Rf[4], Mf[4], BTf[4], KTf[4], VTf; f32x4 WCf[4]; };
constexpr int RS_STRIDE = 13824, RS_NSLOT = 3, RS_OBUF = RS_NSLOT * RS_STRIDE;
constexpr int SCAN_NIT = 264;
__device__ __forceinline__ int rs_mk(int low3) { return low3 | (((low3 >> 2) & 1) << 3); }
__device__ __forceinline__ int rs_mig(int i, int g) { return rs_mk(2 * i + (g >> 1)); }
__device__ __forceinline__ int rs_mgh(int g, int h) { return rs_mk(2 * ((g >> 1) * 2 + h)); }
__device__ __forceinline__ s16x4 lo64(const u32x4 v) { const u32x2 w = {v.x, v.y}; return __builtin_bit_cast(s16x4, w); }
__device__ __forceinline__ s16x4 hi64(const u32x4 v) { const u32x2 w = {v.z, v.w}; return __builtin_bit_cast(s16x4, w); }
__device__ __forceinline__ void scan_frag_read(ScanOps& o, LAS unsigned char* slot, const int (&oar)[4], const int (&om)[2], const int ov, const int g) {
#pragma unroll
    for (int i = 0; i < 4; ++i) {
        const u32x4 ar = *(const LAS u32x4*)(slot + oar[i]), bk = *(const LAS u32x4*)(slot + 4096 + oar[i]);
        o.Af[i] = lo64(ar); o.Rf[i] = hi64(ar); o.BTf[i] = lo64(bk); o.KTf[i] = hi64(bk);
        o.WCf[i] = *(const LAS f32x4*)(slot + 12800 + (4 * i + g) * 16); }
    const u32x4 m0 = *(const LAS u32x4*)(slot + 8192 + om[0]), m1 = *(const LAS u32x4*)(slot + 8192 + om[1]);
    o.Mf[0] = lo64(m0); o.Mf[1] = hi64(m0); o.Mf[2] = lo64(m1); o.Mf[3] = hi64(m1);
    o.VTf = *(const LAS s16x4*)(slot + 10240 + ov);
}
__device__ __forceinline__ void scan_step(const ScanOps& o, f32x4 (&Sacc)[4], s16x4 (&Sb)[4], LAS float* ob, int x, int g, int w) {
    const f32x4 z = {0.f, 0.f, 0.f, 0.f};
    f32x4 X = mfma16(o.Mf[2], o.VTf, z);
#pragma unroll
    for (int i = 0; i < 4; ++i) X = mfma16(o.Af[i], Sb[i], X);
    const s16x4 Xb = pack4(X);
    const f32x4 U = mfma16(o.Mf[0], Xb, z); const s16x4 Ub = pack4(U);
    f32x4 Oc = mfma16(o.Mf[3], o.VTf, z);
#pragma unroll
    for (int i = 0; i < 4; ++i) Oc = mfma16(o.Rf[i], Sb[i], Oc);
    Oc = mfma16(o.Mf[1], Ub, Oc);
#pragma unroll
    for (int i = 0; i < 4; ++i) { f32x4 s = Sacc[i] * o.WCf[i]; s = mfma16(o.KTf[i], o.VTf, s); s = mfma16(o.BTf[i], Ub, s); Sacc[i] = s; Sb[i] = pack4(s); }
#pragma unroll
    for (int r = 0; r < 4; ++r) ob[(4 * g + r) * 64 + 16 * w + x] = Oc[r];
}

__device__ __forceinline__ void p4b_chain(const Args& a, LAS unsigned char* lds, int G, const int wave) {
    const int lane = pg8::get_lane(), x = lane & 15, g = lane >> 4;
    const bf16_t* Rb = (const bf16_t*)a.out; const bf16_t* Vb = (const bf16_t*)((unsigned char*)a.out + 33 * MiB); const bf16_t* Kb = (const bf16_t*)((unsigned char*)a.out + 66 * MiB);
    const bf16_t* KKb = (const bf16_t*)(a.ws + WS_KK);
    const bf16_t* Em = (const bf16_t*)(a.ws + WS_EM); const float* WCa = (const float*)(a.ws + WS_WC); bf16_t* ORAW = (bf16_t*)(a.ws + WS_ORAW);
    LAS float* obuf = (LAS float*)(lds + RS_OBUF);
#define SCAN_BAR() do { asm volatile("s_waitcnt lgkmcnt(0)" ::: "memory"); __builtin_amdgcn_s_barrier(); asm volatile("" ::: "memory"); } while (0)
    for (int it = blockIdx.x; it < NB * NHEAD; it += G) {
        const int b = it >> 3, h = it & 7;
        const bf16_t* Bb = bb_base(a, b);
        const size_t ebase = (size_t)b * T * 512 + h * 64;
        const int sb0 = (int)(ebase * 2);
        if (wave < 4) {
            f32x4 Sacc[4]; s16x4 Sb[4];
#pragma unroll
            for (int i = 0; i < 4; ++i) { Sacc[i] = (f32x4){0.f, 0.f, 0.f, 0.f}; Sb[i] = (s16x4){0, 0, 0, 0}; }
            int oar[4], om[2];
#pragma unroll
            for (int i = 0; i < 4; ++i) oar[i] = (4 * i + g) * 256 + ((x ^ rs_mig(i, g)) * 16);
            om[0] = (2 * g) * 256 + ((x ^ rs_mgh(g, 0)) * 16); om[1] = (2 * g + 1) * 256 + ((x ^ rs_mgh(g, 1)) * 16);
            const int ov = g * 640 + (16 * wave + x) * 8;
            SCAN_BAR();
            ScanOps opA, opB;
            scan_frag_read(opA, lds, oar, om, ov, g);
#define CONS_ITER(cc, CUR, NXT) do { { const int sn_ = ((cc) + 1) % 3; scan_frag_read(NXT, lds + sn_ * RS_STRIDE, oar, om, ov, g); } \
                if ((cc) < NCHK) scan_step(CUR, Sacc, Sb, obuf + ((cc) & 1) * 1024, x, g, wave); SCAN_BAR(); } while (0)
            for (int cc = 0; cc < SCAN_NIT; cc += 2) { CONS_ITER(cc, opA, opB); CONS_ITER(cc + 1, opB, opA); }
#undef CONS_ITER
        } else {
            const int lw = wave - 4, hf = lw & 1, prow = 8 * hf + (lane >> 3), pp = lane & 7;
            const __amdgpu_buffer_rsrc_t rs0 = __builtin_amdgcn_make_buffer_rsrc((void*)(lw < 2 ? KKb : Rb), 0, 0x7fffffff, 0x00020000);
            const __amdgpu_buffer_rsrc_t rs1 = __builtin_amdgcn_make_buffer_rsrc((void*)(lw < 2 ? Bb : Kb), 0, 0x7fffffff, 0x00020000);
            const __amdgpu_buffer_rsrc_t rs2 = __builtin_amdgcn_make_buffer_rsrc((void*)(lw < 2 ? (const void*)Vb : (const void*)Em), 0, 0x7fffffff, 0x00020000);
            const __amdgpu_buffer_rsrc_t rsE = __builtin_amdgcn_make_buffer_rsrc((void*)WCa, 0, 0x7fffffff, 0x00020000), rsO = __builtin_amdgcn_make_buffer_rsrc((void*)ORAW, 0, 0x7fffffff, 0x00020000);
            const int vo01 = prow * 1024 + pp * 16;
            const int voW = (lane & 15) * 16, wcb0 = it * NCHK * 256;
            const int hi8 = (lw < 2) ? 0 : 8;
            int w0a[2], w1a[2], w2a[2];
#pragma unroll
            for (int hl = 0; hl < 2; ++hl) { const int gg = 2 * (pp & 1) + hl, ii = pp >> 1;
                w0a[hl] = (4 * ii + gg) * 256 + ((prow ^ rs_mig(ii, gg)) * 16) + hi8;
                const int kr = 4 * prow + (pp >> 1), ki = kr >> 4, kx = kr & 15;
                w1a[hl] = 4096 + (4 * ki + gg) * 256 + ((kx ^ rs_mig(ki, gg)) * 16) + hi8;
                w2a[hl] = (lw < 2) ? (10240 + gg * 640 + kr * 8) : (8192 + (2 * gg + (ii >> 1)) * 256 + ((prow ^ rs_mgh(gg, ii >> 1)) * 16) + 8 * (ii & 1)); }
            const int ldW = 12800 + (lane & 15) * 16;
            struct RSet { u32x4 r0, r1, r2, rw; };
            RSet s0, s1, s2, s3, s4, s5, s6, s7;
#define RING_LOAD(S, chunk) do { const int cn_ = ((chunk) < NCHK) ? (chunk) : NCHK - 1; const int so_ = sb0 + cn_ * 16 * 1024; \
                S.r0 = __builtin_amdgcn_raw_buffer_load_b128(rs0, vo01, so_, 0); S.r1 = __builtin_amdgcn_raw_buffer_load_b128(rs1, vo01, so_, 0); \
                S.r2 = __builtin_amdgcn_raw_buffer_load_b128(rs2, vo01, so_, 0); S.rw = __builtin_amdgcn_raw_buffer_load_b128(rsE, voW, wcb0 + cn_ * 256, 0); } while (0)
#define RING_WRITE(S, slotp) do { LAS unsigned char* sp_ = (slotp); \
                *(LAS u32x2*)(sp_ + w0a[0]) = (u32x2){S.r0.x, S.r0.y}; *(LAS u32x2*)(sp_ + w0a[1]) = (u32x2){S.r0.z, S.r0.w}; \
                *(LAS u32x2*)(sp_ + w1a[0]) = (u32x2){S.r1.x, S.r1.y}; *(LAS u32x2*)(sp_ + w1a[1]) = (u32x2){S.r1.z, S.r1.w}; \
                *(LAS u32x2*)(sp_ + w2a[0]) = (u32x2){S.r2.x, S.r2.y}; *(LAS u32x2*)(sp_ + w2a[1]) = (u32x2){S.r2.z, S.r2.w}; \
                if (lw == 0 && lane < 16) *(LAS u32x4*)(sp_ + ldW) = S.rw; } while (0)
            RING_LOAD(s0, 0); RING_LOAD(s1, 1); RING_LOAD(s2, 2); RING_LOAD(s3, 3); RING_LOAD(s4, 4); RING_LOAD(s5, 5); RING_LOAD(s6, 6); RING_LOAD(s7, 7);
            RING_WRITE(s0, lds); RING_LOAD(s0, 8); RING_WRITE(s1, lds + RS_STRIDE);
            SCAN_BAR();
#define LOADER_ITER(cc, WS, LS) do { \
                RING_WRITE(WS, lds + (((cc) + 2) % 3) * RS_STRIDE); RING_LOAD(LS, (cc) + 9); \
                if ((cc) >= 1 && (cc) <= NCHK) { const int pc = (cc) - 1; const LAS float* ob = obuf + (pc & 1) * 1024; \
                      \
                    const f32x4 ov_ = *(const LAS f32x4*)(ob + (4 * lw + (lane >> 4)) * 64 + 4 * (lane & 15)); \
                    const u32x2 ow_ = {cvt_pk_bf16(ov_[0], ov_[1]), cvt_pk_bf16(ov_[2], ov_[3])}; \
                    __builtin_amdgcn_raw_buffer_store_b64(ow_, rsO, (lane >> 4) * 1024 + 8 * (lane & 15), sb0 + (pc * 16 + 4 * lw) * 1024, 0); } \
                SCAN_BAR(); } while (0)
            static_assert(SCAN_NIT % 8 == 0 && SCAN_NIT > NCHK, "loader iterations come in eights");
            for (int cc = 0; cc < SCAN_NIT; cc += 8) { LOADER_ITER(cc, s2, s1); LOADER_ITER(cc + 1, s3, s2); LOADER_ITER(cc + 2, s4, s3); LOADER_ITER(cc + 3, s5, s4);
                                                      LOADER_ITER(cc + 4, s6, s5); LOADER_ITER(cc + 5, s7, s6); LOADER_ITER(cc + 6, s0, s7); LOADER_ITER(cc + 7, s1, s0); }
#undef LOADER_ITER
#undef RING_WRITE
#undef RING_LOAD
        }
        __syncthreads();
    }
#undef SCAN_BAR
}

__device__ __forceinline__ void p4c_post(const Args& a, int G, const int wave) {
    const int lane = pg8::get_lane();
    const bf16_t* ORAW = (const bf16_t*)(a.ws + WS_ORAW); const bf16_t* Vb = (const bf16_t*)((unsigned char*)a.out + 33 * MiB); const bf16_t* Gb = (const bf16_t*)(a.ws + WS_ZR + 33 * MiB);
    const float* RKs = (const float*)(a.ws + WS_RK); bf16_t* ACR = (bf16_t*)(a.ws + WS_XN);
    const float* gn_g = a.in[18]; const float* gn_b = a.in[19];
    const int gw = blockIdx.x * NWAVES + wave, NGW = G * NWAVES;
    for (int m2 = gw; m2 < M2; m2 += NGW) {
        const int b = m2 >> 12, t = (m2 & 4095) + NMETA; const size_t m = (size_t)b * T + t;
        const int c = t >> 4, ts = t & 15;
        const float rkv = (lane < 8) ? RKs[m * 8 + lane] : 0.f;
#pragma unroll
        for (int h = 0; h < NHEAD; ++h) {
            const float o = bf2f(ORAW[m * 512 + h * 64 + lane]);
            const float vv = bf2f(Vb[((size_t)b * T + c * 16 + (lane >> 2)) * 512 + h * 64 + (lane & 3) * 16 + ts]);
            const float gg = bf2f(Gb[m * 512 + h * 64 + lane]);
            const float s1 = wave_sum(o), s2 = wave_sum(o * o);
            const float mean = s1 * (1.f / 64.f), var = fmaxf(s2 * (1.f / 64.f) - mean * mean, 0.f);
            const float rk = __builtin_bit_cast(float, __builtin_amdgcn_readlane(__builtin_bit_cast(int, rkv), h));
            const float res = ((o - mean) * (1.f / sqrtf(var + 64e-5f)) * gn_g[h * 64 + lane] + gn_b[h * 64 + lane] + rk * vv) * gg;
            ACR[(size_t)m2 * 512 + h * 64 + lane] = f2bf_bits(res);
        }
    }
}

#define CE_DESC(x, y) do { const float _hi = fmaxf((x), (y)), _lo = fminf((x), (y)); (x) = _hi; (y) = _lo; } while (0)
__device__ __forceinline__ void sort16_desc(float (&v)[16]) {
    CE_DESC(v[0], v[1]); CE_DESC(v[2], v[3]); CE_DESC(v[0], v[2]); CE_DESC(v[1], v[3]); CE_DESC(v[1], v[2]); CE_DESC(v[4], v[5]); CE_DESC(v[6], v[7]); CE_DESC(v[4], v[6]); CE_DESC(v[5], v[7]); CE_DESC(v[5], v[6]); CE_DESC(v[0], v[4]); CE_DESC(v[2], v[6]); CE_DESC(v[2], v[4]); CE_DESC(v[1], v[5]); CE_DESC(v[3], v[7]); CE_DESC(v[3], v[5]); CE_DESC(v[1], v[2]); CE_DESC(v[3], v[4]); CE_DESC(v[5], v[6]); CE_DESC(v[8], v[9]); CE_DESC(v[10], v[11]); CE_DESC(v[8], v[10]); CE_DESC(v[9], v[11]); CE_DESC(v[9], v[10]); CE_DESC(v[12], v[13]); CE_DESC(v[14], v[15]); CE_DESC(v[12], v[14]); CE_DESC(v[13], v[15]); CE_DESC(v[13], v[14]); CE_DESC(v[8], v[12]); CE_DESC(v[10], v[14]); CE_DESC(v[10], v[12]); CE_DESC(v[9], v[13]); CE_DESC(v[11], v[15]); CE_DESC(v[11], v[13]); CE_DESC(v[9], v[10]); CE_DESC(v[11], v[12]); CE_DESC(v[13], v[14]); CE_DESC(v[0], v[8]); CE_DESC(v[4], v[12]); CE_DESC(v[4], v[8]); CE_DESC(v[2], v[10]); CE_DESC(v[6], v[14]); CE_DESC(v[6], v[10]); CE_DESC(v[2], v[4]); CE_DESC(v[6], v[8]); CE_DESC(v[10], v[12]); CE_DESC(v[1], v[9]); CE_DESC(v[5], v[13]); CE_DESC(v[5], v[9]); CE_DESC(v[3], v[11]); CE_DESC(v[7], v[15]); CE_DESC(v[7], v[11]); CE_DESC(v[3], v[5]); CE_DESC(v[7], v[9]); CE_DESC(v[11], v[13]); CE_DESC(v[1], v[2]); CE_DESC(v[3], v[4]); CE_DESC(v[5], v[6]); CE_DESC(v[7], v[8]); CE_DESC(v[9], v[10]); CE_DESC(v[11], v[12]); CE_DESC(v[13], v[14]);
}
__device__ __forceinline__ void merge16(float (&x)[16], const float (&y)[16]) {
#pragma unroll
    for (int i = 0; i < 16; ++i) x[i] = fmaxf(x[i], y[15 - i]);
#pragma unroll
    for (int j = 8; j > 0; j >>= 1) {
#pragma unroll
        for (int i = 0; i < 16; ++i) { const int l = i ^ j; if (l > i) CE_DESC(x[i], x[l]); }
    }
}
__device__ __forceinline__ void xmerge16(float (&x)[16], int mask) {
    float y[16];
#pragma unroll
    for (int i = 0; i < 16; ++i) y[i] = __shfl_xor(x[i], mask);
    merge16(x, y);
}
__device__ __forceinline__ float pk_low(float x, unsigned code, unsigned keep_mask) { return __builtin_bit_cast(float, (__builtin_bit_cast(unsigned, x) & keep_mask) | code); }

__device__ __forceinline__ void p9_topk(const Args& a, LAS unsigned char* lds, int G, const int wave) {
    const int lane = pg8::get_lane(), tid = wave * 64 + lane;
    const bf16_t* Q = (const bf16_t*)(a.ws + WS_ZG); const bf16_t* SK = (const bf16_t*)(a.ws + WS_SK);
    int* TKid = (int*)(a.ws + WS_KK); float* TKg = (float*)(a.ws + WS_KK + 16 * MiB);
    LAS unsigned char* wl = lds + 65536 + wave * 512;
    const int fr = lane & 15, fq = lane >> 4;
    const bool aligned = (G % 8 == 0);
    const int nhb = aligned ? G / 8 : G, rank = aligned ? (int)(blockIdx.x >> 3) : (int)blockIdx.x;
    constexpr int NGRP = M2 / 16;
    for (int h = aligned ? (int)(blockIdx.x & 7) : 0; h < PH; h += aligned ? 8 : 1) {
        __syncthreads();
#pragma unroll
        for (int k = 0; k < 8; ++k) { const int pi = wave * 64 + lane + 512 * k, c = pi >> 11, row = (pi >> 4) & 127, pp = pi & 15;
            const u32x4 v = *(const u32x4*)(SK + ((size_t)(h * 2 + c) * 128 + row) * 128 + pp * 8);
            *(LAS u32x4*)(lds + c * 32768 + row * 256 + ((pp ^ (row & 15)) * 16)) = v; }
        __syncthreads();
    for (int grp = rank * NWAVES + wave; grp < NGRP; grp += nhb * NWAVES) {
        const int tok0 = grp * 16;
        float top[2][16];
#pragma unroll
        for (int c = 0; c < 2; ++c) {
            f32x4 acc[8];
#pragma unroll
            for (int nt = 0; nt < 8; ++nt) acc[nt] = (f32x4){0.f, 0.f, 0.f, 0.f};
            const bf16_t* qrow = Q + (size_t)(tok0 + fr) * 2048 + h * 256 + c * 128 + fq * 8;
            bf16x8 qf[4];
#pragma unroll
            for (int ks = 0; ks < 4; ++ks) qf[ks] = *(const bf16x8*)(qrow + ks * 32);
            const LAS unsigned char* skl = lds + c * 32768 + fr * 256;
#pragma unroll
            for (int nt = 0; nt < 8; ++nt)
#pragma unroll
                for (int ks = 0; ks < 4; ++ks) { const bf16x8 kf = *(const LAS bf16x8*)(skl + nt * 4096 + (((4 * ks + fq) ^ fr) * 16));
                    acc[nt] = __builtin_amdgcn_mfma_f32_16x16x32_bf16(kf, qf[ks], acc[nt], 0, 0, 0); }
            float lo[16], hi[16];
#pragma unroll
            for (int nt = 0; nt < 4; ++nt)
#pragma unroll
                for (int r = 0; r < 4; ++r) { lo[nt * 4 + r] = pk_low(acc[nt][r], (unsigned)(16 * nt + 4 * fq + r), 0xffffff80u); hi[nt * 4 + r] = pk_low(acc[nt + 4][r], (unsigned)(16 * (nt + 4) + 4 * fq + r), 0xffffff80u); }
            sort16_desc(lo); sort16_desc(hi); merge16(lo, hi); xmerge16(lo, 16); xmerge16(lo, 32);
#pragma unroll
            for (int i = 0; i < 16; ++i) top[c][i] = lo[i];
        }
        float cand[16];
        const float PAD = -3.0e38f;
#pragma unroll
        for (int s = 0; s < 16; ++s) {
            const int i1 = (s < 8) ? 1 : (s < 13) ? 2 : 4, j1 = (s < 8) ? s : (s < 13) ? s - 8 : s - 13;
            const int i2 = (s < 4) ? 3 : (s < 6) ? 5 : (s < 8) ? 6 : 7, j2 = (s < 4) ? s : (s < 6) ? s - 4 : (s < 8) ? s - 6 : s - 8;
            const float c0 = pk_low(top[0][0] + top[1][s], (unsigned)s, 0xffffff00u);
            const float c1 = pk_low(top[0][i1] + top[1][j1], (unsigned)(i1 * 16 + j1), 0xffffff00u);
            const float c2 = (s < 10) ? pk_low(top[0][i2] + top[1][j2], (unsigned)(i2 * 16 + j2), 0xffffff00u) : PAD;
            const float c3 = (s < 8) ? pk_low(top[0][8 + s] + top[1][0], (unsigned)((8 + s) * 16), 0xffffff00u) : PAD;
            cand[s] = (fq == 0) ? c0 : (fq == 1) ? c1 : (fq == 2) ? c2 : c3;
        }
        sort16_desc(cand); xmerge16(cand, 16); xmerge16(cand, 32);
        if (fq == 0) {
            u32x4 wa, wb; unsigned pa[4], pb[4];
#pragma unroll
            for (int g = 0; g < 4; ++g) { pa[g] = 0u; pb[g] = 0u;
#pragma unroll
                for (int j = 0; j < 4; ++j) { pa[g] |= (__builtin_bit_cast(unsigned, top[0][4 * g + j]) & 0x7fu) << (8 * j); pb[g] |= (__builtin_bit_cast(unsigned, top[1][4 * g + j]) & 0x7fu) << (8 * j); } }
            wa.x = pa[0]; wa.y = pa[1]; wa.z = pa[2]; wa.w = pa[3]; wb.x = pb[0]; wb.y = pb[1]; wb.z = pb[2]; wb.w = pb[3];
            *(LAS u32x4*)(wl + fr * 32) = wa; *(LAS u32x4*)(wl + fr * 32 + 16) = wb;
            LDS_WAIT();
            float p[16], sum = 0.f; int eid[16];
            const float mx = cand[0];
#pragma unroll
            for (int i = 0; i < 16; ++i) { p[i] = __expf(cand[i] - mx); sum += p[i];
                const unsigned code = __builtin_bit_cast(unsigned, cand[i]) & 0xffu;
                const int i1 = wl[fr * 32 + (code >> 4)], i2 = wl[fr * 32 + 16 + (code & 15u)];
                eid[i] = i1 * PK + i2; }
            const float inv = 1.f / sum;
            int* ip = TKid + (size_t)(tok0 + fr) * 128 + h * 16; float* gp = TKg + (size_t)(tok0 + fr) * 128 + h * 16;
#pragma unroll
            for (int g = 0; g < 4; ++g) { *(int4*)(ip + 4 * g) = make_int4(eid[4 * g], eid[4 * g + 1], eid[4 * g + 2], eid[4 * g + 3]);
                *(f32x4*)(gp + 4 * g) = (f32x4){p[4 * g] * inv, p[4 * g + 1] * inv, p[4 * g + 2] * inv, p[4 * g + 3] * inv}; }
            LDS_WAIT();
        }
    }
    }
}

typedef __bf16 bf16v2 __attribute__((ext_vector_type(2)));
__device__ __forceinline__ float dot2bf(unsigned x, unsigned y, float acc) { return __builtin_amdgcn_fdot2_f32_bf16(__builtin_bit_cast(bf16v2, x), __builtin_bit_cast(bf16v2, y), acc, false); }
__device__ __forceinline__ float gelu_exact(float x) { return 0.5f * x * (1.f + erff(x * 0.70710678118f)); }

typedef float f32x2 __attribute__((ext_vector_type(2)));
struct XcdPart { unsigned nloc, nx, rnk, kx; };
typedef long i64_t;
__device__ __forceinline__ i64_t pack64(unsigned lo, unsigned hi) { const u32x2 w = {lo, hi}; return __builtin_bit_cast(i64_t, w); }
__device__ __forceinline__ void pu_partial(const Args& a, LAS unsigned char* lds, const int wave, const XcdPart xp) {
    const int lane = pg8::get_lane(), j16 = lane & 15, kq = lane >> 4;
    const bf16_t* H1b = (const bf16_t*)(a.ws + WS_ZC); const int* TKid = (const int*)(a.ws + WS_KK); const float* ssq = (const float*)(a.ws + WS_SSQ);
    const unsigned char* EU = a.ws + WS_EU; bf16_t* PART = (bf16_t*)(a.ws + WS_ZG);
    const int t_first = (int)xp.rnk * NWAVES + wave, t_stride = (int)xp.nloc * NWAVES;
    const int nt = (t_first < M2) ? (M2 - t_first + t_stride - 1) / t_stride : 0;
    if (nt == 0) return;
    const __amdgpu_buffer_rsrc_t rP = __builtin_amdgcn_make_buffer_rsrc((void*)PART, 0, 0x7fffffff, 0x00020000);
    LAS unsigned char* wl = lds + wave * 16384; LAS unsigned char* xs = lds + 132096 + wave * 128; LAS unsigned char* la = lds + 133120 + wave * 1664;
    const int pz0 = ((lane & 7) ^ (lane >> 4)) * 16, pz1 = ((lane & 7) ^ (4 + (lane >> 4))) * 16;
    const int mm = (j16 >> 1) & 7, rob = (j16 >> 3) * 1024 + (j16 & 7) * 128;
    const int ro0 = rob + (((2 * kq) ^ mm) * 16), ro1 = rob + (((2 * kq + 1) ^ mm) * 16);
    const f32x4 z4 = {0.f, 0.f, 0.f, 0.f};
    for (int s = (int)xp.kx; s < 8; s += (int)xp.nx) {
        const unsigned char* EUs = EU + 128 * s;
        i64_t xc[4];
#define PU_X(j) do { const int jc_ = ((j) < nt) ? (j) : nt - 1; const int tk_ = t_first + jc_ * t_stride; LAS unsigned char* sl_ = la + ((j) & 1) * 832; \
            __builtin_amdgcn_global_load_lds((const unsigned*)(TKid + (size_t)tk_ * 128 + lane), (LAS unsigned*)sl_, 4, 0, 0); \
            __builtin_amdgcn_global_load_lds((const unsigned*)(TKid + (size_t)tk_ * 128 + 64 + lane), (LAS unsigned*)(sl_ + 256), 4, 0, 0); \
            __builtin_amdgcn_global_load_lds((const unsigned*)(H1b + (size_t)tk_ * 1024 + 128 * s + 2 * lane), (LAS unsigned*)(sl_ + 512), 4, 0, 0); \
            if (lane == 0) __builtin_amdgcn_global_load_lds((const unsigned*)(ssq + tk_), (LAS unsigned*)(sl_ + 768), 4, 0, 0); } while (0)
#define PU_X8(j) do { const LAS unsigned char* sl_ = la + ((j) & 1) * 832; const u32x4 X = *(const LAS u32x4*)(sl_ + 512 + 16 * j16); const float sq_ = *(const LAS float*)(sl_ + 768); \
            const float sc_ = 16.f * __builtin_amdgcn_rsqf(sq_ * (1.f / 1024.f) + 1e-6f); \
            int p0_ = 0, p1_ = 0; \
            p0_ = __builtin_amdgcn_cvt_pk_fp8_f32(bflo(X.x) * sc_, bfhi(X.x) * sc_, p0_, false); p0_ = __builtin_amdgcn_cvt_pk_fp8_f32(bflo(X.y) * sc_, bfhi(X.y) * sc_, p0_, true); \
            p1_ = __builtin_amdgcn_cvt_pk_fp8_f32(bflo(X.z) * sc_, bfhi(X.z) * sc_, p1_, false); p1_ = __builtin_amdgcn_cvt_pk_fp8_f32(bflo(X.w) * sc_, bfhi(X.w) * sc_, p1_, true); \
            *(LAS u32x2*)(xs + 8 * j16) = (u32x2){(unsigned)p0_, (unsigned)p1_}; LDS_WAIT(); asm volatile("" ::: "memory"); \
            const u32x4 xa_ = *(const LAS u32x4*)(xs + 32 * kq), xb_ = *(const LAS u32x4*)(xs + 32 * kq + 16); LDS_WAIT(); asm volatile("" ::: "memory"); \
            xc[0] = pack64(xa_.x, xa_.y); xc[1] = pack64(xa_.z, xa_.w); xc[2] = pack64(xb_.x, xb_.y); xc[3] = pack64(xb_.z, xb_.w); } while (0)
#define PU_Q(j, c) do { const LAS unsigned char* sl_ = la + ((j) & 1) * 832; _Pragma("unroll") for (int w_ = 0; w_ < 4; ++w_) { \
            const unsigned id_ = *(const LAS unsigned*)(sl_ + 4 * (32 * (c) + 8 * w_ + (lane >> 3))); \
            const unsigned char* gp_ = EUs + ((size_t)id_ << 10) + ((w_ & 1) ? pz1 : pz0); \
            __builtin_amdgcn_global_load_lds((const unsigned*)gp_, (LAS unsigned*)(wl + (c) * 4096 + w_ * 1024), 16, 0, 1); } } while (0)
#define PU_G(ACC, P0, P1) do { ACC = __builtin_amdgcn_mfma_f32_16x16x32_fp8_fp8(xc[0], pack64(P0.x, P0.y), z4, 0, 0, 0); ACC = __builtin_amdgcn_mfma_f32_16x16x32_fp8_fp8(xc[1], pack64(P0.z, P0.w), ACC, 0, 0, 0); \
            ACC = __builtin_amdgcn_mfma_f32_16x16x32_fp8_fp8(xc[2], pack64(P1.x, P1.y), ACC, 0, 0, 0); ACC = __builtin_amdgcn_mfma_f32_16x16x32_fp8_fp8(xc[3], pack64(P1.z, P1.w), ACC, 0, 0, 0); } while (0)
#define PU_C(ACC0, ACC1, c) do { asm volatile("s_waitcnt vmcnt(16)" ::: "memory"); \
            const u32x4 a0_ = *(const LAS u32x4*)(wl + (c) * 4096 + ro0), a1_ = *(const LAS u32x4*)(wl + (c) * 4096 + ro1), b0_ = *(const LAS u32x4*)(wl + (c) * 4096 + 2048 + ro0), b1_ = *(const LAS u32x4*)(wl + (c) * 4096 + 2048 + ro1); \
            LDS_WAIT(); asm volatile("" ::: "memory");        \
            PU_G(ACC0, a0_, a1_); PU_G(ACC1, b0_, b1_); } while (0)
        PU_X(0); PU_X(1);
        asm volatile("s_waitcnt vmcnt(0)" ::: "memory");
        PU_X8(0);
        PU_Q(0, 0); PU_Q(0, 1); PU_Q(0, 2); PU_Q(0, 3);
        for (int j = 0; j < nt; ++j) {
            PU_X(j + 2);
            f32x4 c0, c1, c2, c3, c4, c5, c6, c7;
            PU_C(c0, c1, 0); PU_Q(j + 1, 0);
            PU_C(c2, c3, 1); PU_Q(j + 1, 1);
            PU_C(c4, c5, 2); PU_Q(j + 1, 2);
            PU_C(c6, c7, 3); PU_Q(j + 1, 3);
            { const float v0 = (kq == 0) ? c0[0] : (kq == 1) ? c1[0] : (kq == 2) ? c2[0] : c3[0], v1 = (kq == 0) ? c4[0] : (kq == 1) ? c5[0] : (kq == 2) ? c6[0] : c7[0];
              const int so_ = (s * M2 + t_first + j * t_stride) * 256;
              __builtin_amdgcn_raw_buffer_store_b16(f2bf_bits(v0), rP, 2 * lane, so_, 0); __builtin_amdgcn_raw_buffer_store_b16(f2bf_bits(v1), rP, 2 * lane + 128, so_, 0); }
            PU_X8(j + 1);
        }
        asm volatile("s_waitcnt vmcnt(0)" ::: "memory");
#undef PU_C
#undef PU_G
#undef PU_Q
#undef PU_X8
#undef PU_X
    }
}
__device__ __forceinline__ void pc_combine(const Args& a, int G, const int wave) {
    const int lane = pg8::get_lane();
    const int* TKid = (const int*)(a.ws + WS_KK); const float* TKg = (const float*)(a.ws + WS_KK + 16 * MiB); const bf16_t* PART = (const bf16_t*)(a.ws + WS_ZG); bf16_t* CFb = (bf16_t*)(a.ws + WS_A2);
    const float* SU = (const float*)(a.ws + WS_EU + 16 * MiB); const float* SV = (const float*)(a.ws + WS_EV + 16 * MiB);
    const int gt = blockIdx.x * NTHR + wave * 64 + lane, NGT = G * NTHR;
    for (int idx0 = gt; idx0 < M2 * 128; idx0 += 4 * NGT) {
        int id[4]; float gt4[4], sm[4], su[4], sv[4];
#pragma unroll
        for (int u = 0; u < 4; ++u) { const int idx = idx0 + u * NGT; const int ic = (idx < M2 * 128) ? idx : idx0;
            id[u] = TKid[ic]; gt4[u] = TKg[ic];
            unsigned short pr[8];
#pragma unroll
            for (int sl = 0; sl < 8; ++sl) pr[sl] = PART[(size_t)sl * M2 * 128 + ic];
            float s = 0.f;
#pragma unroll
            for (int sl = 0; sl < 8; ++sl) s += bf2f(pr[sl]);
            sm[u] = s; }
#pragma unroll
        for (int u = 0; u < 4; ++u) { su[u] = SU[id[u]]; sv[u] = SV[id[u]]; }
#pragma unroll
        for (int u = 0; u < 4; ++u) { const int idx = idx0 + u * NGT;
            if (idx < M2 * 128) CFb[idx] = f2bf_bits(gt4[u] * gelu_exact(sm[u] * (1.f / 16.f) * su[u]) * sv[u]); }
    }
}
__device__ __forceinline__ float wave_max_nn(float x) {
#define DPP_MAXNN(x, ctrl) fmaxf((x), __builtin_bit_cast(float, __builtin_amdgcn_update_dpp(0, __builtin_bit_cast(int, (x)), (ctrl), 0xf, 0xf, true)))
    x = DPP_MAXNN(x, 0xB1); x = DPP_MAXNN(x, 0x4E); x = DPP_MAXNN(x, 0x141); x = DPP_MAXNN(x, 0x140);
#undef DPP_MAXNN
    const int xi = __builtin_bit_cast(int, x);
    const float a = __builtin_bit_cast(float, __builtin_amdgcn_readlane(xi, 0)), b = __builtin_bit_cast(float, __builtin_amdgcn_readlane(xi, 16)), c = __builtin_bit_cast(float, __builtin_amdgcn_readlane(xi, 32)), d = __builtin_bit_cast(float, __builtin_amdgcn_readlane(xi, 48));
    return fmaxf(fmaxf(a, b), fmaxf(c, d));
}
typedef int v2i_t __attribute__((ext_vector_type(2)));
__device__ __forceinline__ void pv_output(const Args& a, LAS unsigned char* lds, const int wave, const XcdPart xp) {
    const int lane = pg8::get_lane(), kq = lane >> 4;
    const int* TKid = (const int*)(a.ws + WS_KK); const bf16_t* CFb = (const bf16_t*)(a.ws + WS_A2);
    const unsigned char* EV = a.ws + WS_EV; bf16_t* Y = (bf16_t*)(a.ws + WS_ZG);
    const int t_first = (int)xp.rnk * NWAVES + wave, t_stride = (int)xp.nloc * NWAVES;
    const int nt = (t_first < M2) ? (M2 - t_first + t_stride - 1) / t_stride : 0;
    if (nt == 0) return;
    const __amdgpu_buffer_rsrc_t rY = __builtin_amdgcn_make_buffer_rsrc((void*)Y, 0, 0x7fffffff, 0x00020000);
    LAS unsigned char* wl = lds + wave * 16384; LAS unsigned char* cv = lds + 131328 + wave * 128; LAS unsigned char* la = lds + 132352 + wave * 1536;
    const int pz0 = ((lane & 7) ^ (lane >> 4)) * 16, pz1 = ((lane & 7) ^ (4 + (lane >> 4))) * 16;
    const int q = (lane & 15) >> 1, jj = 8 * (kq & 1) + q, mm = (jj >> 1) & 7;
    const int trb = (kq >> 1) * 2048 + (jj >> 3) * 1024 + (jj & 7) * 128 + 8 * (lane & 1);
    for (int s = (int)xp.kx; s < 8; s += (int)xp.nx) {
        const unsigned char* EVs = EV + 128 * s;
        i64_t cf[4]; float yinv;
#define PV_X(j) do { const int jc_ = ((j) < nt) ? (j) : nt - 1; const int tk_ = t_first + jc_ * t_stride; LAS unsigned char* sl_ = la + ((j) & 1) * 768; \
            __builtin_amdgcn_global_load_lds((const unsigned*)(TKid + (size_t)tk_ * 128 + lane), (LAS unsigned*)sl_, 4, 0, 0); \
            __builtin_amdgcn_global_load_lds((const unsigned*)(TKid + (size_t)tk_ * 128 + 64 + lane), (LAS unsigned*)(sl_ + 256), 4, 0, 0); \
            __builtin_amdgcn_global_load_lds((const unsigned*)(CFb + (size_t)tk_ * 128 + 2 * lane), (LAS unsigned*)(sl_ + 512), 4, 0, 0); } while (0)
#define PV_CF(j) do { const LAS unsigned char* sl_ = la + ((j) & 1) * 768; const unsigned w_ = *(const LAS unsigned*)(sl_ + 512 + 4 * lane); const float c0_ = bflo(w_), c1_ = bfhi(w_); \
            const float m_ = fmaxf(wave_max_nn(fmaxf(fabsf(c0_), fabsf(c1_))), 1e-30f); const float sc_ = 256.f * __builtin_amdgcn_rcpf(m_); yinv = m_ * (1.f / 256.f); \
            const int p_ = __builtin_amdgcn_cvt_pk_fp8_f32(c0_ * sc_, c1_ * sc_, 0, false); \
            *(LAS unsigned short*)(cv + 2 * lane) = (unsigned short)(p_ & 0xffff); LDS_WAIT(); asm volatile("" ::: "memory"); \
            _Pragma("unroll") for (int k_ = 0; k_ < 4; ++k_) cf[k_] = *(const LAS i64_t*)(cv + 32 * k_ + 8 * kq); \
            LDS_WAIT(); asm volatile("" ::: "memory"); } while (0)
#define PV_Q(j, c) do { const LAS unsigned char* sl_ = la + ((j) & 1) * 768; _Pragma("unroll") for (int w_ = 0; w_ < 4; ++w_) { \
            const unsigned id_ = *(const LAS unsigned*)(sl_ + 4 * (32 * (c) + 8 * w_ + (lane >> 3))); \
            const unsigned char* gp_ = EVs + ((size_t)id_ << 10) + ((w_ & 1) ? pz1 : pz0); \
            __builtin_amdgcn_global_load_lds((const unsigned*)gp_, (LAS unsigned*)(wl + (c) * 4096 + w_ * 1024), 16, 0, 1); } } while (0)
#define PV_C(c) do { asm volatile("s_waitcnt vmcnt(15)" ::: "memory"); v2i_t b_[8]; \
            _Pragma("unroll") for (int n_ = 0; n_ < 8; ++n_) b_[n_] = __builtin_amdgcn_ds_read_tr8_b64_v2i32((LAS v2i_t*)(wl + (c) * 4096 + trb + ((n_ ^ mm) * 16))); \
            LDS_WAIT(); asm volatile("" ::: "memory");        \
            _Pragma("unroll") for (int n_ = 0; n_ < 8; ++n_) acc[n_] = __builtin_amdgcn_mfma_f32_16x16x32_fp8_fp8(cf[c], __builtin_bit_cast(i64_t, b_[n_]), acc[n_], 0, 0, 0); } while (0)
        PV_X(0); PV_X(1);
        asm volatile("s_waitcnt vmcnt(0)" ::: "memory");
        PV_CF(0);
        PV_Q(0, 0); PV_Q(0, 1); PV_Q(0, 2); PV_Q(0, 3);
        for (int j = 0; j < nt; ++j) {
            PV_X(j + 2);
            f32x4 acc[8];
#pragma unroll
            for (int n_ = 0; n_ < 8; ++n_) acc[n_] = (f32x4){0.f, 0.f, 0.f, 0.f};
            PV_C(0); PV_Q(j + 1, 0);
            PV_C(1); PV_Q(j + 1, 1);
            PV_C(2); PV_Q(j + 1, 2);
            PV_C(3); PV_Q(j + 1, 3);
            { const float v0 = ((kq == 0) ? acc[0][0] : (kq == 1) ? acc[1][0] : (kq == 2) ? acc[2][0] : acc[3][0]) * yinv, v1 = ((kq == 0) ? acc[4][0] : (kq == 1) ? acc[5][0] : (kq == 2) ? acc[6][0] : acc[7][0]) * yinv;
              const int so_ = (t_first + j * t_stride) * 2048 + 256 * s;
              __builtin_amdgcn_raw_buffer_store_b16(f2bf_bits(v0), rY, 2 * lane, so_, 0); __builtin_amdgcn_raw_buffer_store_b16(f2bf_bits(v1), rY, 2 * lane + 128, so_, 0); }
            PV_CF(j + 1);
        }
        asm volatile("s_waitcnt vmcnt(0)" ::: "memory");
#undef PV_C
#undef PV_Q
#undef PV_CF
#undef PV_X
    }
}
__device__ __forceinline__ void pf_final(const Args& a, int G, const int wave) {
    const int lane = pg8::get_lane();
    float* OUT = a.out; const bf16_t* H1b = (const bf16_t*)(a.ws + WS_ZC); const bf16_t* Y = (const bf16_t*)(a.ws + WS_ZG); const float* gfin = a.in[27];
    const int gw = blockIdx.x * NWAVES + wave, NGW = G * NWAVES;
    f32x4 g[4];
#pragma unroll
    for (int q = 0; q < 4; ++q) g[q] = *(const f32x4*)(gfin + 16 * lane + 4 * q);
    u32x4 hn0, hn1, yn0, yn1;
#define PF_LOAD(tok) do { hn0 = *(const u32x4*)(H1b + (size_t)(tok) * 1024 + 16 * lane); hn1 = *(const u32x4*)(H1b + (size_t)(tok) * 1024 + 16 * lane + 8); \
        yn0 = *(const u32x4*)(Y + (size_t)(tok) * 1024 + 16 * lane); yn1 = *(const u32x4*)(Y + (size_t)(tok) * 1024 + 16 * lane + 8); } while (0)
    if (gw < M2) PF_LOAD(gw);
    for (int tok = gw; tok < M2; tok += NGW) {
        const u32x4 h0 = hn0, h1 = hn1, y0 = yn0, y1 = yn1;
        { const int tn = (tok + NGW < M2) ? tok + NGW : tok; PF_LOAD(tn); }
        f32x4 h[4];
        h[0] = (f32x4){bflo(h0.x) + bflo(y0.x), bfhi(h0.x) + bfhi(y0.x), bflo(h0.y) + bflo(y0.y), bfhi(h0.y) + bfhi(y0.y)};
        h[1] = (f32x4){bflo(h0.z) + bflo(y0.z), bfhi(h0.z) + bfhi(y0.z), bflo(h0.w) + bflo(y0.w), bfhi(h0.w) + bfhi(y0.w)};
        h[2] = (f32x4){bflo(h1.x) + bflo(y1.x), bfhi(h1.x) + bfhi(y1.x), bflo(h1.y) + bflo(y1.y), bfhi(h1.y) + bfhi(y1.y)};
        h[3] = (f32x4){bflo(h1.z) + bflo(y1.z), bfhi(h1.z) + bfhi(y1.z), bflo(h1.w) + bflo(y1.w), bfhi(h1.w) + bfhi(y1.w)};
        float s = 0.f;
#pragma unroll
        for (int q = 0; q < 4; ++q) s += (h[q][0] * h[q][0] + h[q][1] * h[q][1]) + (h[q][2] * h[q][2] + h[q][3] * h[q][3]);
        const float rf = __builtin_amdgcn_rsqf(wave_sum(s) * (1.f / 1024.f) + 1e-6f);
        float* op = OUT + (size_t)tok * 1024 + 16 * lane;
#pragma unroll
        for (int q = 0; q < 4; ++q) *(f32x4*)(op + 4 * q) = h[q] * rf * g[q];
    }
#undef PF_LOAD
}

#define XB_TMO      128
#define XB_XCNT(j)  (256  + 64 * (j))
#define XB_XSUB(j)  (1280 + 64 * (j))
#define XB_XGEN(j)  (2304 + 64 * (j))
#define XB_TOP      3328
#define XB_TOPGEN   3392
#define XCD_BAR_WORDS 3456
#define XB_SPIN_CAP (1u << 23)
__device__ __forceinline__ unsigned xb_ld(unsigned* p)              { return __hip_atomic_load(p, __ATOMIC_RELAXED, __HIP_MEMORY_SCOPE_AGENT); }
__device__ __forceinline__ unsigned xb_add(unsigned* p, unsigned v) { return __hip_atomic_fetch_add(p, v, __ATOMIC_RELAXED, __HIP_MEMORY_SCOPE_AGENT); }
__device__ __forceinline__ unsigned xb_xcc_id() { return (unsigned)__builtin_amdgcn_s_getreg((3 << 11) | 20) & 0xFu; }
#define XB_SPIN(cond, bar) do { unsigned _sp = 0; while (cond) { __builtin_amdgcn_s_sleep(1); \
    if ((++_sp & 255u) == 0u) { if (xb_ld(&(bar)[XB_TMO])) break; if (_sp > XB_SPIN_CAP) { atomicAdd(&(bar)[XB_TMO], 1u); break; } } } } while (0)
struct XcdBarrier { unsigned* bar; unsigned x; volatile LAS unsigned* st; };
__device__ __forceinline__ void xcd_barrier_complete(unsigned* bar, unsigned x, unsigned G, unsigned& nloc, unsigned& nx, unsigned& below) {
    unsigned sum, cnt, mine, sp = 0u;
    for (;;) {
        sum = 0u; cnt = 0u; mine = 0u; below = 0u;
#pragma unroll
        for (unsigned j = 0; j < 16; ++j) { const unsigned c = xb_ld(&bar[XB_XCNT(j)]); sum += c; cnt += (c > 0u) ? 1u : 0u; mine = (j == x) ? c : mine; below += (j < x && c > 0u) ? 1u : 0u; }
        if (sum == G) break;
        __builtin_amdgcn_s_sleep(1);
        if ((++sp & 255u) == 0u) { if (xb_ld(&bar[XB_TMO])) break; if (sp > XB_SPIN_CAP) { atomicAdd(&bar[XB_TMO], 1u); break; } }
    }
    nloc = mine > 0u ? mine : 1u; nx = cnt > 0u ? cnt : 1u;
}
__device__ __forceinline__ void xcd_barrier(const XcdBarrier& b, const bool t0, const unsigned G) {
    asm volatile("s_waitcnt vmcnt(0)" ::: "memory");
    __syncthreads();
    if (t0) {
        unsigned* bar = b.bar;
        __builtin_amdgcn_s_waitcnt(0);
        unsigned nloc = b.st[0], nx = b.st[1];
        if (nloc == 0u) { unsigned below; xcd_barrier_complete(bar, b.x, G, nloc, nx, below); b.st[0] = nloc; b.st[1] = nx; b.st[3] = below; }
        const unsigned old = xb_add(&bar[XB_XSUB(b.x)], 1u);
        const unsigned gen = old / nloc;
        if (old + 1u == (gen + 1u) * nloc) {
            __builtin_amdgcn_fence(__ATOMIC_RELEASE, "agent");
            asm volatile("s_waitcnt vmcnt(0)" ::: "memory");
            const unsigned og = xb_add(&bar[XB_TOP], 1u);
            const unsigned tg = og / nx;
            if (og + 1u == (tg + 1u) * nx) xb_add(&bar[XB_TOPGEN], 1u);
            else XB_SPIN(xb_ld(&bar[XB_TOPGEN]) == tg, bar);
            __builtin_amdgcn_fence(__ATOMIC_ACQUIRE, "agent");
            xb_add(&bar[XB_XGEN(b.x)], 1u);
            asm volatile("s_waitcnt vmcnt(0)" ::: "memory");
        } else {
            XB_SPIN(xb_ld(&bar[XB_XGEN(b.x)]) == gen, bar);
            __builtin_amdgcn_fence(__ATOMIC_ACQUIRE, "agent");
            asm volatile("s_waitcnt vmcnt(0)" ::: "memory");
        }
    }
    __syncthreads();
}
constexpr size_t WS_BAR = 64 * 1024;
constexpr int LDS_BAR_OFF = 131072;

#if defined(MK_DUP_PH) && MK_DUP_PH == 5
#define MK_REP5 2
#else
#define MK_REP5 1
#endif
#if defined(MK_DUP_PH) && MK_DUP_PH == 7
#define MK_REP7 2
#else
#define MK_REP7 1
#endif
#ifndef MK_PADN
#define MK_PADN 0
#endif
#define MK_PAD() asm volatile(".rept " MK_STR(MK_PADN) "\n s_nop 0\n .endr" ::: "memory")
#define MK_STR2(x) #x
#define MK_STR(x) MK_STR2(x)
constexpr int NPH = 13;
__global__ void __launch_bounds__(NTHR, 2) fwd_kernel(Args a) {
    __shared__ __attribute__((aligned(16))) unsigned char lds_raw[LDS_BYTES];
    LAS unsigned char* lds = (LAS unsigned char*)lds_raw;
    MK_PAD();
    const int G = gridDim.x;
    const int wave_s = __builtin_amdgcn_readfirstlane((int)threadIdx.x >> 6);
    const int lo = a.ph_lo, hi = a.ph_hi;
#define IN(k) (lo <= (k) && (k) < hi)
#if MK_ONE_LAUNCH
    XcdBarrier xbar; xbar.bar = (unsigned*)(a.ws + WS_BAR); xbar.st = (volatile LAS unsigned*)(lds + LDS_BAR_OFF); xbar.x = xb_xcc_id();
    { const int lane0 = pg8::get_lane(); if (wave_s == 0 && lane0 < 4) xbar.st[lane0] = 0u; __syncthreads(); }
#define SEAM(k) do { if (IN(k) && IN((k) + 1)) { if ((k) == 0) cg::this_grid().sync(); else { const bool t0_ = (wave_s == 0) && (pg8::get_lane() == 0); xcd_barrier(xbar, t0_, (unsigned)G); } } } while (0)
#else
#define SEAM(k) do { } while (0)
#endif
#if defined(MK_PROBE_PH)
    volatile LAS unsigned long long* stamps = (volatile LAS unsigned long long*)(lds + LDS_BAR_OFF + 64);
#define STAMP(i) do { if (blockIdx.x == 0 && wave_s == 0 && pg8::get_lane() == 0) stamps[(i)] = __builtin_amdgcn_s_memrealtime(); } while (0)
#else
#define STAMP(i) do { } while (0)
#endif
    STAMP(0);
    unsigned char* ws = a.ws;
    bf16_t* XN = (bf16_t*)(ws + WS_XN);
    const bool late_p0 = (G > NB * NHEAD);
    if (IN(0)) {
#if MK_ONE_LAUNCH
        { const int gt_ = (int)blockIdx.x * NTHR + wave_s * 64 + pg8::get_lane(), NGT_ = G * NTHR; unsigned* bw_ = (unsigned*)(ws + WS_BAR); float* sq_ = (float*)(ws + WS_SSQ);
          for (int i = gt_; i < XCD_BAR_WORDS; i += NGT_) bw_[i] = 0u;
          for (int i = gt_; i < M2; i += NGT_) sq_[i] = 0.f; }
#endif
        if (late_p0) p0_prologue<0>(a, lds, (int)blockIdx.x, G, wave_s); else p0_prologue<2>(a, lds, (int)blockIdx.x, G, wave_s); } SEAM(0); STAMP(1);
#if MK_ONE_LAUNCH
    if (wave_s == 0 && pg8::get_lane() == 0) xbar.st[2] = xb_add(&xbar.bar[XB_XCNT(xbar.x)], 1u);
#endif
    constexpr int NZ_LATE = 4;
    const int nz_early = late_p0 ? (INTOT / 256 - NZ_LATE) : INTOT / 256;
    if (IN(1)) {
        pg8::Gemm g{XN, (const bf16_t*)(ws + WS_WIN), MP, nz_early * 256, 1024, 1024, 1024}; pg8::StaticOrder S; S.init(MP, nz_early * 256, G, (int)blockIdx.x);
        pg8::EpiZ E{(bf16_t*)(ws + WS_ZC), (bf16_t*)(ws + WS_ZR), (bf16_t*)(ws + WS_ZG), 0};
        pg8::gemm_phase<pg8::EpiZ, pg8::StaticOrder, true, true>(lds, g, S, E, wave_s);
    } SEAM(1); STAMP(2);
#if defined(MK_DUP_PH) && MK_DUP_PH == 2
    if (IN(2)) { p2_conv(a, lds, G, wave_s, false); p2_lorag(a, G, wave_s); __syncthreads(); }
#endif
#if defined(MK_DUP_PH) && MK_DUP_PH == 21
    if (IN(2)) { p2_conv(a, lds, G, wave_s, false); __syncthreads(); }
#endif
    const bool split_tail = (G >= 64) && (G % 8 == 0);
    if (IN(2)) { p2_conv(a, lds, G, wave_s, split_tail);
        if (split_tail && (int)blockIdx.x >= G - NB) { __syncthreads(); p4a_fused<true>(a, lds, G, wave_s, (int)blockIdx.x - (G - NB)); }
        p2_lorag(a, G, wave_s); __syncthreads(); }
#if defined(MK_DUP_PH) && MK_DUP_PH == 43
    if (IN(4)) { p4a_fused<false>(a, lds, G, wave_s, 0); __syncthreads(); }
#endif
    if (IN(4)) { p4a_fused<false>(a, lds, G, wave_s, 0); if (!split_tail) { for (int tb_ = (int)blockIdx.x; tb_ < NB; tb_ += G) { __syncthreads(); p4a_fused<true>(a, lds, G, wave_s, tb_); } } }
#if MK_ONE_LAUNCH
    if (IN(4)) { const bool t0_ = (wave_s == 0) && (pg8::get_lane() == 0); xcd_barrier(xbar, t0_, (unsigned)G); }
#endif
#if defined(MK_DUP_PH) && MK_DUP_PH == 41
    if (IN(4)) { p4b_chain(a, lds, G, wave_s); __syncthreads(); }
#endif
#define G_GEMM(VG, VB) do { pg8::Gemm gg_{(const bf16_t*)(ws + WS_A2), (const bf16_t*)(ws + WS_WSM) + (size_t)1024 * 256 + 128, MP, 512, 128, 128, 256}; pg8::StaticOrder Sg_; Sg_.init(MP, 512, (VG), (VB)); \
        pg8::EpiG Eg_{(bf16_t*)(ws + WS_ZR + 33 * MiB)}; pg8::gemm_phase<pg8::EpiG, pg8::StaticOrder, true, true>(lds, gg_, Sg_, Eg_, wave_s); } while (0)
    if (IN(4)) {
        if (!late_p0) { G_GEMM(G, (int)blockIdx.x); __syncthreads(); }
        if ((int)blockIdx.x < NB * NHEAD || !late_p0) p4b_chain(a, lds, G, wave_s);
        else {
            G_GEMM(G - NB * NHEAD, (int)blockIdx.x - NB * NHEAD); __syncthreads();
            p0_prologue<1>(a, lds, (int)blockIdx.x - NB * NHEAD, G - NB * NHEAD, wave_s);
            __syncthreads();
            pg8::Gemm g{XN, (const bf16_t*)(ws + WS_WIN) + (size_t)nz_early * 256 * 1024, MP, NZ_LATE * 256, 1024, 1024, 1024}; pg8::StaticOrder S; S.init(MP, NZ_LATE * 256, G - NB * NHEAD, (int)blockIdx.x - NB * NHEAD);
            pg8::EpiZ E{(bf16_t*)(ws + WS_ZC), (bf16_t*)(ws + WS_ZR), (bf16_t*)(ws + WS_ZG), nz_early};
            pg8::gemm_phase<pg8::EpiZ, pg8::StaticOrder, true, true>(lds, g, S, E, wave_s);
        }
    }
#if MK_ONE_LAUNCH
    if (IN(4)) { const bool t0_ = (wave_s == 0) && (pg8::get_lane() == 0); xcd_barrier(xbar, t0_, (unsigned)G); }
#endif
#if defined(MK_DUP_PH) && MK_DUP_PH == 42
    if (IN(4)) { p4c_post(a, G, wave_s); __syncthreads(); }
#endif
    if (IN(4)) { p4c_post(a, G, wave_s); } SEAM(4); STAMP(5);
#if defined(MK_DUP_PH) && MK_DUP_PH == 99 && MK_ONE_LAUNCH
    { const bool t0_ = (wave_s == 0) && (pg8::get_lane() == 0); for (int r_ = 0; r_ < 10; ++r_) xcd_barrier(xbar, t0_, (unsigned)G); }
#endif
    for (int rep_ = 0; rep_ < MK_REP5; ++rep_)
    if (IN(5)) {
        bf16_t* Mx = (bf16_t*)(ws + WS_ZR); const bf16_t* Zg = (const bf16_t*)(ws + WS_ZG);
        pg8::Gemm g{(const bf16_t*)(ws + WS_ACL), (const bf16_t*)(ws + WS_WCR), M2, 1024, 1024, 512, 1024, (const bf16_t*)(ws + WS_XN)}; pg8::StaticOrder S; S.init(M2, 1024, G, (int)blockIdx.x);
        pg8::EpiMixF E{Mx, Zg}; pg8::gemm_phase<pg8::EpiMixF, pg8::StaticOrder, true, true>(lds, g, S, E, wave_s);
    } SEAM(5); STAMP(6);
#if defined(MK_DUP_PH) && MK_DUP_PH == 6
    if (IN(6)) {
        pg8::Gemm g{(const bf16_t*)(ws + WS_ZR), (const bf16_t*)(ws + WS_WO), M2, 1024, 1024, 1024, 1024}; pg8::StaticOrder S; S.init(M2, 1024, G, (int)blockIdx.x);
        pg8::EpiH1 E{a.in[0], a.out, (bf16_t*)(ws + WS_ZC), (float*)(ws + WS_CTL + 768 * 1024)};
        pg8::gemm_phase<pg8::EpiH1, pg8::StaticOrder, true, true>(lds, g, S, E, wave_s); __syncthreads();
    }
#endif
    if (IN(6)) {
        pg8::Gemm g{(const bf16_t*)(ws + WS_ZR), (const bf16_t*)(ws + WS_WO), M2, 1024, 1024, 1024, 1024}; pg8::StaticOrder S; S.init(M2, 1024, G, (int)blockIdx.x);
        pg8::EpiH1 E{a.in[0], a.out, (bf16_t*)(ws + WS_ZC), (float*)(ws + WS_SSQ)};
        pg8::gemm_phase<pg8::EpiH1, pg8::StaticOrder, true, true>(lds, g, S, E, wave_s);
    } SEAM(6); STAMP(7);
    for (int rep_ = 0; rep_ < MK_REP7; ++rep_)
    if (IN(7)) {
        pg8::Gemm g{(const bf16_t*)(ws + WS_ZC), (const bf16_t*)(ws + WS_WQ), M2, 2048, 1024, 1024, 1024}; pg8::StaticOrder S; S.init(M2, 2048, G, (int)blockIdx.x);
        pg8::EpiQ E{(bf16_t*)(ws + WS_ZG), (const float*)(ws + WS_SSQ)};
        pg8::gemm_phase<pg8::EpiQ, pg8::StaticOrder, true, true>(lds, g, S, E, wave_s);
    } SEAM(7); STAMP(8);
#if defined(MK_DUP_PH) && MK_DUP_PH == 8
    if (IN(8)) { p9_topk(a, lds, G, wave_s); __syncthreads(); }
#endif
    if (IN(8)) { p9_topk(a, lds, G, wave_s); } SEAM(8); STAMP(9);
    XcdPart xp;
#if MK_ONE_LAUNCH
    xp.nloc = __builtin_amdgcn_readfirstlane(xbar.st[0]); xp.nx = __builtin_amdgcn_readfirstlane(xbar.st[1]); xp.rnk = __builtin_amdgcn_readfirstlane(xbar.st[2]); xp.kx = __builtin_amdgcn_readfirstlane(xbar.st[3]);
    if (xp.nloc == 0u || xp.nx == 0u) { xp.nloc = (unsigned)G; xp.nx = 1u; xp.rnk = blockIdx.x; xp.kx = 0u; }
#else
    xp.nloc = (unsigned)G; xp.nx = 1u; xp.rnk = blockIdx.x; xp.kx = 0u;
#endif
#if defined(MK_DUP_PH) && MK_DUP_PH == 9
    if (IN(9)) { pu_partial(a, lds, wave_s, xp); __syncthreads(); }
#endif
    if (IN(9)) { pu_partial(a, lds, wave_s, xp); } SEAM(9);
    if (IN(10)) { pc_combine(a, G, wave_s); } SEAM(10);
#if defined(MK_DUP_PH) && MK_DUP_PH == 11
    if (IN(11)) { pv_output(a, lds, wave_s, xp); __syncthreads(); }
#endif
    if (IN(11)) { pv_output(a, lds, wave_s, xp); } SEAM(11);
    if (IN(12)) { pf_final(a, G, wave_s); }
#if defined(MK_PROBE_PH)
    STAMP(10);
    if (blockIdx.x == 0 && wave_s == 0 && pg8::get_lane() == 0) { asm volatile("s_waitcnt vmcnt(0) lgkmcnt(0)" ::: "memory"); const float us = (float)(stamps[MK_PROBE_PH + 1] - stamps[MK_PROBE_PH]) * 0.01f; a.out[0] += us; }
#endif
#undef IN
#undef SEAM
}

extern "C" void kernel_launch(void* const* d_in, const int* in_sizes, int n_in, void* d_out, int out_size, void* d_ws, size_t ws_size, hipStream_t stream) {
    static int grid = 0;
    if (grid == 0) {
        if (n_in != 28 || out_size != M2 * D || ws_size < WS_END) { fprintf(stderr, "kernel_launch: unexpected shapes (n_in %d out %d ws %zu)\n", n_in, out_size, ws_size); grid = -1; return; }
        int dev = 0, cus = 0, per_cu = 0;
        if (hipGetDevice(&dev) != hipSuccess || hipDeviceGetAttribute(&cus, hipDeviceAttributeMultiprocessorCount, dev) != hipSuccess) { grid = -1; return; }
        if (hipOccupancyMaxActiveBlocksPerMultiprocessor(&per_cu, (const void*)fwd_kernel, NTHR, 0) != hipSuccess || per_cu < 1) { fprintf(stderr, "kernel_launch: occupancy query says %d blocks per CU\n", per_cu); (void)hipGetLastError(); grid = -1; return; }
        grid = cus;
    }
    if (grid < 0) return;
    Args a{};
    for (int i = 0; i < 28; ++i) a.in[i] = (const float*)d_in[i];
    a.out = (float*)d_out; a.ws = (unsigned char*)d_ws;
#if MK_ONE_LAUNCH
    a.ph_lo = 0; a.ph_hi = NPH;
    void* args[] = {&a};
    hipError_t e = hipLaunchCooperativeKernel((const void*)fwd_kernel, dim3(grid), dim3(NTHR), args, 0, stream);
    if (e != hipSuccess) fprintf(stderr, "kernel_launch: cooperative launch failed: %s (grid %d)\n", hipGetErrorString(e), grid);
#else
#ifndef MK_PH_HI
#define MK_PH_HI NPH
#endif
#ifndef MK_PH_LO
#define MK_PH_LO 0
#endif
    for (int ph = MK_PH_LO; ph < MK_PH_HI; ++ph) { a.ph_lo = ph; a.ph_hi = ph + 1; hipLaunchKernelGGL(fwd_kernel, dim3(grid), dim3(NTHR), 0, stream, a); }
#endif
}
```
